# Optimizing an MI355X kernel written in HIP

```python
import jax, jax.numpy as jnp
from jax import lax
import numpy as np

D_MODEL = 1024
BATCH = 32
SEQ = 2048
DEPTH = 1

D_MIX = D_MODEL
D_SGU = D_MIX // 2
SGU_GROUPS = 4
SGU_GROUP_DIM = D_SGU // SGU_GROUPS
CHUNK = 128
N_HEADS = 8
HEAD_DIM = (D_MIX - D_SGU) // N_HEADS
N_KV_HEADS = 2
GQA_GROUP = N_HEADS // N_KV_HEADS
ROT_DIM = HEAD_DIM // 4
ROPE_THETA = 500000.0
IDX_HEADS = 8
IDX_DIM = 64
TOPK_MAX = 256
Q_BLOCK = 128
D_FF = 4 * D_MODEL
EPS = 1e-6
COL_SIZES = (D_SGU, D_SGU,
             N_HEADS * HEAD_DIM,
             N_KV_HEADS * HEAD_DIM,
             N_KV_HEADS * HEAD_DIM,
             IDX_HEADS * IDX_DIM,
             IDX_DIM,
             IDX_HEADS)
D_IN = sum(COL_SIZES)

kernel_name = "hybrid_sgu_dsa_block"


def rms_norm(x, g):
    x32 = x.astype(jnp.float32)
    y = x32 * lax.rsqrt(jnp.mean(x32 * x32, axis=-1, keepdims=True) + EPS)
    return (y * g.astype(jnp.float32)).astype(x.dtype)


def rope_tables(positions):
    inv_freq = ROPE_THETA ** (-jnp.arange(0, ROT_DIM, 2, dtype=jnp.float32) / ROT_DIM)
    ang = positions.astype(jnp.float32)[..., None] * inv_freq
    return jnp.cos(ang), jnp.sin(ang)


def partial_rope(x, cos, sin):
    half = ROT_DIM // 2
    c = cos[:, :, None, :].astype(x.dtype)
    s = sin[:, :, None, :].astype(x.dtype)
    x1, x2, xp = x[..., :half], x[..., half:ROT_DIM], x[..., ROT_DIM:]
    return jnp.concatenate([x1 * c - x2 * s, x2 * c + x1 * s, xp], axis=-1)


def split_cols(p):
    outs, start = [], 0
    for n in COL_SIZES:
        outs.append(p[..., start:start + n])
        start += n
    return outs


def spatial_gating(u, v, g_v, w_s, b_s):
    B, S, _ = u.shape
    v = rms_norm(v.reshape(B, S, SGU_GROUPS, SGU_GROUP_DIM), g_v.reshape(SGU_GROUPS, SGU_GROUP_DIM))
    v = v.reshape(B, S // CHUNK, CHUNK, SGU_GROUPS, SGU_GROUP_DIM)
    causal = jnp.tril(jnp.ones((CHUNK, CHUNK), dtype=w_s.dtype))
    w_m = w_s * causal[None]
    mixed = jnp.einsum('gts,bnsgc->bntgc', w_m, v) + b_s.T[None, None, :, :, None]
    return u * mixed.reshape(B, S, D_SGU)


def dsa_attention(q, k, v, q_idx, k_idx, w_idx):
    B, S = q.shape[0], q.shape[1]
    topk = min(TOPK_MAX, S // 4)
    nb = S // Q_BLOCK
    key_pos = jnp.arange(S)

    def blocks(a):
        return a.reshape((B, nb, Q_BLOCK) + a.shape[2:]).swapaxes(0, 1)

    def one_block(args):
        qb, qib, wb, start = args
        t_pos = start + jnp.arange(Q_BLOCK)
        causal = key_pos[None, :] <= t_pos[:, None]
        dots = jnp.einsum('bthd,bsd->bths', qib, k_idx,
                          preferred_element_type=jnp.float32) * (IDX_DIM ** -0.5)
        score = jnp.einsum('bth,bths->bts', wb.astype(jnp.float32) * (IDX_HEADS ** -0.5),
                           jax.nn.relu(dots))
        score = jnp.where(causal[None], score, -jnp.inf)
        _, idx = lax.top_k(score, topk)
        sel_ok = idx <= t_pos[None, :, None]
        kg = jax.vmap(lambda kb, ib: kb[ib])(k, idx)
        vg = jax.vmap(lambda vb, ib: vb[ib])(v, idx)
        qg = qb.reshape(B, Q_BLOCK, N_KV_HEADS, GQA_GROUP, HEAD_DIM)
        logits = jnp.einsum('btkgd,btjkd->btkgj', qg, kg,
                            preferred_element_type=jnp.float32) * (HEAD_DIM ** -0.5)
        logits = jnp.where(sel_ok[:, :, None, None, :], logits, -jnp.inf)
        p = jax.nn.softmax(logits, axis=-1).astype(v.dtype)
        o = jnp.einsum('btkgj,btjkd->btkgd', p, vg)
        return o.reshape(B, Q_BLOCK, N_HEADS * HEAD_DIM)

    starts = jnp.arange(nb, dtype=jnp.int32) * Q_BLOCK
    out = lax.map(one_block, (blocks(q), blocks(q_idx), blocks(w_idx), starts))
    return out.swapaxes(0, 1).reshape(B, S, N_HEADS * HEAD_DIM)


def setup_inputs(seed: int = 0) -> dict:
    key = jax.random.key(seed)
    ks = jax.random.split(key, 24)
    f32 = jnp.float32
    L, D = DEPTH, D_MODEL

    def nrm(k, shape, scale):
        return jax.random.normal(k, shape, f32) * scale

    def gain(k, shape):
        return 1.0 + 0.02 * jax.random.normal(k, shape, f32)

    x = jax.random.normal(ks[0], (BATCH, SEQ, D), f32)
    c = jax.random.normal(ks[1], (BATCH, D), f32)
    offset = jax.random.randint(ks[2], (BATCH, 1), 0, 1024, dtype=jnp.int32)
    positions = offset + jnp.arange(SEQ, dtype=jnp.int32)[None, :]
    return {
        "x": x,
        "c": c,
        "positions": positions,
        "w_ada": nrm(ks[3], (L, D, 6 * D), D ** -0.5),
        "b_ada": nrm(ks[4], (L, 6 * D), 0.02),
        "g_pre_mix": gain(ks[5], (L, D)),
        "w_in": nrm(ks[6], (L, D, D_IN), D ** -0.5),
        "g_sgu_v": gain(ks[7], (L, D_SGU)),
        "w_spatial": nrm(ks[8], (L, SGU_GROUPS, CHUNK, CHUNK), CHUNK ** -0.5),
        "b_spatial": gain(ks[9], (L, SGU_GROUPS, CHUNK)),
        "g_out_sgu": gain(ks[10], (L, D_SGU)),
        "g_out_attn": gain(ks[11], (L, N_HEADS * HEAD_DIM)),
        "w_out": nrm(ks[12], (L, D_MIX, D), D_MIX ** -0.5),
        "g_post_mix": gain(ks[13], (L, D)),
        "g_pre_ffn": gain(ks[14], (L, D)),
        "w_ff1": nrm(ks[15], (L, D, D_FF), D ** -0.5),
        "w_ff2": nrm(ks[16], (L, D_FF, D), D_FF ** -0.5),
        "g_post_ffn": gain(ks[17], (L, D)),
    }


def reference(x, c, positions, w_ada, b_ada, g_pre_mix, w_in, g_sgu_v, w_spatial, b_spatial,
              g_out_sgu, g_out_attn, w_out, g_post_mix, g_pre_ffn, w_ff1, w_ff2, g_post_ffn):
    B, S, _ = x.shape
    cos, sin = rope_tables(positions)
    c_act = jax.nn.silu(c)
    for l in range(DEPTH):
        mod = jnp.einsum('bd,de->be', c_act, w_ada[l]) + b_ada[l]
        sh1, sc1, g1, sh2, sc2, g2 = jnp.split(mod[:, None, :], 6, axis=-1)

        h = rms_norm(x, g_pre_mix[l]) * (1.0 + sc1) + sh1
        proj = jnp.einsum('bsd,de->bse', h, w_in[l])
        p_u, p_v, p_q, p_k, p_val, p_qi, p_ki, p_wi = split_cols(proj)

        z_u, z_v = jax.nn.gelu(p_u), jax.nn.gelu(p_v)
        y_a = spatial_gating(z_u, z_v, g_sgu_v[l], w_spatial[l], b_spatial[l])

        q = partial_rope(p_q.reshape(B, S, N_HEADS, HEAD_DIM), cos, sin)
        k = partial_rope(p_k.reshape(B, S, N_KV_HEADS, HEAD_DIM), cos, sin)
        v = p_val.reshape(B, S, N_KV_HEADS, HEAD_DIM)
        q_idx = partial_rope(p_qi.reshape(B, S, IDX_HEADS, IDX_DIM), cos, sin)
        k_idx = partial_rope(p_ki.reshape(B, S, 1, IDX_DIM), cos, sin)[:, :, 0, :]
        y_b = dsa_attention(q, k, v, q_idx, k_idx, p_wi)

        merged = jnp.concatenate([rms_norm(y_a, g_out_sgu[l]), rms_norm(y_b, g_out_attn[l])], axis=-1)
        o = jnp.einsum('bse,ed->bsd', merged, w_out[l])
        x = x + g1 * rms_norm(o, g_post_mix[l])

        h2 = rms_norm(x, g_pre_ffn[l]) * (1.0 + sc2) + sh2
        f = jnp.square(jax.nn.relu(jnp.einsum('bsd,df->bsf', h2, w_ff1[l])))
        f = jnp.einsum('bsf,fd->bsd', f, w_ff2[l])
        x = x + g2 * rms_norm(f, g_post_ffn[l])
    return x
```

```cpp
#include <hip/hip_runtime.h>
#include <cstdio>
#include <cstdint>
#define MK_N_LAUNCHES 9
namespace pg8 {
#define PG8_LAS __attribute__((address_space(3)))
typedef unsigned short bf16_t;
typedef short bf16x8 __attribute__((ext_vector_type(8)));
typedef float f32x4 __attribute__((ext_vector_type(4)));
typedef unsigned u32x4 __attribute__((ext_vector_type(4)));
constexpr int BM = 256, BK = 64, HALF = 128, HTB = HALF * BK * 2  , STAGE_BYTES = 8 * HTB, NXCD = 8, WGM = 8;

__host__ __device__ __forceinline__ int lds_byte(int r, int c) { const int st = (r >> 4) * 2 + (c >> 5), rr = r & 15, cc = c & 31, ob = rr * 64 + cc * 2; return st * 1024 + (ob ^ (((ob >> 9) & 1) << 5)); }
__host__ __device__ __forceinline__ void stage_rc(int b, int& R, int& C) { const int st = b / 1024, sb = b % 1024, swz = sb ^ (((sb >> 9) & 1) << 5); R = (st >> 1) * 16 + swz / 64; C = (st & 1) * 32 + (swz % 64) / 2; }
__host__ __device__ __forceinline__ int perm32(int rho) { const int n = rho >> 4, i = rho & 15; return 8 * (i >> 2) + 4 * n + (i & 3); }

struct Unit { int pm, pn; };
struct Gemm { const bf16_t* A; const bf16_t* Bt; int M, N, K; };

struct StaticOrder {
    int nM, nN, nwg, G, c;
    __host__ __device__ void init(int M, int N, int G_, int c_) { nM = M / BM; nN = N / BM; nwg = nM * nN; G = G_; c = c_; }
    __host__ __device__ bool next(int i, Unit& u) const {
        const long L = (long)i * G + c; if (L >= nwg) return false;
        int wgid = (int)L; { const int q = nwg / NXCD, r = nwg % NXCD, xcd = wgid % NXCD, off = wgid / NXCD; wgid = (xcd < r ? xcd * (q + 1) : r * (q + 1) + (xcd - r) * q) + off; }
        const int nig = WGM * nN, gid = wgid / nig, fm = gid * WGM, gsz = (nM - fm) < WGM ? (nM - fm) : WGM;
        u.pm = fm + ((wgid % nig) % gsz); u.pn = (wgid % nig) / gsz; return true;
    }
    __device__ __forceinline__ void a_ready(const Unit&) const {}
    __device__ __forceinline__ void done(const Unit&) const {}
};
__device__ __forceinline__ unsigned cvt_pk_bf16(float lo, float hi) { unsigned r; asm volatile("v_cvt_pk_bf16_f32 %0, %1, %2" : "=v"(r) : "v"(lo), "v"(hi)); return r; }
typedef unsigned u32x2 __attribute__((ext_vector_type(2)));
__device__ __forceinline__ float gelu_tanh(float x) {
    const float u = x * (1.0f + 0.044715f * x * x);
    const float e = __builtin_amdgcn_exp2f(-2.302208198f * u);
    return x * __builtin_amdgcn_rcpf(1.0f + e);
}
__device__ __forceinline__ void store8(bf16_t* p, const f32x4& v0, const f32x4& v1) {
    u32x4 w; w.x = cvt_pk_bf16(v0[0], v0[1]); w.y = cvt_pk_bf16(v0[2], v0[3]); w.z = cvt_pk_bf16(v1[0], v1[1]); w.w = cvt_pk_bf16(v1[2], v1[3]);
    *(u32x4*)p = w;
}
__device__ __forceinline__ void rope8(f32x4& v0, f32x4& v1, const f32x4& c0, const f32x4& c1, const f32x4& s0, const f32x4& s1, int fq) {
    f32x4 p0, p1;
#pragma unroll
    for (int i = 0; i < 4; ++i) { p0[i] = __shfl_xor(v0[i], 16); p1[i] = __shfl_xor(v1[i], 16); }
    const float sg = (fq == 0) ? -1.f : 1.f;
    if (fq < 2) { v0 = v0 * c0 + sg * (p0 * s0); v1 = v1 * c1 + sg * (p1 * s1); }
}
constexpr float QSCALE = 0.18033688011112042f;
constexpr float QISCALE = 0.125f;
constexpr float WISCALE = 0.3535533905932738f;
struct EpiProj {
    static constexpr bool PERM = true, AFTER_DRAIN = false;
    bf16_t *ZU, *ZV, *Q, *K, *VT, *QI, *KI; float* WI; const float* cs; const float* sn;
    __device__ __forceinline__ void operator()(const f32x4 (&acc)[2][2][4][2], const Unit& u, int wr, int wc, int fr, int fq) const {
        const int pn = u.pn; const int row0 = u.pm * BM + wr * 64 + fr; const int cw = wc * 32 + 8 * fq;
        if (pn < 4) {
            bf16_t* base = (pn < 2) ? ZU : ZV; const int colt = (pn & 1) * 256;
#pragma unroll
            for (int ai = 0; ai < 2; ++ai)
#pragma unroll
                for (int m = 0; m < 4; ++m) { const size_t row = (size_t)(row0 + ai * HALF + m * 16);
#pragma unroll
                    for (int bj = 0; bj < 2; ++bj) { f32x4 v0 = acc[ai][bj][m][0], v1 = acc[ai][bj][m][1];
#pragma unroll
                        for (int i = 0; i < 4; ++i) { v0[i] = gelu_tanh(v0[i]); v1[i] = gelu_tanh(v1[i]); }
                        store8(base + row * 512 + colt + bj * HALF + cw, v0, v1); } }
        } else if (pn == 4 || pn == 5 || pn == 7 || pn == 8) {
            const bool isq = pn < 6; bf16_t* base = isq ? Q : QI; const int colt = (isq ? pn - 4 : pn - 7) * 256; const float sc = isq ? QSCALE : QISCALE;
            const bool rope = (wc & 1) == 0;
#pragma unroll
            for (int ai = 0; ai < 2; ++ai)
#pragma unroll
                for (int m = 0; m < 4; ++m) { const size_t row = (size_t)(row0 + ai * HALF + m * 16);
                    f32x4 c0 = {1.f, 1.f, 1.f, 1.f}, c1 = c0, s0 = {0.f, 0.f, 0.f, 0.f}, s1 = s0;
                    if (rope) { c0 = *(const f32x4*)(cs + row * 8); c1 = *(const f32x4*)(cs + row * 8 + 4); s0 = *(const f32x4*)(sn + row * 8); s1 = *(const f32x4*)(sn + row * 8 + 4); }
#pragma unroll
                    for (int bj = 0; bj < 2; ++bj) { f32x4 v0 = acc[ai][bj][m][0], v1 = acc[ai][bj][m][1];
                        if (rope) rope8(v0, v1, c0, c1, s0, s1, fq);
                        v0 = v0 * sc; v1 = v1 * sc;
                        store8(base + row * 512 + colt + bj * HALF + cw, v0, v1); } }
        } else if (pn == 6) {
            const bool rope = (wc & 1) == 0;
#pragma unroll
            for (int ai = 0; ai < 2; ++ai)
#pragma unroll
                for (int m = 0; m < 4; ++m) { const size_t row = (size_t)(row0 + ai * HALF + m * 16);
                    { f32x4 v0 = acc[ai][0][m][0], v1 = acc[ai][0][m][1];
                      if (rope) { const f32x4 c0 = *(const f32x4*)(cs + row * 8), c1 = *(const f32x4*)(cs + row * 8 + 4), s0 = *(const f32x4*)(sn + row * 8), s1 = *(const f32x4*)(sn + row * 8 + 4);
                                  rope8(v0, v1, c0, c1, s0, s1, fq); }
                      store8(K + row * 128 + cw, v0, v1); }
                    { const f32x4 v0 = acc[ai][1][m][0], v1 = acc[ai][1][m][1];
                      const size_t b = row >> 11, s = row & 2047; const int kvh = cw >> 6, d0 = cw & 63;
                      bf16_t* vp = VT + ((b * 2 + kvh) * 64 + d0) * 2048 + s;
                      const unsigned w0 = cvt_pk_bf16(v0[0], v0[1]), w1 = cvt_pk_bf16(v0[2], v0[3]), w2 = cvt_pk_bf16(v1[0], v1[1]), w3 = cvt_pk_bf16(v1[2], v1[3]);
                      vp[0 * 2048] = (bf16_t)(w0 & 0xffffu); vp[1 * 2048] = (bf16_t)(w0 >> 16); vp[2 * 2048] = (bf16_t)(w1 & 0xffffu); vp[3 * 2048] = (bf16_t)(w1 >> 16);
                      vp[4 * 2048] = (bf16_t)(w2 & 0xffffu); vp[5 * 2048] = (bf16_t)(w2 >> 16); vp[6 * 2048] = (bf16_t)(w3 & 0xffffu); vp[7 * 2048] = (bf16_t)(w3 >> 16); } }
        } else {
            if (wc < 2) {
                const bool rope = wc == 0;
#pragma unroll
                for (int ai = 0; ai < 2; ++ai)
#pragma unroll
                    for (int m = 0; m < 4; ++m) { const size_t row = (size_t)(row0 + ai * HALF + m * 16);
                        f32x4 v0 = acc[ai][0][m][0], v1 = acc[ai][0][m][1];
                        if (rope) { const f32x4 c0 = *(const f32x4*)(cs + row * 8), c1 = *(const f32x4*)(cs + row * 8 + 4), s0 = *(const f32x4*)(sn + row * 8), s1 = *(const f32x4*)(sn + row * 8 + 4);
                                    rope8(v0, v1, c0, c1, s0, s1, fq); }
                        store8(KI + row * 64 + cw, v0, v1); }
            } else if (wc == 2 && fq == 0) {
#pragma unroll
                for (int ai = 0; ai < 2; ++ai)
#pragma unroll
                    for (int m = 0; m < 4; ++m) { const size_t row = (size_t)(row0 + ai * HALF + m * 16);
                        *(f32x4*)(WI + row * 8) = acc[ai][0][m][0] * WISCALE; *(f32x4*)(WI + row * 8 + 4) = acc[ai][0][m][1] * WISCALE; }
            }
        }
    }
};
struct EpiRelu2 {
    static constexpr bool PERM = true, AFTER_DRAIN = false;
    bf16_t* O; int ldc;
    __device__ __forceinline__ void operator()(const f32x4 (&acc)[2][2][4][2], const Unit& u, int wr, int wc, int fr, int fq) const {
        const int row0 = u.pm * BM + wr * 64 + fr; const int col0 = u.pn * BM + wc * 32 + 8 * fq;
#pragma unroll
        for (int ai = 0; ai < 2; ++ai)
#pragma unroll
            for (int m = 0; m < 4; ++m) { bf16_t* rowp = O + (size_t)(row0 + ai * HALF + m * 16) * ldc + col0;
#pragma unroll
                for (int bj = 0; bj < 2; ++bj) { f32x4 v0 = acc[ai][bj][m][0], v1 = acc[ai][bj][m][1];
#pragma unroll
                    for (int i = 0; i < 4; ++i) { const float a = fmaxf(v0[i], 0.f), b = fmaxf(v1[i], 0.f); v0[i] = a * a; v1[i] = b * b; }
                    store8(rowp + bj * HALF, v0, v1); } }
    }
};
struct EpiNormPart {
    static constexpr bool PERM = true, AFTER_DRAIN = false;
    bf16_t* O; int ldc; float* part;
    __device__ __forceinline__ void operator()(const f32x4 (&acc)[2][2][4][2], const Unit& u, int wr, int wc, int fr, int fq) const {
        const int row0 = u.pm * BM + wr * 64 + fr; const int col0 = u.pn * BM + wc * 32 + 8 * fq;
#pragma unroll
        for (int ai = 0; ai < 2; ++ai)
#pragma unroll
            for (int m = 0; m < 4; ++m) { const size_t row = (size_t)(row0 + ai * HALF + m * 16); bf16_t* rowp = O + row * ldc + col0; float s = 0.f;
#pragma unroll
                for (int bj = 0; bj < 2; ++bj) { const f32x4 v0 = acc[ai][bj][m][0], v1 = acc[ai][bj][m][1];
                    s += (v0[0] * v0[0] + v0[1] * v0[1]) + (v0[2] * v0[2] + v0[3] * v0[3]) + (v1[0] * v1[0] + v1[1] * v1[1]) + (v1[2] * v1[2] + v1[3] * v1[3]);
                    store8(rowp + bj * HALF, v0, v1); }
                s += __shfl_xor(s, 16); s += __shfl_xor(s, 32);
                if (fq == 0) part[row * 16 + u.pn * 4 + wc] = s; }
    }
};
template <class Epi, class Sched, bool ALIGN_EPI = false, bool SP2 = false>
__device__ __forceinline__ void gemm_phase(PG8_LAS unsigned char* lds, const Gemm g, const Sched& S, const Epi& E) {
    const int tid = threadIdx.x, wid = __builtin_amdgcn_readfirstlane(tid >> 6), lane = tid & 63, wr = wid >> 2, wc = wid & 3, fr = lane & 15, fq = lane >> 4;
    const int K = g.K, nt = K / BK;
    unsigned voffA[2], voffB[2];
#pragma unroll
    for (int i = 0; i < 2; ++i) { int R, C; stage_rc(tid * 16 + i * 8192, R, C); const int Rb = Epi::PERM ? ((R & ~31) + perm32(R & 31)) : R;
        voffA[i] = (unsigned)(R * K + C) * 2u; voffB[i] = (unsigned)(Rb * K + C) * 2u; }
    const size_t kstep = (size_t)(BK * 2);
    const size_t hstep = (size_t)HALF * K * 2;
    const size_t tstep = 2 * hstep;
    const unsigned ldsw = (unsigned)wid * 1024u;
    const int aoff = lds_byte(wr * 64 + fr, fq * 8), boff = lds_byte(wc * 32 + fr, fq * 8);
#define PG8_SA(b, h) (((b) * 2 + (h)) * HTB)
#define PG8_SB(b, h) ((4 + (b) * 2 + (h)) * HTB)
#define PG8_STAGE(bufoff, gbase, voff) do { _Pragma("unroll") for (int _i = 0; _i < 2; ++_i) \
        __builtin_amdgcn_global_load_lds((const unsigned*)((const char*)(gbase) + (voff)[_i]), (PG8_LAS unsigned*)(lds + (bufoff) + ldsw + _i * 8192), 16, 0, 0); } while (0)
#define PG8_LDA(dst, b, h) do { _Pragma("unroll") for (int m = 0; m < 4; ++m) _Pragma("unroll") for (int k = 0; k < 2; ++k) dst[m][k] = *(const PG8_LAS bf16x8*)(lds + PG8_SA(b, h) + aoff + m * 2048 + k * 1024); } while (0)
#define PG8_LDB(dst, b, h) do { _Pragma("unroll") for (int n = 0; n < 2; ++n) _Pragma("unroll") for (int k = 0; k < 2; ++k) dst[n][k] = *(const PG8_LAS bf16x8*)(lds + PG8_SB(b, h) + boff + n * 2048 + k * 1024); } while (0)
#define PG8_MMA(ai, bj, At, Bt) do { __builtin_amdgcn_s_setprio(1); _Pragma("unroll") for (int m = 0; m < 4; ++m) _Pragma("unroll") for (int n = 0; n < 2; ++n) _Pragma("unroll") for (int k = 0; k < 2; ++k) \
        acc[ai][bj][m][n] = __builtin_amdgcn_mfma_f32_16x16x32_bf16(Bt[n][k], At[m][k], acc[ai][bj][m][n], 0, 0, 0); __builtin_amdgcn_s_setprio(0); } while (0)
#define PG8_WAIT_V(n) asm volatile("s_waitcnt vmcnt(" #n ")" ::: "memory")
#define PG8_WAIT_L(n) asm volatile("s_waitcnt lgkmcnt(" #n ")" ::: "memory")
#define PG8_BAR __builtin_amdgcn_s_barrier()
#define PG8_SCHED __builtin_amdgcn_sched_barrier(0)
    Unit cur, nxt; int ui = 0;
    if (!S.next(0, cur)) return;
    f32x4 acc[2][2][4][2];
#pragma unroll
    for (int a = 0; a < 2; ++a)
#pragma unroll
        for (int b = 0; b < 2; ++b)
#pragma unroll
            for (int m = 0; m < 4; ++m)
#pragma unroll
                for (int n = 0; n < 2; ++n) acc[a][b][m][n] = (f32x4){0.f, 0.f, 0.f, 0.f};
    bf16x8 At[4][2], B0[2][2], B1[2][2];
    const char* cA = (const char*)g.A + (size_t)cur.pm * tstep; const char* cB = (const char*)g.Bt + (size_t)cur.pn * tstep;
    S.a_ready(cur);
    if constexpr (SP2) {
        PG8_STAGE(PG8_SB(0, 0), cB, voffB); PG8_STAGE(PG8_SB(0, 1), cB + hstep, voffB); PG8_STAGE(PG8_SA(0, 0), cA, voffA); PG8_STAGE(PG8_SA(0, 1), cA + hstep, voffA);
        if (wr == 1) PG8_BAR;
        PG8_WAIT_V(2); PG8_BAR;
        PG8_STAGE(PG8_SB(1, 0), cB + kstep, voffB); PG8_STAGE(PG8_SA(1, 0), cA + kstep, voffA); PG8_STAGE(PG8_SB(1, 1), cB + hstep + kstep, voffB);
        PG8_WAIT_V(6); PG8_BAR;
    } else {
        PG8_STAGE(PG8_SB(0, 0), cB, voffB); PG8_STAGE(PG8_SA(0, 0), cA, voffA); PG8_STAGE(PG8_SB(0, 1), cB + hstep, voffB); PG8_STAGE(PG8_SA(0, 1), cA + hstep, voffA);
        if (wr == 1) PG8_BAR;
        PG8_WAIT_V(4); PG8_BAR;
        PG8_STAGE(PG8_SB(1, 0), cB + kstep, voffB); PG8_STAGE(PG8_SA(1, 0), cA + kstep, voffA); PG8_STAGE(PG8_SB(1, 1), cB + hstep + kstep, voffB);
        PG8_WAIT_V(6); PG8_BAR;
    }
    for (;;) {
        const bool has_next = S.next(ui + 1, nxt);
        const char* nA = has_next ? (const char*)g.A + (size_t)nxt.pm * tstep : cA; const char* nB = has_next ? (const char*)g.Bt + (size_t)nxt.pn * tstep : cB;
        for (int t = 0; t < nt; t += 2) {
            const bool last = (t == nt - 2);
            const char* a1 = cA + (size_t)(t + 1) * kstep;
            const char* a2 = last ? nA : cA + (size_t)(t + 2) * kstep; const char* b2 = last ? nB : cB + (size_t)(t + 2) * kstep;
            const char* a3 = a2 + kstep; const char* b3 = b2 + kstep;
            if (last && has_next) S.a_ready(nxt);
            if constexpr (SP2) {
            PG8_LDB(B0, 0, 0); PG8_LDB(B1, 0, 1); PG8_SCHED; PG8_LDA(At, 0, 0); PG8_STAGE(PG8_SA(1, 1), a1 + hstep, voffA);
            PG8_WAIT_V(8); PG8_WAIT_L(0); PG8_BAR; PG8_MMA(0, 0, At, B0); PG8_MMA(0, 1, At, B1); PG8_BAR; PG8_SCHED;
            PG8_LDA(At, 0, 1); PG8_STAGE(PG8_SB(0, 0), b2, voffB); PG8_STAGE(PG8_SB(0, 1), b2 + hstep, voffB); PG8_STAGE(PG8_SA(0, 0), a2, voffA);
            PG8_WAIT_V(8); PG8_WAIT_L(0); PG8_BAR; PG8_MMA(1, 0, At, B0); PG8_MMA(1, 1, At, B1); PG8_BAR; PG8_SCHED;
            PG8_LDB(B0, 1, 0); PG8_LDB(B1, 1, 1); PG8_SCHED; PG8_LDA(At, 1, 0); PG8_STAGE(PG8_SA(0, 1), a2 + hstep, voffA);
            PG8_WAIT_V(8); PG8_WAIT_L(0); PG8_BAR; PG8_MMA(0, 0, At, B0); PG8_MMA(0, 1, At, B1); PG8_BAR; PG8_SCHED;
            PG8_LDA(At, 1, 1); PG8_STAGE(PG8_SB(1, 0), b3, voffB); PG8_STAGE(PG8_SB(1, 1), b3 + hstep, voffB); PG8_STAGE(PG8_SA(1, 0), a3, voffA);
            PG8_WAIT_V(8); PG8_WAIT_L(0); PG8_BAR; PG8_MMA(1, 0, At, B0); PG8_MMA(1, 1, At, B1); PG8_BAR; PG8_SCHED;
            } else {
            PG8_LDB(B0, 0, 0); PG8_SCHED; PG8_LDA(At, 0, 0); PG8_STAGE(PG8_SA(1, 1), a1 + hstep, voffA);
            PG8_WAIT_L(8); PG8_BAR; PG8_WAIT_L(0); PG8_MMA(0, 0, At, B0); PG8_BAR; PG8_SCHED;
            PG8_LDB(B1, 0, 1); PG8_STAGE(PG8_SB(0, 0), b2, voffB);
            PG8_BAR; PG8_WAIT_L(0); PG8_MMA(0, 1, At, B1); PG8_BAR;
            PG8_LDA(At, 0, 1); PG8_STAGE(PG8_SA(0, 0), a2, voffA);
            PG8_BAR; PG8_WAIT_L(0); PG8_MMA(1, 0, At, B0); PG8_BAR; PG8_SCHED;
            PG8_STAGE(PG8_SB(0, 1), b2 + hstep, voffB);
            PG8_WAIT_V(6); PG8_BAR; PG8_MMA(1, 1, At, B1); PG8_BAR;
            PG8_LDB(B0, 1, 0); PG8_SCHED; PG8_LDA(At, 1, 0); PG8_STAGE(PG8_SA(0, 1), a2 + hstep, voffA);
            PG8_WAIT_L(8); PG8_BAR; PG8_WAIT_L(0); PG8_MMA(0, 0, At, B0); PG8_BAR; PG8_SCHED;
            PG8_LDB(B1, 1, 1); PG8_STAGE(PG8_SB(1, 0), b3, voffB);
            PG8_BAR; PG8_WAIT_L(0); PG8_MMA(0, 1, At, B1); PG8_BAR;
            PG8_LDA(At, 1, 1); PG8_STAGE(PG8_SA(1, 0), a3, voffA);
            PG8_BAR; PG8_WAIT_L(0); PG8_MMA(1, 0, At, B0); PG8_BAR; PG8_SCHED;
            PG8_STAGE(PG8_SB(1, 1), b3 + hstep, voffB);
            PG8_WAIT_V(6); PG8_BAR; PG8_MMA(1, 1, At, B1); PG8_BAR;
            }
        }
        if constexpr (ALIGN_EPI) { if (wr == 0) PG8_BAR; }
        if constexpr (!Epi::AFTER_DRAIN) { E(acc, cur, wr, wc, fr, fq); S.done(cur); }
        if (!has_next) break;
#pragma unroll
        for (int a = 0; a < 2; ++a)
#pragma unroll
            for (int b = 0; b < 2; ++b)
#pragma unroll
                for (int m = 0; m < 4; ++m)
#pragma unroll
                    for (int n = 0; n < 2; ++n) acc[a][b][m][n] = (f32x4){0.f, 0.f, 0.f, 0.f};
        cur = nxt; cA = nA; cB = nB; ++ui;
        if constexpr (ALIGN_EPI) { if (wr == 1) PG8_BAR; }
    }
    PG8_WAIT_V(0);
    if constexpr (!ALIGN_EPI) { if (wr == 0) PG8_BAR; }
    PG8_BAR;
    if constexpr (Epi::AFTER_DRAIN) { E.fused(acc, cur, wr, wc, fr, fq, lds, wid, lane); S.done(cur); }
#undef PG8_SA
#undef PG8_SB
#undef PG8_STAGE
#undef PG8_LDA
#undef PG8_LDB
#undef PG8_MMA
#undef PG8_WAIT_V
#undef PG8_WAIT_L
#undef PG8_BAR
#undef PG8_SCHED
}
}
#define PG8_SP2 true
#define PG8_ALIGN true
#define GAS __attribute__((address_space(1)))
#define LAS __attribute__((address_space(3)))
typedef unsigned short bf16;
typedef unsigned v4u __attribute__((ext_vector_type(4)));
typedef float f32x4 __attribute__((ext_vector_type(4)));
typedef short bf16x8 __attribute__((ext_vector_type(8)));
typedef GAS unsigned gu32;
typedef GAS unsigned long long gu64;
#define RLX_AGENT __ATOMIC_RELAXED, __HIP_MEMORY_SCOPE_AGENT
#define LDS_WAIT() asm volatile("s_waitcnt lgkmcnt(0)" ::: "memory")
#define VM_WAIT() asm volatile("s_waitcnt vmcnt(0)" ::: "memory")
__device__ __forceinline__ unsigned long long rt() { return __builtin_amdgcn_s_memrealtime(); }
__device__ __forceinline__ unsigned f2bf(float f) { unsigned u = __builtin_bit_cast(unsigned, f); return (u + 0x7fffu + ((u >> 16) & 1u)) >> 16; }
__device__ __forceinline__ unsigned pk2(float lo, float hi) { return f2bf(lo) | (f2bf(hi) << 16); }

#define XB_TMO      128
#define XB_XCNT(j)  (256  + 64 * (j))
#define XB_XSUB(j)  (1280 + 64 * (j))
#define XB_XGEN(j)  (2304 + 64 * (j))
#define XB_TOP      3328
#define XB_TOPGEN   3392
#define XCD_BAR_WORDS 3456
#define XB_SPIN_CAP (1u << 18)

__device__ __forceinline__ unsigned xb_ld(unsigned* p)              { return __hip_atomic_load(p, __ATOMIC_RELAXED, __HIP_MEMORY_SCOPE_AGENT); }
__device__ __forceinline__ unsigned xb_add(unsigned* p, unsigned v) { return __hip_atomic_fetch_add(p, v, __ATOMIC_RELAXED, __HIP_MEMORY_SCOPE_AGENT); }
__device__ __forceinline__ unsigned xb_xcc_id() { return (unsigned)__builtin_amdgcn_s_getreg((3 << 11) | 20) & 0xFu; }
#define XB_SPIN(cond, bar) do { unsigned _sp = 0; while (cond) { __builtin_amdgcn_s_sleep(1); \
    if ((++_sp & 255u) == 0u) { if (xb_ld(&(bar)[XB_TMO])) break; if (_sp > XB_SPIN_CAP) { atomicAdd(&(bar)[XB_TMO], 1u); break; } } } } while (0)

struct XcdBarrier {
    unsigned* bar; unsigned x;
    volatile LAS unsigned* st;
};

__device__ __forceinline__ XcdBarrier xcd_barrier_post(unsigned* bar, volatile LAS unsigned* st) {
    XcdBarrier b; b.bar = bar; b.x = xb_xcc_id(); b.st = st;
    if (threadIdx.x == 0) (void)xb_add(&bar[XB_XCNT(b.x)], 1u);
    return b;
}
__device__ __forceinline__ void xcd_barrier_complete(unsigned* bar, unsigned x, unsigned& nloc, unsigned& nx) {
    const unsigned G = gridDim.x * gridDim.y * gridDim.z;
    unsigned sum, cnt, mine, sp = 0u;
    for (;;) {
        sum = 0u; cnt = 0u; mine = 0u;
#pragma unroll
        for (unsigned j = 0; j < 16; ++j) { const unsigned c = xb_ld(&bar[XB_XCNT(j)]); sum += c; cnt += (c > 0u) ? 1u : 0u; mine = (j == x) ? c : mine; }
        if (sum == G) break;
        __builtin_amdgcn_s_sleep(1);
        if ((++sp & 255u) == 0u) { if (xb_ld(&bar[XB_TMO])) break; if (sp > XB_SPIN_CAP) { atomicAdd(&bar[XB_TMO], 1u); break; } }
    }
    nloc = mine > 0u ? mine : 1u; nx = cnt > 0u ? cnt : 1u;
}

__device__ __forceinline__ void xcd_barrier(const XcdBarrier& b) {
    asm volatile("s_waitcnt vmcnt(0)" ::: "memory");
    __syncthreads();
    if (threadIdx.x == 0) {
        unsigned* bar = b.bar;
        __builtin_amdgcn_s_waitcnt(0);
        unsigned nloc = b.st[0], nx = b.st[1];
        if (nloc == 0u) { xcd_barrier_complete(bar, b.x, nloc, nx); b.st[0] = nloc; b.st[1] = nx; }
        const unsigned old = xb_add(&bar[XB_XSUB(b.x)], 1u);
        const unsigned gen = old / nloc;
        if (old + 1u == (gen + 1u) * nloc) {
            __builtin_amdgcn_fence(__ATOMIC_RELEASE, "agent");
            asm volatile("s_waitcnt vmcnt(0)" ::: "memory");
            const unsigned og = xb_add(&bar[XB_TOP], 1u);
            const unsigned tg = og / nx;
            if (og + 1u == (tg + 1u) * nx) xb_add(&bar[XB_TOPGEN], 1u);
            else XB_SPIN(xb_ld(&bar[XB_TOPGEN]) == tg, bar);
            __builtin_amdgcn_fence(__ATOMIC_ACQUIRE, "agent");
            xb_add(&bar[XB_XGEN(b.x)], 1u);
            asm volatile("s_waitcnt vmcnt(0)" ::: "memory");
        } else {
            XB_SPIN(xb_ld(&bar[XB_XGEN(b.x)]) == gen, bar);
            __builtin_amdgcn_fence(__ATOMIC_ACQUIRE, "agent");
            asm volatile("s_waitcnt vmcnt(0)" ::: "memory");
        }
    }
    __syncthreads();
}
#ifndef MK_N_LAUNCHES
#define MK_N_LAUNCHES 1
#endif
constexpr int NWAVES = 8;
constexpr int N_PHASES = 9;
constexpr int BATCH = 32, SEQ = 2048, D = 1024, M = BATCH * SEQ, DIN = 2376, DINP = 2560, FF = 4096, DSGU = 512;
constexpr float EPS = 1e-6f;
constexpr size_t MiB = 1u << 20;
constexpr size_t WS_CTL = 0, CTL_ZERO_BYTES = 1 * MiB;
constexpr size_t WS_MOD = 1 * MiB;
constexpr size_t WS_COS = 2 * MiB, WS_SIN = 4 * MiB;
constexpr size_t WS_WM = 6 * MiB;
constexpr size_t WS_PART = 7 * MiB;
constexpr size_t WS_WIN = 12 * MiB, WS_WOUT = 17 * MiB, WS_W1 = 19 * MiB, WS_W2 = 27 * MiB;
constexpr size_t WS_WI = 36 * MiB;
constexpr size_t WS_H = 40 * MiB;
constexpr size_t WS_BIG = 168 * MiB;
constexpr size_t WS_ZU = WS_BIG, WS_ZV = WS_BIG + 64 * MiB, WS_Q = WS_BIG + 128 * MiB, WS_K = WS_BIG + 192 * MiB, WS_VT = WS_BIG + 208 * MiB,
                 WS_QI = WS_BIG + 224 * MiB, WS_KI = WS_BIG + 288 * MiB, WS_MERGED = WS_BIG + 296 * MiB;
constexpr size_t WS_O = WS_BIG;
constexpr size_t WS_HB = WS_BIG;
constexpr size_t WS_SCR = WS_BIG + 512 * MiB;
constexpr size_t WS_F = WS_SCR;
constexpr size_t WS_END = WS_SCR + 256 * MiB;
constexpr size_t SCR_PER_WG = 1 * MiB, SCR_SC = 0, SCR_MK = 512 * 1024, SCR_YB = 768 * 1024;
constexpr int CW_BAR = 4096;
constexpr int RING_OFF = 0, RING_BYTES = 131072;
constexpr int LDSCTL_OFF = RING_BYTES, MISC_OFF = LDSCTL_OFF + 320, AUX_OFF = LDSCTL_OFF + 1024;
constexpr int LDS_BYTES = 147456;

typedef float f32x16 __attribute__((ext_vector_type(16)));
typedef float f32x2 __attribute__((ext_vector_type(2)));
typedef unsigned u32x2 __attribute__((ext_vector_type(2)));
#define MFMA32(a, b, c) __builtin_amdgcn_mfma_f32_32x32x16_bf16((a), (b), (c), 0, 0, 0)

struct Frame {
    LAS unsigned char* lds;
    volatile LAS unsigned* MISC;
    gu32* ctl;
    int tid, lane, wave, vcu, G;
    const float *x, *c; const int* pos; const float *w_ada, *b_ada, *g_pre_mix, *w_in, *g_sgu_v, *w_spatial, *b_spatial, *g_out_sgu, *g_out_attn, *w_out, *g_post_mix, *g_pre_ffn, *w_ff1, *w_ff2, *g_post_ffn;
    float* out;
    float *MOD, *COS, *SIN, *PART, *WI;
    bf16 *WM, *WIN, *WOUT, *W1, *W2, *H, *ZU, *ZV, *Q, *K, *VT, *QI, *KI, *MERGED, *O, *HB, *FB;
    unsigned char* scr;
};
__device__ __forceinline__ float bflo(unsigned u) { return __builtin_bit_cast(float, u << 16); }
__device__ __forceinline__ float bfhi(unsigned u) { return __builtin_bit_cast(float, u & 0xffff0000u); }
__device__ __forceinline__ unsigned pkbf(float lo, float hi) { return pg8::cvt_pk_bf16(lo, hi); }
__device__ __forceinline__ float wave_sum(float v) {
#pragma unroll
    for (int o = 1; o < 64; o <<= 1) v += __shfl_xor(v, o);
    return v;
}
__device__ __forceinline__ void block_sync_mem() {
    asm volatile("s_waitcnt vmcnt(0)" ::: "memory");
    __syncthreads();
    if (threadIdx.x == 0) { __builtin_amdgcn_fence(__ATOMIC_ACQUIRE, "agent"); asm volatile("s_waitcnt vmcnt(0)" ::: "memory"); }
    __syncthreads();
}

__device__ __forceinline__ void p0_transpose_item(const float* W, int K, int N, int Npad, bf16* WT, LAS float* scr, int item, int lane) {
    const int nblk = Npad / 32, kb = item / nblk, nb = item % nblk, k0 = 64 * kb, n0 = 32 * nb;
    const int nn = n0 + (lane & 31);
#pragma unroll 8
    for (int i = 0; i < 32; ++i) { const int kk = 2 * i + (lane >> 5); scr[kk * 33 + (lane & 31)] = (nn < N) ? W[(size_t)(k0 + kk) * N + nn] : 0.f; }
    LDS_WAIT(); asm volatile("" ::: "memory");
    const int c = lane & 7;
#pragma unroll
    for (int j = 0; j < 4; ++j) { const int n = (lane >> 3) + 8 * j; const LAS float* s = scr + (8 * c) * 33 + n;
        v4u o; o.x = pk2(s[0 * 33], s[1 * 33]); o.y = pk2(s[2 * 33], s[3 * 33]); o.z = pk2(s[4 * 33], s[5 * 33]); o.w = pk2(s[6 * 33], s[7 * 33]);
        *(GAS v4u*)(WT + (size_t)(n0 + n) * K + k0 + 8 * c) = o; }
    LDS_WAIT(); asm volatile("" ::: "memory");
}
__device__ __forceinline__ void p0_mod_unit(Frame& F, int u) {
    const int lane = F.lane, w = F.wave, tid = F.tid;
    LAS float* csl = (LAS float*)F.lds + w * 4096;
#pragma unroll 4
    for (int i = 0; i < 64; ++i) { const int idx = i * 64 + lane, b = idx >> 7, d = idx & 127; const float cv = F.c[b * D + 128 * w + d];
        csl[d * 32 + b] = cv / (1.0f + __expf(-cv)); }
    LDS_WAIT(); asm volatile("" ::: "memory");
    float acc[32];
#pragma unroll
    for (int b = 0; b < 32; ++b) acc[b] = 0.f;
    const float* wp = F.w_ada + (size_t)(128 * w) * 6144 + 64 * u + lane;
#pragma unroll 2
    for (int d = 0; d < 128; ++d) { const float wv = wp[(size_t)d * 6144];
#pragma unroll
        for (int b4 = 0; b4 < 8; ++b4) { const f32x4 cc = *(const LAS f32x4*)(csl + d * 32 + 4 * b4);
            acc[4 * b4 + 0] += cc[0] * wv; acc[4 * b4 + 1] += cc[1] * wv; acc[4 * b4 + 2] += cc[2] * wv; acc[4 * b4 + 3] += cc[3] * wv; } }
    __syncthreads();
    LAS float* red = (LAS float*)F.lds;
#pragma unroll
    for (int b = 0; b < 32; ++b) red[(w * 32 + b) * 64 + lane] = acc[b];
    __syncthreads();
#pragma unroll
    for (int k = 0; k < 4; ++k) { const int o = tid + 512 * k, b = o >> 6, col = o & 63; float s = 0.f;
#pragma unroll
        for (int ww = 0; ww < 8; ++ww) s += red[(ww * 32 + b) * 64 + col];
        F.MOD[b * 6144 + 64 * u + col] = s + F.b_ada[64 * u + col]; }
    __syncthreads();
}
__device__ __forceinline__ void p0_prologue(Frame& F) {
    for (int u = F.vcu; u < 96; u += F.G) p0_mod_unit(F, u);
    LAS float* scr = (LAS float*)(F.lds + RING_OFF + F.wave * 16384);
    const int gw = F.vcu * NWAVES + F.wave, NGW = F.G * NWAVES;
    constexpr int I_IN = (D / 64) * (DINP / 32), I_OUT = (D / 64) * (D / 32), I_1 = (D / 64) * (FF / 32), I_2 = (FF / 64) * (D / 32);
    constexpr int NITEMS = I_IN + I_OUT + I_1 + I_2;
    for (int it = gw; it < NITEMS; it += NGW) {
        int r = it;
        if (r < I_IN) { p0_transpose_item(F.w_in, D, DIN, DINP, F.WIN, scr, r, F.lane); continue; } r -= I_IN;
        if (r < I_OUT) { p0_transpose_item(F.w_out, D, D, D, F.WOUT, scr, r, F.lane); continue; } r -= I_OUT;
        if (r < I_1) { p0_transpose_item(F.w_ff1, D, FF, FF, F.W1, scr, r, F.lane); continue; } r -= I_1;
        p0_transpose_item(F.w_ff2, FF, D, D, F.W2, scr, r, F.lane);
    }
    const int gt = F.vcu * NWAVES * 64 + F.tid, NT = F.G * NWAVES * 64;
    for (int i = gt; i < 4 * 128 * 128; i += NT) { const int t = (i >> 7) & 127, s = i & 127; F.WM[i] = (bf16)f2bf(s <= t ? F.w_spatial[i] : 0.f); }
    for (int i = gt; i < M * 8; i += NT) { const int m = i >> 3, j = i & 7;
        const double rpp = (j == 0) ? 0.15915494309189535 : (j == 1) ? 0.03086376340470123 : (j == 2) ? 0.005985185712713705 : (j == 3) ? 0.001160663641240061 :
                           (j == 4) ? 0.00022507907903927653 : (j == 5) ? 4.364795279280289e-05 : (j == 6) ? 8.464330808241401e-06 : 1.6414262627950345e-06;
        const double rev = (double)F.pos[m] * rpp; const float fr = (float)(rev - __builtin_floor(rev));
        F.COS[i] = __builtin_amdgcn_cosf(fr); F.SIN[i] = __builtin_amdgcn_sinf(fr); }
}
__device__ __forceinline__ void p1_hprep(Frame& F) {
    const int gw = F.vcu * NWAVES + F.wave, NGW = F.G * NWAVES, lane = F.lane;
    for (int chunk = gw; chunk < M / 32; chunk += NGW) {
        const int b = (chunk * 32) / SEQ; const float* mod = F.MOD + b * 6144;
        f32x4 ga[4], sh[4];
#pragma unroll
        for (int j = 0; j < 4; ++j) { const int c = 4 * lane + 256 * j; const f32x4 g = *(const f32x4*)(F.g_pre_mix + c), sc = *(const f32x4*)(mod + 1024 + c); ga[j] = g * (sc + 1.0f); sh[j] = *(const f32x4*)(mod + c); }
        for (int r = 0; r < 32; ++r) { const size_t m = (size_t)chunk * 32 + r;
            const GAS f32x4* xr = (const GAS f32x4*)(F.x + m * D) + lane; f32x4 v[4]; float s = 0.f;
#pragma unroll
            for (int j = 0; j < 4; ++j) { v[j] = xr[64 * j]; s += (v[j].x * v[j].x + v[j].y * v[j].y) + (v[j].z * v[j].z + v[j].w * v[j].w); }
            const float rstd = rsqrtf(wave_sum(s) * (1.f / D) + EPS);
            GAS u32x2* o8 = (GAS u32x2*)(F.H + m * D) + lane;
#pragma unroll
            for (int j = 0; j < 4; ++j) { const f32x4 o = v[j] * rstd * ga[j] + sh[j]; u32x2 w; w.x = pkbf(o.x, o.y); w.y = pkbf(o.z, o.w); o8[64 * j] = w; } }
    }
}
__device__ __forceinline__ void p5_postmix(Frame& F) {
    const int gw = F.vcu * NWAVES + F.wave, NGW = F.G * NWAVES, lane = F.lane;
    for (int chunk = gw; chunk < M / 32; chunk += NGW) {
        const int b = (chunk * 32) / SEQ; const float* mod = F.MOD + b * 6144;
        f32x4 g1[4], ga[4], sh[4];
#pragma unroll
        for (int j = 0; j < 4; ++j) { const int c = 4 * lane + 256 * j;
            g1[j] = *(const f32x4*)(mod + 2048 + c) * *(const f32x4*)(F.g_post_mix + c);
            ga[j] = *(const f32x4*)(F.g_pre_ffn + c) * (*(const f32x4*)(mod + 4096 + c) + 1.0f); sh[j] = *(const f32x4*)(mod + 3072 + c); }
        for (int r = 0; r < 32; ++r) { const size_t m = (size_t)chunk * 32 + r;
            float ps = F.PART[m * 16 + (lane & 15)]; ps += __shfl_xor(ps, 1); ps += __shfl_xor(ps, 2); ps += __shfl_xor(ps, 4); ps += __shfl_xor(ps, 8);
            const float rstd_o = rsqrtf(ps * (1.f / D) + EPS);
            const GAS f32x4* xr = (const GAS f32x4*)(F.x + m * D) + lane; const GAS u32x2* orow = (const GAS u32x2*)(F.O + m * D) + lane;
            GAS f32x4* outr = (GAS f32x4*)(F.out + m * D) + lane;
            f32x4 v[4]; float s = 0.f;
#pragma unroll
            for (int j = 0; j < 4; ++j) { const u32x2 ow = orow[64 * j]; const f32x4 ov = {bflo(ow.x), bfhi(ow.x), bflo(ow.y), bfhi(ow.y)};
                v[j] = xr[64 * j] + g1[j] * (ov * rstd_o); outr[64 * j] = v[j];
                s += (v[j].x * v[j].x + v[j].y * v[j].y) + (v[j].z * v[j].z + v[j].w * v[j].w); }
            const float rstd = rsqrtf(wave_sum(s) * (1.f / D) + EPS);
            GAS u32x2* o8 = (GAS u32x2*)(F.H + m * D) + lane;
#pragma unroll
            for (int j = 0; j < 4; ++j) { const f32x4 o = v[j] * rstd * ga[j] + sh[j]; u32x2 w; w.x = pkbf(o.x, o.y); w.y = pkbf(o.z, o.w); o8[64 * j] = w; } }
    }
}
__device__ __forceinline__ void p8_final(Frame& F) {
    const int gw = F.vcu * NWAVES + F.wave, NGW = F.G * NWAVES, lane = F.lane;
    for (int chunk = gw; chunk < M / 32; chunk += NGW) {
        const int b = (chunk * 32) / SEQ; const float* mod = F.MOD + b * 6144;
        f32x4 g2[4];
#pragma unroll
        for (int j = 0; j < 4; ++j) { const int c = 4 * lane + 256 * j; g2[j] = *(const f32x4*)(mod + 5120 + c) * *(const f32x4*)(F.g_post_ffn + c); }
        for (int r = 0; r < 32; ++r) { const size_t m = (size_t)chunk * 32 + r;
            float ps = F.PART[m * 16 + (lane & 15)]; ps += __shfl_xor(ps, 1); ps += __shfl_xor(ps, 2); ps += __shfl_xor(ps, 4); ps += __shfl_xor(ps, 8);
            const float rstd_f = rsqrtf(ps * (1.f / D) + EPS);
            const GAS u32x2* frow = (const GAS u32x2*)(F.FB + m * D) + lane; GAS f32x4* outr = (GAS f32x4*)(F.out + m * D) + lane;
#pragma unroll
            for (int j = 0; j < 4; ++j) { const u32x2 fw = frow[64 * j]; const f32x4 fv = {bflo(fw.x), bfhi(fw.x), bflo(fw.y), bfhi(fw.y)};
                outr[64 * j] = outr[64 * j] + g2[j] * (fv * rstd_f); } }
    }
}
__device__ __forceinline__ void sgu_unit(Frame& F, int b, int n) {
    const int tid = F.tid, lane = F.lane, w = F.wave;
    const size_t R0 = (size_t)b * SEQ + (size_t)n * 128;
    LAS bf16* vn = (LAS bf16*)F.lds;
    LAS float* rpart = (LAS float*)(F.lds + AUX_OFF);
    {
        f32x4 gv0 = *(const f32x4*)(F.g_sgu_v + 8 * lane), gv1 = *(const f32x4*)(F.g_sgu_v + 8 * lane + 4);
#pragma unroll 4
        for (int i = 0; i < 16; ++i) { const int s = 16 * w + i;
            const v4u raw = *(const GAS v4u*)(F.ZV + (R0 + s) * DSGU + 8 * lane);
            f32x4 a = {bflo(raw.x), bfhi(raw.x), bflo(raw.y), bfhi(raw.y)}, c = {bflo(raw.z), bfhi(raw.z), bflo(raw.w), bfhi(raw.w)};
            float ss = (a.x * a.x + a.y * a.y) + (a.z * a.z + a.w * a.w) + (c.x * c.x + c.y * c.y) + (c.z * c.z + c.w * c.w);
            ss += __shfl_xor(ss, 1); ss += __shfl_xor(ss, 2); ss += __shfl_xor(ss, 4); ss += __shfl_xor(ss, 8);
            const float rstd = rsqrtf(ss * (1.f / 128.f) + EPS);
            a = a * rstd * gv0; c = c * rstd * gv1;
            v4u o; o.x = pkbf(a.x, a.y); o.y = pkbf(a.z, a.w); o.z = pkbf(c.x, c.y); o.w = pkbf(c.z, c.w);
            *(LAS v4u*)(vn + s * DSGU + 8 * lane) = o; }
    }
    __syncthreads();
    const int tt = w & 3, ch = w >> 2, tl = lane & 31, h = lane >> 5;
    const int t = tt * 32 + tl;
    f32x16 acc[8];
#pragma unroll
    for (int i = 0; i < 8; ++i)
#pragma unroll
        for (int r = 0; r < 16; ++r) acc[i][r] = 0.f;
    const int kmax = 2 * (tt + 1);
#pragma unroll
    for (int gi = 0; gi < 2; ++gi) { const int g = 2 * ch + gi;
        const bf16* bp = F.WM + ((size_t)(g * 128 + t)) * 128 + 8 * h;
#pragma unroll
        for (int ct = 0; ct < 4; ++ct) { const LAS bf16* colp = vn + g * 128 + ct * 32 + tl + 8 * h * DSGU;
            f32x16 a = acc[gi * 4 + ct];
#pragma unroll 2
            for (int kk = 0; kk < kmax; ++kk) {
                const LAS bf16* p = colp + kk * 16 * DSGU;
                const unsigned e0 = p[0], e1 = p[DSGU], e2 = p[2 * DSGU], e3 = p[3 * DSGU], e4 = p[4 * DSGU], e5 = p[5 * DSGU], e6 = p[6 * DSGU], e7 = p[7 * DSGU];
                v4u pk; pk.x = e0 | (e1 << 16); pk.y = e2 | (e3 << 16); pk.z = e4 | (e5 << 16); pk.w = e6 | (e7 << 16);
                const bf16x8 Bf = *(const GAS bf16x8*)(bp + kk * 16);
                a = MFMA32(__builtin_bit_cast(bf16x8, pk), Bf, a); }
            acc[gi * 4 + ct] = a; }
    }
    float ssq = 0.f;
#pragma unroll
    for (int gi = 0; gi < 2; ++gi) { const int g = 2 * ch + gi; const float bias = F.b_spatial[g * 128 + t];
#pragma unroll
        for (int ct = 0; ct < 4; ++ct)
#pragma unroll
            for (int qd = 0; qd < 4; ++qd) { const int c0 = g * 128 + ct * 32 + 8 * qd + 4 * h;
                const u32x2 zu = *(const GAS u32x2*)(F.ZU + (R0 + t) * DSGU + c0);
                const float u0 = bflo(zu.x), u1 = bfhi(zu.x), u2 = bflo(zu.y), u3 = bfhi(zu.y);
                float v0 = (acc[gi * 4 + ct][4 * qd + 0] + bias) * u0, v1 = (acc[gi * 4 + ct][4 * qd + 1] + bias) * u1, v2 = (acc[gi * 4 + ct][4 * qd + 2] + bias) * u2, v3 = (acc[gi * 4 + ct][4 * qd + 3] + bias) * u3;
                acc[gi * 4 + ct][4 * qd + 0] = v0; acc[gi * 4 + ct][4 * qd + 1] = v1; acc[gi * 4 + ct][4 * qd + 2] = v2; acc[gi * 4 + ct][4 * qd + 3] = v3;
                ssq += (v0 * v0 + v1 * v1) + (v2 * v2 + v3 * v3); } }
    ssq += __shfl_xor(ssq, 32);
    if (h == 0) rpart[ch * 128 + t] = ssq;
    __syncthreads();
    const float rstd = rsqrtf((rpart[t] + rpart[128 + t]) * (1.f / 512.f) + EPS);
#pragma unroll
    for (int gi = 0; gi < 2; ++gi) { const int g = 2 * ch + gi;
#pragma unroll
        for (int ct = 0; ct < 4; ++ct)
#pragma unroll
            for (int qd = 0; qd < 4; ++qd) { const int c0 = g * 128 + ct * 32 + 8 * qd + 4 * h;
                const f32x4 go = *(const f32x4*)(F.g_out_sgu + c0);
                u32x2 o; o.x = pkbf(acc[gi * 4 + ct][4 * qd + 0] * rstd * go.x, acc[gi * 4 + ct][4 * qd + 1] * rstd * go.y);
                o.y = pkbf(acc[gi * 4 + ct][4 * qd + 2] * rstd * go.z, acc[gi * 4 + ct][4 * qd + 3] * rstd * go.w);
                *(GAS u32x2*)(F.MERGED + (R0 + t) * D + c0) = o; } }
    __syncthreads();
}
__device__ __forceinline__ unsigned okey(unsigned x) { return (x & 0x8000u) ? (x ^ 0xffffu) : (x | 0x8000u); }
__device__ __forceinline__ void radix_scan(const v4u c, unsigned kk, int lane, unsigned& bin_out, unsigned& rem_out) {
    const unsigned T = c.x + c.y + c.z + c.w; unsigned S = T;
#pragma unroll
    for (int off = 1; off < 64; off <<= 1) { const unsigned v = __shfl_down(S, off); if (lane + off < 64) S += v; }
    const unsigned above = S - T; const bool found = (S >= kk) && (above < kk);
    unsigned bin, rem, cum = above;
    if (cum + c.w >= kk) { bin = 3; rem = kk - cum; } else { cum += c.w;
        if (cum + c.z >= kk) { bin = 2; rem = kk - cum; } else { cum += c.z;
            if (cum + c.y >= kk) { bin = 1; rem = kk - cum; } else { cum += c.y; bin = 0; rem = kk - cum; } } }
    bin += 4 * lane;
    const unsigned long long bm = __ballot(found); const int src = bm ? (__ffsll((long long)bm) - 1) : 0;
    bin_out = __shfl(bin, src); rem_out = __shfl(rem, src);
}
__device__ __forceinline__ void dsa_unit(Frame& F, int b, int qb) {
    const int lane = F.lane, w = F.wave;
    bf16* SC = (bf16*)(F.scr + SCR_SC); unsigned* MK = (unsigned*)(F.scr + SCR_MK); bf16* YB = (bf16*)(F.scr + SCR_YB);
    const int g = w & 3, kh = w >> 2, q = lane & 31, h = lane >> 5;
    const int t0 = 128 * qb + 32 * g;
    const size_t rowq = (size_t)b * SEQ + t0 + q;
    const int ntile = 4 * qb + g + 1;
#ifndef NO_PASSA
    if (qb >= 2) {
#pragma unroll 4
        for (int i = 0; i < 16; ++i) { const int idx = i * 512 + F.tid, row = idx >> 6, c = idx & 63;
            const v4u v = *(const GAS v4u*)(F.QI + ((size_t)b * SEQ + 128 * qb + row) * 512 + c * 8);
            *(LAS v4u*)(F.lds + row * 1024 + ((c ^ (row & 15)) << 4)) = v; }
        __syncthreads();
        const int qrow = 32 * g + q; const int lx = h ^ (qrow & 15);
        unsigned offs[8];
#pragma unroll
        for (int c8 = 0; c8 < 8; ++c8) offs[c8] = (unsigned)(qrow * 1024 + (((2 * c8) ^ lx) << 4));
        const f32x4 w0 = *(const f32x4*)(F.WI + rowq * 8), w1 = *(const f32x4*)(F.WI + rowq * 8 + 4);
        const float wv[8] = {w0.x, w0.y, w0.z, w0.w, w1.x, w1.y, w1.z, w1.w};
#pragma unroll 1
        for (int j = kh; j < ntile; j += 2) {
            asm volatile("" ::: "memory");
            const size_t rowk = (size_t)b * SEQ + 32 * j + q;
            bf16x8 kf[4];
#pragma unroll
            for (int kk = 0; kk < 4; ++kk) kf[kk] = *(const GAS bf16x8*)(F.KI + rowk * 64 + kk * 16 + 8 * h);
            f32x16 sc;
#pragma unroll
            for (int r = 0; r < 16; ++r) sc[r] = 0.f;
#pragma unroll
            for (int hd = 0; hd < 8; ++hd) { f32x16 d;
#pragma unroll
                for (int r = 0; r < 16; ++r) d[r] = 0.f;
#pragma unroll
                for (int kk = 0; kk < 4; ++kk) { const bf16x8 qf = *(const LAS bf16x8*)(F.lds + offs[(hd & 1) * 4 + kk] + 256 * (hd >> 1)); d = MFMA32(kf[kk], qf, d); }
#pragma unroll
                for (int r = 0; r < 16; ++r) { const float dv = d[r]; const int di = __float_as_int(dv); const float rl = __int_as_float(di & ~(di >> 31)); sc[r] = __builtin_fmaf(wv[hd], rl, sc[r]); } }
#pragma unroll
            for (int qd = 0; qd < 4; ++qd) { u32x2 o;
                o.x = __builtin_bit_cast(unsigned, __builtin_amdgcn_cvt_pkrtz(sc[4 * qd + 0], sc[4 * qd + 1]));
                o.y = __builtin_bit_cast(unsigned, __builtin_amdgcn_cvt_pkrtz(sc[4 * qd + 2], sc[4 * qd + 3]));
                *(GAS u32x2*)(SC + (size_t)(32 * g + q) * 2048 + 32 * j + 8 * qd + 4 * h) = o; }
        }
    }
#endif
    block_sync_mem();
#ifndef NO_PASSB
    {
        LAS unsigned* hist = (LAS unsigned*)F.lds + w * 256;
        for (int i = 0; i < 16; ++i) { const int ql = 16 * w + i; const int t = 128 * qb + ql;
            const int lo = 32 * lane;
            const unsigned causal = (t >= lo + 31) ? 0xffffffffu : (t < lo ? 0u : ((2u << (t - lo)) - 1u));
            unsigned word = causal;
            if (qb >= 2) {
                const GAS v4u* rp = (const GAS v4u*)(SC + (size_t)ql * 2048 + 32 * lane);
                unsigned key[32];
#pragma unroll
                for (int k = 0; k < 4; ++k) { const v4u raw = rp[k];
#pragma unroll
                    for (int c = 0; c < 4; ++c) { const unsigned dd = raw[c]; const int idx = 8 * k + 2 * c;
                        key[idx] = ((causal >> idx) & 1u) ? okey(dd & 0xffffu) : 0u; key[idx + 1] = ((causal >> (idx + 1)) & 1u) ? okey(dd >> 16) : 0u; } }
                *(LAS v4u*)(hist + 4 * lane) = (v4u){0u, 0u, 0u, 0u};
                asm volatile("s_waitcnt lgkmcnt(0)" ::: "memory");
#pragma unroll
                for (int k = 0; k < 32; ++k) __hip_atomic_fetch_add((unsigned*)(hist + (key[k] >> 8)), 1u, __ATOMIC_RELAXED, __HIP_MEMORY_SCOPE_WORKGROUP);
                asm volatile("s_waitcnt lgkmcnt(0)" ::: "memory");
                v4u cnt = *(const LAS v4u*)(hist + 4 * lane);
                unsigned b1, r1; radix_scan(cnt, 256u, lane, b1, r1);
                asm volatile("s_waitcnt lgkmcnt(0)" ::: "memory");
                *(LAS v4u*)(hist + 4 * lane) = (v4u){0u, 0u, 0u, 0u};
                asm volatile("s_waitcnt lgkmcnt(0)" ::: "memory");
#pragma unroll
                for (int k = 0; k < 32; ++k) { if ((key[k] >> 8) == b1) __hip_atomic_fetch_add((unsigned*)(hist + (key[k] & 255u)), 1u, __ATOMIC_RELAXED, __HIP_MEMORY_SCOPE_WORKGROUP); }
                asm volatile("s_waitcnt lgkmcnt(0)" ::: "memory");
                cnt = *(const LAS v4u*)(hist + 4 * lane);
                unsigned b2, r2; radix_scan(cnt, r1, lane, b2, r2);
                asm volatile("s_waitcnt lgkmcnt(0)" ::: "memory");
                const unsigned thr = (b1 << 8) | b2;
                unsigned sel = 0u;
#pragma unroll
                for (int k = 0; k < 32; ++k) sel |= (key[k] >= thr ? 1u : 0u) << k;
                word = sel & causal;
            }
            MK[ql * 64 + lane] = word;
        }
    }
#endif
    block_sync_mem();
#ifndef NO_PASSC
#pragma unroll 1
    for (int hh = 0; hh < 4; ++hh) {
        const int hA = 4 * kh + hh;
        bf16x8 qa[4];
#pragma unroll
        for (int kk = 0; kk < 4; ++kk) qa[kk] = *(const GAS bf16x8*)(F.Q + rowq * 512 + hA * 64 + kk * 16 + 8 * h);
        f32x16 oA0, oA1;
#pragma unroll
        for (int r = 0; r < 16; ++r) { oA0[r] = 0.f; oA1[r] = 0.f; }
        float mA = -1e30f, lA = 0.f;
#pragma unroll 1
        for (int j = 0; j < ntile; ++j) {
            asm volatile("" ::: "memory");
            const size_t rowk = (size_t)b * SEQ + 32 * j + q;
            bf16x8 kf[4];
#pragma unroll
            for (int kk = 0; kk < 4; ++kk) kf[kk] = *(const GAS bf16x8*)(F.K + rowk * 128 + kh * 64 + kk * 16 + 8 * h);
            const unsigned mwh = MK[(32 * g + q) * 64 + j] >> (4 * h);
            bf16x8 vt[2][2];
#pragma unroll
            for (int dt = 0; dt < 2; ++dt)
#pragma unroll
                for (int sp = 0; sp < 2; ++sp) { const bf16* vp = F.VT + ((size_t)(b * 2 + kh) * 64 + dt * 32 + q) * 2048 + 32 * j + 16 * sp + 4 * h;
                    const u32x2 lo = *(const GAS u32x2*)vp, hi = *(const GAS u32x2*)(vp + 8);
                    vt[dt][sp] = __builtin_bit_cast(bf16x8, ((v4u){lo.x, lo.y, hi.x, hi.y})); }
            f32x16 sA;
#pragma unroll
            for (int r = 0; r < 16; ++r) sA[r] = 0.f;
#pragma unroll
            for (int kk = 0; kk < 4; ++kk) sA = MFMA32(kf[kk], qa[kk], sA);
            float mx = -INFINITY;
#pragma unroll
            for (int r = 0; r < 16; ++r) { const bool on = (mwh >> ((r & 3) + 8 * (r >> 2))) & 1u; sA[r] = on ? sA[r] : -INFINITY; mx = fmaxf(mx, sA[r]); }
            mx = fmaxf(mx, __shfl_xor(mx, 32));
            const float mn = fmaxf(mA, mx); const float al = __builtin_amdgcn_exp2f(mA - mn); mA = mn; float ls = 0.f;
#pragma unroll
            for (int r = 0; r < 16; ++r) { sA[r] = __builtin_amdgcn_exp2f(sA[r] - mn); ls += sA[r]; }
            lA = lA * al + ls;
#pragma unroll
            for (int r = 0; r < 16; ++r) { oA0[r] *= al; oA1[r] *= al; }
            v4u pk; pk.x = pkbf(sA[0], sA[1]); pk.y = pkbf(sA[2], sA[3]); pk.z = pkbf(sA[4], sA[5]); pk.w = pkbf(sA[6], sA[7]); const bf16x8 pA0 = __builtin_bit_cast(bf16x8, pk);
            pk.x = pkbf(sA[8], sA[9]); pk.y = pkbf(sA[10], sA[11]); pk.z = pkbf(sA[12], sA[13]); pk.w = pkbf(sA[14], sA[15]); const bf16x8 pA1 = __builtin_bit_cast(bf16x8, pk);
            oA0 = MFMA32(vt[0][0], pA0, oA0); oA0 = MFMA32(vt[0][1], pA1, oA0); oA1 = MFMA32(vt[1][0], pA0, oA1); oA1 = MFMA32(vt[1][1], pA1, oA1);
        }
        lA += __shfl_xor(lA, 32);
        const float iA = 1.0f / lA;
        bf16* yrow = YB + (size_t)(32 * g + q) * 512 + hA * 64 + 4 * h;
#pragma unroll
        for (int qd = 0; qd < 4; ++qd) { u32x2 o;
            o.x = pkbf(oA0[4 * qd] * iA, oA0[4 * qd + 1] * iA); o.y = pkbf(oA0[4 * qd + 2] * iA, oA0[4 * qd + 3] * iA); *(GAS u32x2*)(yrow + 8 * qd) = o;
            o.x = pkbf(oA1[4 * qd] * iA, oA1[4 * qd + 1] * iA); o.y = pkbf(oA1[4 * qd + 2] * iA, oA1[4 * qd + 3] * iA); *(GAS u32x2*)(yrow + 32 + 8 * qd) = o; }
    }
#endif
    block_sync_mem();
    {
        const f32x4 go0 = *(const f32x4*)(F.g_out_attn + 8 * lane), go1 = *(const f32x4*)(F.g_out_attn + 8 * lane + 4);
        for (int i = 0; i < 16; ++i) { const int ql = 16 * w + i; const size_t row = (size_t)b * SEQ + 128 * qb + ql;
            const v4u raw = *(const GAS v4u*)(YB + (size_t)ql * 512 + 8 * lane);
            f32x4 a = {bflo(raw.x), bfhi(raw.x), bflo(raw.y), bfhi(raw.y)}, c = {bflo(raw.z), bfhi(raw.z), bflo(raw.w), bfhi(raw.w)};
            const float ss = wave_sum((a.x * a.x + a.y * a.y) + (a.z * a.z + a.w * a.w) + (c.x * c.x + c.y * c.y) + (c.z * c.z + c.w * c.w));
            const float rstd = rsqrtf(ss * (1.f / 512.f) + EPS);
            a = a * rstd * go0; c = c * rstd * go1;
            v4u o; o.x = pkbf(a.x, a.y); o.y = pkbf(a.z, a.w); o.z = pkbf(c.x, c.y); o.w = pkbf(c.z, c.w);
            *(GAS v4u*)(F.MERGED + row * D + 512 + 8 * lane) = o; }
    }
    block_sync_mem();
}

struct Args { const void* in[18]; float* out; unsigned char* ws; int ph_lo, ph_hi; };
__global__ void __launch_bounds__(NWAVES * 64, 2) fwd_kernel(Args args) {
    extern __shared__ __attribute__((aligned(16))) unsigned char lds[];
    Frame F;
    F.lds = (LAS unsigned char*)lds;
    F.MISC = (volatile LAS unsigned*)(F.lds + MISC_OFF);
    F.tid = threadIdx.x; F.lane = F.tid & 63; F.wave = __builtin_amdgcn_readfirstlane(F.tid >> 6);
    F.G = gridDim.x; { const int bx = blockIdx.x; F.vcu = (F.G % 8 == 0) ? (bx % 8) * (F.G / 8) + bx / 8 : bx; }
    unsigned char* ws = args.ws;
    F.ctl = (gu32*)(ws + WS_CTL);
    F.x = (const float*)args.in[0]; F.c = (const float*)args.in[1]; F.pos = (const int*)args.in[2]; F.w_ada = (const float*)args.in[3]; F.b_ada = (const float*)args.in[4];
    F.g_pre_mix = (const float*)args.in[5]; F.w_in = (const float*)args.in[6]; F.g_sgu_v = (const float*)args.in[7]; F.w_spatial = (const float*)args.in[8]; F.b_spatial = (const float*)args.in[9];
    F.g_out_sgu = (const float*)args.in[10]; F.g_out_attn = (const float*)args.in[11]; F.w_out = (const float*)args.in[12]; F.g_post_mix = (const float*)args.in[13]; F.g_pre_ffn = (const float*)args.in[14];
    F.w_ff1 = (const float*)args.in[15]; F.w_ff2 = (const float*)args.in[16]; F.g_post_ffn = (const float*)args.in[17];
    F.out = args.out;
    F.MOD = (float*)(ws + WS_MOD); F.COS = (float*)(ws + WS_COS); F.SIN = (float*)(ws + WS_SIN); F.PART = (float*)(ws + WS_PART); F.WI = (float*)(ws + WS_WI);
    F.WM = (bf16*)(ws + WS_WM); F.WIN = (bf16*)(ws + WS_WIN); F.WOUT = (bf16*)(ws + WS_WOUT); F.W1 = (bf16*)(ws + WS_W1); F.W2 = (bf16*)(ws + WS_W2);
    F.H = (bf16*)(ws + WS_H); F.ZU = (bf16*)(ws + WS_ZU); F.ZV = (bf16*)(ws + WS_ZV); F.Q = (bf16*)(ws + WS_Q); F.K = (bf16*)(ws + WS_K); F.VT = (bf16*)(ws + WS_VT);
    F.QI = (bf16*)(ws + WS_QI); F.KI = (bf16*)(ws + WS_KI); F.MERGED = (bf16*)(ws + WS_MERGED); F.O = (bf16*)(ws + WS_O); F.HB = (bf16*)(ws + WS_HB); F.FB = (bf16*)(ws + WS_F);
    F.scr = ws + WS_SCR + (size_t)blockIdx.x * SCR_PER_WG;
    for (int u = F.tid; u < (LDS_BYTES - LDSCTL_OFF) / 4; u += NWAVES * 64) ((LAS unsigned*)(F.lds + LDSCTL_OFF))[u] = 0u;
    __syncthreads();
    const int lo = args.ph_lo, hi = args.ph_hi;
    const bool fusedrun = (hi - lo) > 1;
    XcdBarrier bar; bar.bar = (unsigned*)(F.ctl + CW_BAR); bar.x = 0; bar.st = nullptr;
    if (fusedrun) bar = xcd_barrier_post((unsigned*)(F.ctl + CW_BAR), F.MISC + 8);
#define IN(k) (lo <= (k) && (k) < hi)
#ifdef ONLY_PHASE
#define PHASE_ON(k) ((k) == ONLY_PHASE)
#else
#define PHASE_ON(k) true
#endif
#define SEAM(k) do { if (IN(k) && IN((k) + 1)) xcd_barrier(bar); } while (0)

    if (PHASE_ON(0) && IN(0)) { p0_prologue(F); SEAM(0); }
    if (PHASE_ON(1) && IN(1)) { p1_hprep(F); SEAM(1); }
    if (PHASE_ON(2) && IN(2)) {
        pg8::Gemm g{F.H, F.WIN, M, DINP, D}; pg8::StaticOrder S; S.init(M, DINP, F.G, (int)blockIdx.x);
        pg8::EpiProj E{F.ZU, F.ZV, F.Q, F.K, F.VT, F.QI, F.KI, F.WI, F.COS, F.SIN};
        pg8::gemm_phase<pg8::EpiProj, pg8::StaticOrder, PG8_ALIGN, PG8_SP2>(F.lds + RING_OFF, g, S, E);
        SEAM(2);
    }
    if (PHASE_ON(3) && IN(3)) {
#ifndef NO_SGU
        for (int u = F.vcu; u < BATCH * 16; u += F.G) sgu_unit(F, u >> 4, u & 15);
#endif
        for (int u = F.vcu; u < BATCH * 8; u += F.G) { const int b = u >> 3, p = u & 7;
#pragma unroll 1
            for (int k = 0; k < 2; ++k) dsa_unit(F, b, k ? p : 15 - p); }
        SEAM(3);
    }
    if (PHASE_ON(4) && IN(4)) {
        pg8::Gemm g{F.MERGED, F.WOUT, M, D, D}; pg8::StaticOrder S; S.init(M, D, F.G, (int)blockIdx.x);
        pg8::EpiNormPart E{F.O, D, F.PART};
        pg8::gemm_phase<pg8::EpiNormPart, pg8::StaticOrder, PG8_ALIGN, PG8_SP2>(F.lds + RING_OFF, g, S, E);
        SEAM(4);
    }
    if (PHASE_ON(5) && IN(5)) { p5_postmix(F); SEAM(5); }
    if (PHASE_ON(6) && IN(6)) {
        pg8::Gemm g{F.H, F.W1, M, FF, D}; pg8::StaticOrder S; S.init(M, FF, F.G, (int)blockIdx.x);
        pg8::EpiRelu2 E{F.HB, FF};
        pg8::gemm_phase<pg8::EpiRelu2, pg8::StaticOrder, PG8_ALIGN, PG8_SP2>(F.lds + RING_OFF, g, S, E);
        SEAM(6);
    }
    if (PHASE_ON(7) && IN(7)) {
        pg8::Gemm g{F.HB, F.W2, M, D, FF}; pg8::StaticOrder S; S.init(M, D, F.G, (int)blockIdx.x);
        pg8::EpiNormPart E{F.FB, D, F.PART};
        pg8::gemm_phase<pg8::EpiNormPart, pg8::StaticOrder, PG8_ALIGN, PG8_SP2>(F.lds + RING_OFF, g, S, E);
        SEAM(7);
    }
    if (PHASE_ON(8) && IN(8)) { p8_final(F);
#ifdef DIAG
        {
            asm volatile("s_waitcnt vmcnt(0)" ::: "memory"); __syncthreads();
            float code = 0.f;
#pragma unroll
            for (int k = 0; k < 4; ++k) { const float e = __builtin_bit_cast(float, __hip_atomic_load(F.ctl + 8192 + DIAG_SET * 4 + k, __ATOMIC_RELAXED, __HIP_MEMORY_SCOPE_AGENT)); if (e > DIAG_TOL) code += 0.25f * (float)(1 << k); }
            const int gw = F.vcu * NWAVES + F.wave, NGW = F.G * NWAVES;
            for (int chunk = gw; chunk < M / 32; chunk += NGW) for (int r = 0; r < 32; ++r) { GAS f32x4* outr = (GAS f32x4*)(F.out + ((size_t)chunk * 32 + r) * D) + F.lane;
#pragma unroll
                for (int j = 0; j < 4; ++j) outr[64 * j] = outr[64 * j] * (1.0f + code); }
        }
#endif
    }
#undef IN
#undef SEAM
}


#ifdef DIAG
constexpr int CW_DIAG = 8192;
__device__ __forceinline__ void diag_max(gu32* ctl, int k, float err) { if (!(err == err)) err = 1e30f; atomicMax((unsigned*)(ctl + CW_DIAG + k), __builtin_bit_cast(unsigned, err)); }
__device__ __forceinline__ float relerr(float got, float want, float floor_) { return __builtin_fabsf(got - want) / (__builtin_fabsf(want) + floor_); }
__device__ __forceinline__ float bf2f(bf16 v) { return __builtin_bit_cast(float, (unsigned)v << 16); }
__device__ __forceinline__ float h2f(unsigned short v) { return (float)__builtin_bit_cast(_Float16, v); }
__device__ __forceinline__ float wave_max(float v) {
#pragma unroll
    for (int o = 1; o < 64; o <<= 1) v = fmaxf(v, __shfl_xor(v, o));
    return v;
}
__device__ __forceinline__ float gelu_ref(float p) { return p / (1.0f + __expf(-1.5957691216057308f * (p + 0.044715f * p * p * p))); }
__global__ void __launch_bounds__(512) diag_kernel(Args args) {
    __shared__ float pr[8][2400];
    unsigned char* ws = args.ws; gu32* ctl = (gu32*)(ws + WS_CTL);
    const float* x = (const float*)args.in[0]; const float* cc_ = (const float*)args.in[1]; const float* w_ada = (const float*)args.in[3]; const float* b_ada = (const float*)args.in[4];
    const float* g_pre_mix = (const float*)args.in[5]; const float* g_sgu_v = (const float*)args.in[7]; const float* b_spatial = (const float*)args.in[9]; const float* g_out_sgu = (const float*)args.in[10];
    const float* MOD = (const float*)(ws + WS_MOD); const float* COS = (const float*)(ws + WS_COS); const float* SIN = (const float*)(ws + WS_SIN); const float* WI = (const float*)(ws + WS_WI);
    const bf16 *WM = (const bf16*)(ws + WS_WM), *WIN = (const bf16*)(ws + WS_WIN), *H = (const bf16*)(ws + WS_H), *ZU = (const bf16*)(ws + WS_ZU), *ZV = (const bf16*)(ws + WS_ZV), *Q = (const bf16*)(ws + WS_Q), *K = (const bf16*)(ws + WS_K),
               *VT = (const bf16*)(ws + WS_VT), *QI = (const bf16*)(ws + WS_QI), *KI = (const bf16*)(ws + WS_KI), *MERGED = (const bf16*)(ws + WS_MERGED);
    const int tid = threadIdx.x, lane = tid & 63, w = tid >> 6, G = gridDim.x; const int bx = blockIdx.x, vcu = (G % 8 == 0) ? (bx % 8) * (G / 8) + bx / 8 : bx; const int gw = vcu * 8 + w;
    {
        const size_t m = ((size_t)gw * 97 + 13) % M; const size_t b = m >> 11, s = m & 2047;
#pragma unroll 1
        for (int i = 0; i < 38; ++i) { const int col = lane + 64 * i; float acc = 0.f;
            if (col < DIN) {
#pragma unroll 4
                for (int k = 0; k < D; ++k) acc += bf2f(H[m * D + k]) * bf2f(WIN[(size_t)col * D + k]);
                pr[w][col] = acc; } }
        __syncthreads();
#pragma unroll 1
        for (int i = 0; i < 38; ++i) { const int col = lane + 64 * i; if (col >= DIN) break;
            const float p = pr[w][col];
            if (col < 1024) { const float got = bf2f(col < 512 ? ZU[m * 512 + col] : ZV[m * 512 + col - 512]); diag_max(ctl, 4, relerr(got, gelu_ref(p), 0.05f)); }
            else if (col < 1664) { const bool isq = col < 1536; const int cc = isq ? col - 1024 : col - 1536; const int d = cc & 63; float v = p;
                if (d < 8) v = p * COS[m * 8 + d] - pr[w][col + 8] * SIN[m * 8 + d]; else if (d < 16) v = p * COS[m * 8 + d - 8] + pr[w][col - 8] * SIN[m * 8 + d - 8];
                if (isq) v *= 0.18033688011112042f;
                const float got = bf2f(isq ? Q[m * 512 + cc] : K[m * 128 + cc]); diag_max(ctl, 5, relerr(got, v, 0.05f)); }
            else if (col < 1792) { const int cc = col - 1664, kvh = cc >> 6, d = cc & 63; const float got = bf2f(VT[((b * 2 + kvh) * 64 + d) * 2048 + s]); diag_max(ctl, 6, relerr(got, p, 0.05f)); }
            else if (col < 2368) { const bool isq = col < 2304; const int cc = isq ? col - 1792 : col - 2304; const int d = cc & 63; float v = p;
                if (d < 8) v = p * COS[m * 8 + d] - pr[w][col + 8] * SIN[m * 8 + d]; else if (d < 16) v = p * COS[m * 8 + d - 8] + pr[w][col - 8] * SIN[m * 8 + d - 8];
                if (isq) v *= 0.125f;
                const float got = bf2f(isq ? QI[m * 512 + cc] : KI[m * 64 + cc]); diag_max(ctl, 5, relerr(got, v, 0.05f)); }
            else { const float got = WI[m * 8 + col - 2368]; diag_max(ctl, 6, relerr(got, p * 0.3535533905932738f, 0.05f)); } }
        { const int bb = gw & 31, e = (gw * 131 + 7) % 6144; float acc = 0.f;
          for (int k = lane; k < D; k += 64) { const float cv = cc_[bb * D + k]; acc += cv / (1.0f + __expf(-cv)) * w_ada[(size_t)k * 6144 + e]; }
          acc = wave_sum(acc) + b_ada[e]; diag_max(ctl, 7, relerr(MOD[bb * 6144 + e], acc, 0.02f)); }
        { float ss = 0.f; for (int k = lane; k < D; k += 64) { const float xv = x[m * D + k]; ss += xv * xv; }
          const float rstd = rsqrtf(wave_sum(ss) / D + EPS); const int k = (lane * 17 + 3) & 1023; const float* mod = MOD + b * 6144;
          const float want = x[m * D + k] * rstd * g_pre_mix[k] * (1.f + mod[1024 + k]) + mod[k]; diag_max(ctl, 7, relerr(bf2f(H[m * D + k]), want, 0.02f)); }
    }
    {
        const size_t m = ((size_t)gw * 61 + 29) % M; const size_t R0 = m & ~(size_t)127; const int tc = (int)(m & 127);
        float ssq = 0.f;
#pragma unroll 1
        for (int pass = 0; pass < 2; ++pass) { const float rs = rsqrtf(wave_sum(ssq) * (1.f / 512.f) + EPS);
#pragma unroll 1
            for (int e = 0; e < 8; ++e) { const int c = 8 * lane + e, g = c >> 7; float mix = 0.f;
#pragma unroll 1
                for (int s2 = 0; s2 <= tc; ++s2) {
                    float gs = 0.f; for (int k = 0; k < 128; ++k) { const float zv = bf2f(ZV[(R0 + s2) * 512 + g * 128 + k]); gs += zv * zv; }
                    const float vnv = bf2f((bf16)f2bf(bf2f(ZV[(R0 + s2) * 512 + c]) * rsqrtf(gs * (1.f / 128.f) + EPS) * g_sgu_v[c]));
                    mix += bf2f(WM[(g * 128 + tc) * 128 + s2]) * vnv; }
                const float yv = (mix + b_spatial[g * 128 + tc]) * bf2f(ZU[(R0 + tc) * 512 + c]);
                if (pass == 0) ssq += yv * yv; else diag_max(ctl, 3, relerr(bf2f(MERGED[(R0 + tc) * D + c]), yv * rs * g_out_sgu[c], 0.05f)); } }
    }
    if (vcu < 256) {
        const int b = vcu >> 3, qb = vcu & 7;
        const unsigned char* scr = ws + WS_SCR + (size_t)blockIdx.x * SCR_PER_WG;
        const unsigned short* SC = (const unsigned short*)(scr + SCR_SC); const unsigned* MK = (const unsigned*)(scr + SCR_MK); const bf16* YB = (const bf16*)(scr + SCR_YB);
#pragma unroll 1
        for (int i = 0; i < 16; ++i) { const int ql = 16 * w + i, t = 128 * qb + ql; int pc = __builtin_popcount(MK[ql * 64 + lane]);
#pragma unroll
            for (int o = 1; o < 64; o <<= 1) pc += __shfl_xor(pc, o);
            const int want = (t + 1 < 256) ? t + 1 : 256; if (pc < want || pc > want + 16) diag_max(ctl, 0, 1.0f + (float)(pc > want ? pc - want : want - pc)); }
        if (qb >= 2) { const int ql = 16 * w + 5, t = 128 * qb + ql; const size_t row = (size_t)b * SEQ + t; const int s2 = (lane * 37 + w * 11) % (t + 1); const size_t krow = (size_t)b * SEQ + s2;
            float sc2 = 0.f;
#pragma unroll 1
            for (int hd = 0; hd < 8; ++hd) { float d = 0.f; for (int dd = 0; dd < 64; ++dd) d += bf2f(QI[row * 512 + hd * 64 + dd]) * bf2f(KI[krow * 64 + dd]); sc2 += WI[row * 8 + hd] * fmaxf(d, 0.f); }
            diag_max(ctl, 1, relerr(h2f(SC[(size_t)ql * 2048 + s2]), sc2, 0.05f));
            float mins = INFINITY, maxu = -INFINITY;
#pragma unroll 1
            for (int s3 = lane; s3 <= t; s3 += 64) { const float v = h2f(SC[(size_t)ql * 2048 + s3]); if ((MK[ql * 64 + (s3 >> 5)] >> (s3 & 31)) & 1u) mins = fminf(mins, v); else maxu = fmaxf(maxu, v); }
            mins = -wave_max(-mins); maxu = wave_max(maxu); if (maxu > mins) diag_max(ctl, 0, 100.0f); }
        { const int ql = 16 * w + 9, t = 128 * qb + ql, hd = w, kvh = hd >> 2; const size_t row = (size_t)b * SEQ + t;
          const float qd = bf2f(Q[row * 512 + hd * 64 + lane]); float mrun = -1e30f, lrun = 0.f, o = 0.f;
#pragma unroll 1
          for (int s2 = 0; s2 <= t; ++s2) { if (!((MK[ql * 64 + (s2 >> 5)] >> (s2 & 31)) & 1u)) continue;
              const float lg = wave_sum(qd * bf2f(K[((size_t)b * SEQ + s2) * 128 + kvh * 64 + lane]));
              const float mn = fmaxf(mrun, lg), al = __builtin_amdgcn_exp2f(mrun - mn), p = __builtin_amdgcn_exp2f(lg - mn);
              lrun = lrun * al + p; o = o * al + p * bf2f(VT[((size_t)(b * 2 + kvh) * 64 + lane) * 2048 + s2]); mrun = mn; }
          diag_max(ctl, 2, relerr(bf2f(YB[(size_t)ql * 512 + hd * 64 + lane]), o / lrun, 0.02f)); }
    }
}
#endif

extern "C" void kernel_launch(void* const* d_in, const int* in_sizes, int n_in, void* d_out, int out_size, void* d_ws, size_t ws_size, hipStream_t stream) {
    static int grid = 0;
    if (grid == 0) {
        if (n_in != 18 || in_sizes[0] != M * D || out_size != M * D || ws_size < WS_END) { fprintf(stderr, "kernel_launch: unexpected problem shape or workspace (n_in %d, ws %zu < %zu)\n", n_in, ws_size, (size_t)WS_END); grid = -1; return; }
        int dev = 0, cus = 0, per_cu = 0;
        if (hipGetDevice(&dev) != hipSuccess || hipDeviceGetAttribute(&cus, hipDeviceAttributeMultiprocessorCount, dev) != hipSuccess) { grid = -1; return; }
        if (hipFuncSetAttribute((const void*)fwd_kernel, hipFuncAttributeMaxDynamicSharedMemorySize, LDS_BYTES) != hipSuccess) { grid = -1; return; }
        if (hipOccupancyMaxActiveBlocksPerMultiprocessor(&per_cu, (const void*)fwd_kernel, NWAVES * 64, LDS_BYTES) != hipSuccess || per_cu < 1) { fprintf(stderr, "kernel_launch: occupancy query reports %d workgroups per CU\n", per_cu); }
        (void)hipGetLastError();
        grid = cus;
    }
    if (grid < 0) return;
    if (hipMemsetAsync((char*)d_ws + WS_CTL, 0, CTL_ZERO_BYTES, stream) != hipSuccess) return;
    Args a{};
    for (int i = 0; i < 18; ++i) a.in[i] = d_in[i];
    a.out = (float*)d_out; a.ws = (unsigned char*)d_ws;
#if MK_N_LAUNCHES == 1
    a.ph_lo = 0; a.ph_hi = N_PHASES;
    hipLaunchKernelGGL(fwd_kernel, dim3(grid), dim3(NWAVES * 64), LDS_BYTES, stream, a);
#else
    for (int li = 0; li < N_PHASES; ++li) { a.ph_lo = li; a.ph_hi = li + 1; hipLaunchKernelGGL(fwd_kernel, dim3(grid), dim3(NWAVES * 64), LDS_BYTES, stream, a);
#ifdef DIAG
        if (li == 3) hipLaunchKernelGGL(diag_kernel, dim3(grid), dim3(512), 0, stream, a);
#endif
    }
#endif
}
```

```cpp
#include <hip/hip_runtime.h>
#include <cstdio>
#include <cstdint>
#define MK_N_LAUNCHES 1
namespace pg8 {
#define PG8_LAS __attribute__((address_space(3)))
typedef unsigned short bf16_t;
typedef short bf16x8 __attribute__((ext_vector_type(8)));
typedef float f32x4 __attribute__((ext_vector_type(4)));
typedef unsigned u32x4 __attribute__((ext_vector_type(4)));
constexpr int BM = 256, BK = 64, HALF = 128, HTB = HALF * BK * 2  , STAGE_BYTES = 8 * HTB, NXCD = 8, WGM = 8;

__host__ __device__ __forceinline__ int lds_byte(int r, int c) { const int st = (r >> 4) * 2 + (c >> 5), rr = r & 15, cc = c & 31, ob = rr * 64 + cc * 2; return st * 1024 + (ob ^ (((ob >> 9) & 1) << 5)); }
__host__ __device__ __forceinline__ void stage_rc(int b, int& R, int& C) { const int st = b / 1024, sb = b % 1024, swz = sb ^ (((sb >> 9) & 1) << 5); R = (st >> 1) * 16 + swz / 64; C = (st & 1) * 32 + (swz % 64) / 2; }
__host__ __device__ __forceinline__ int perm32(int rho) { const int n = rho >> 4, i = rho & 15; return 8 * (i >> 2) + 4 * n + (i & 3); }

struct Unit { int pm, pn; };
struct Gemm { const bf16_t* A; const bf16_t* Bt; int M, N, K; };

struct StaticOrder {
    int nM, nN, nwg, G, c;
    __host__ __device__ void init(int M, int N, int G_, int c_) { nM = M / BM; nN = N / BM; nwg = nM * nN; G = G_; c = c_; }
    __host__ __device__ bool next(int i, Unit& u) const {
        const long L = (long)i * G + c; if (L >= nwg) return false;
        int wgid = (int)L; { const int q = nwg / NXCD, r = nwg % NXCD, xcd = wgid % NXCD, off = wgid / NXCD; wgid = (xcd < r ? xcd * (q + 1) : r * (q + 1) + (xcd - r) * q) + off; }
        const int nig = WGM * nN, gid = wgid / nig, fm = gid * WGM, gsz = (nM - fm) < WGM ? (nM - fm) : WGM;
        u.pm = fm + ((wgid % nig) % gsz); u.pn = (wgid % nig) / gsz; return true;
    }
    __device__ __forceinline__ void a_ready(const Unit&) const {}
    __device__ __forceinline__ void done(const Unit&) const {}
};
__device__ __forceinline__ unsigned cvt_pk_bf16(float lo, float hi) { unsigned r; asm volatile("v_cvt_pk_bf16_f32 %0, %1, %2" : "=v"(r) : "v"(lo), "v"(hi)); return r; }
typedef unsigned u32x2 __attribute__((ext_vector_type(2)));
__device__ __forceinline__ float gelu_tanh(float x) {
    const float u = x * (1.0f + 0.044715f * x * x);
    const float e = __builtin_amdgcn_exp2f(-2.302208198f * u);
    return x * __builtin_amdgcn_rcpf(1.0f + e);
}
__device__ __forceinline__ void store8(bf16_t* p, const f32x4& v0, const f32x4& v1) {
    u32x4 w; w.x = cvt_pk_bf16(v0[0], v0[1]); w.y = cvt_pk_bf16(v0[2], v0[3]); w.z = cvt_pk_bf16(v1[0], v1[1]); w.w = cvt_pk_bf16(v1[2], v1[3]);
    *(u32x4*)p = w;
}
__device__ __forceinline__ void rope8(f32x4& v0, f32x4& v1, const f32x4& c0, const f32x4& c1, const f32x4& s0, const f32x4& s1, int fq) {
    f32x4 p0, p1;
#pragma unroll
    for (int i = 0; i < 4; ++i) { p0[i] = __shfl_xor(v0[i], 16); p1[i] = __shfl_xor(v1[i], 16); }
    const float sg = (fq == 0) ? -1.f : 1.f;
    if (fq < 2) { v0 = v0 * c0 + sg * (p0 * s0); v1 = v1 * c1 + sg * (p1 * s1); }
}
constexpr float QSCALE = 0.18033688011112042f;
constexpr float QISCALE = 0.125f;
constexpr float WISCALE = 0.3535533905932738f;
struct EpiProj {
    static constexpr bool PERM = true, AFTER_DRAIN = false;
    bf16_t *ZU, *ZV, *Q, *K, *VT, *QI, *KI; float* WI; const float* cs; const float* sn;
    __device__ __forceinline__ void operator()(const f32x4 (&acc)[2][2][4][2], const Unit& u, int wr, int wc, int fr, int fq) const {
        const int pn = u.pn; const int row0 = u.pm * BM + wr * 64 + fr; const int cw = wc * 32 + 8 * fq;
        if (pn < 4) {
            bf16_t* base = (pn < 2) ? ZU : ZV; const int colt = (pn & 1) * 256;
#pragma unroll
            for (int ai = 0; ai < 2; ++ai)
#pragma unroll
                for (int m = 0; m < 4; ++m) { const size_t row = (size_t)(row0 + ai * HALF + m * 16);
#pragma unroll
                    for (int bj = 0; bj < 2; ++bj) { f32x4 v0 = acc[ai][bj][m][0], v1 = acc[ai][bj][m][1];
#pragma unroll
                        for (int i = 0; i < 4; ++i) { v0[i] = gelu_tanh(v0[i]); v1[i] = gelu_tanh(v1[i]); }
                        store8(base + row * 512 + colt + bj * HALF + cw, v0, v1); } }
        } else if (pn == 4 || pn == 5 || pn == 7 || pn == 8) {
            const bool isq = pn < 6; bf16_t* base = isq ? Q : QI; const int colt = (isq ? pn - 4 : pn - 7) * 256; const float sc = isq ? QSCALE : QISCALE;
            const bool rope = (wc & 1) == 0;
#pragma unroll
            for (int ai = 0; ai < 2; ++ai)
#pragma unroll
                for (int m = 0; m < 4; ++m) { const size_t row = (size_t)(row0 + ai * HALF + m * 16);
                    f32x4 c0 = {1.f, 1.f, 1.f, 1.f}, c1 = c0, s0 = {0.f, 0.f, 0.f, 0.f}, s1 = s0;
                    if (rope) { c0 = *(const f32x4*)(cs + row * 8); c1 = *(const f32x4*)(cs + row * 8 + 4); s0 = *(const f32x4*)(sn + row * 8); s1 = *(const f32x4*)(sn + row * 8 + 4); }
#pragma unroll
                    for (int bj = 0; bj < 2; ++bj) { f32x4 v0 = acc[ai][bj][m][0], v1 = acc[ai][bj][m][1];
                        if (rope) rope8(v0, v1, c0, c1, s0, s1, fq);
                        v0 = v0 * sc; v1 = v1 * sc;
                        store8(base + row * 512 + colt + bj * HALF + cw, v0, v1); } }
        } else if (pn == 6) {
            const bool rope = (wc & 1) == 0;
#pragma unroll
            for (int ai = 0; ai < 2; ++ai)
#pragma unroll
                for (int m = 0; m < 4; ++m) { const size_t row = (size_t)(row0 + ai * HALF + m * 16);
                    { f32x4 v0 = acc[ai][0][m][0], v1 = acc[ai][0][m][1];
                      if (rope) { const f32x4 c0 = *(const f32x4*)(cs + row * 8), c1 = *(const f32x4*)(cs + row * 8 + 4), s0 = *(const f32x4*)(sn + row * 8), s1 = *(const f32x4*)(sn + row * 8 + 4);
                                  rope8(v0, v1, c0, c1, s0, s1, fq); }
                      store8(K + row * 128 + cw, v0, v1); }
                    { const f32x4 v0 = acc[ai][1][m][0], v1 = acc[ai][1][m][1];
                      const size_t b = row >> 11, s = row & 2047; const int kvh = cw >> 6, d0 = cw & 63;
                      bf16_t* vp = VT + ((b * 2 + kvh) * 64 + d0) * 2048 + s;
                      const unsigned w0 = cvt_pk_bf16(v0[0], v0[1]), w1 = cvt_pk_bf16(v0[2], v0[3]), w2 = cvt_pk_bf16(v1[0], v1[1]), w3 = cvt_pk_bf16(v1[2], v1[3]);
                      vp[0 * 2048] = (bf16_t)(w0 & 0xffffu); vp[1 * 2048] = (bf16_t)(w0 >> 16); vp[2 * 2048] = (bf16_t)(w1 & 0xffffu); vp[3 * 2048] = (bf16_t)(w1 >> 16);
                      vp[4 * 2048] = (bf16_t)(w2 & 0xffffu); vp[5 * 2048] = (bf16_t)(w2 >> 16); vp[6 * 2048] = (bf16_t)(w3 & 0xffffu); vp[7 * 2048] = (bf16_t)(w3 >> 16); } }
        } else {
            if (wc < 2) {
                const bool rope = wc == 0;
#pragma unroll
                for (int ai = 0; ai < 2; ++ai)
#pragma unroll
                    for (int m = 0; m < 4; ++m) { const size_t row = (size_t)(row0 + ai * HALF + m * 16);
                        f32x4 v0 = acc[ai][0][m][0], v1 = acc[ai][0][m][1];
                        if (rope) { const f32x4 c0 = *(const f32x4*)(cs + row * 8), c1 = *(const f32x4*)(cs + row * 8 + 4), s0 = *(const f32x4*)(sn + row * 8), s1 = *(const f32x4*)(sn + row * 8 + 4);
                                    rope8(v0, v1, c0, c1, s0, s1, fq); }
                        store8(KI + row * 64 + cw, v0, v1); }
            } else if (wc == 2 && fq == 0) {
#pragma unroll
                for (int ai = 0; ai < 2; ++ai)
#pragma unroll
                    for (int m = 0; m < 4; ++m) { const size_t row = (size_t)(row0 + ai * HALF + m * 16);
                        *(f32x4*)(WI + row * 8) = acc[ai][0][m][0] * WISCALE; *(f32x4*)(WI + row * 8 + 4) = acc[ai][0][m][1] * WISCALE; }
            }
        }
    }
};
struct EpiRelu2 {
    static constexpr bool PERM = true, AFTER_DRAIN = false;
    bf16_t* O; int ldc;
    __device__ __forceinline__ void operator()(const f32x4 (&acc)[2][2][4][2], const Unit& u, int wr, int wc, int fr, int fq) const {
        const int row0 = u.pm * BM + wr * 64 + fr; const int col0 = u.pn * BM + wc * 32 + 8 * fq;
#pragma unroll
        for (int ai = 0; ai < 2; ++ai)
#pragma unroll
            for (int m = 0; m < 4; ++m) { bf16_t* rowp = O + (size_t)(row0 + ai * HALF + m * 16) * ldc + col0;
#pragma unroll
                for (int bj = 0; bj < 2; ++bj) { f32x4 v0 = acc[ai][bj][m][0], v1 = acc[ai][bj][m][1];
#pragma unroll
                    for (int i = 0; i < 4; ++i) { const float a = fmaxf(v0[i], 0.f), b = fmaxf(v1[i], 0.f); v0[i] = a * a; v1[i] = b * b; }
                    store8(rowp + bj * HALF, v0, v1); } }
    }
};
struct EpiNormPart {
    static constexpr bool PERM = true, AFTER_DRAIN = false;
    bf16_t* O; int ldc; float* part;
    __device__ __forceinline__ void operator()(const f32x4 (&acc)[2][2][4][2], const Unit& u, int wr, int wc, int fr, int fq) const {
        const int row0 = u.pm * BM + wr * 64 + fr; const int col0 = u.pn * BM + wc * 32 + 8 * fq;
#pragma unroll
        for (int ai = 0; ai < 2; ++ai)
#pragma unroll
            for (int m = 0; m < 4; ++m) { const size_t row = (size_t)(row0 + ai * HALF + m * 16); bf16_t* rowp = O + row * ldc + col0; float s = 0.f;
#pragma unroll
                for (int bj = 0; bj < 2; ++bj) { const f32x4 v0 = acc[ai][bj][m][0], v1 = acc[ai][bj][m][1];
                    s += (v0[0] * v0[0] + v0[1] * v0[1]) + (v0[2] * v0[2] + v0[3] * v0[3]) + (v1[0] * v1[0] + v1[1] * v1[1]) + (v1[2] * v1[2] + v1[3] * v1[3]);
                    store8(rowp + bj * HALF, v0, v1); }
                s += __shfl_xor(s, 16); s += __shfl_xor(s, 32);
                if (fq == 0) part[row * 16 + u.pn * 4 + wc] = s; }
    }
};
template <class Epi, class Sched, bool ALIGN_EPI = false, bool SP2 = false>
__device__ __forceinline__ void gemm_phase(PG8_LAS unsigned char* lds, const Gemm g, const Sched& S, const Epi& E) {
    const int tid = threadIdx.x, wid = __builtin_amdgcn_readfirstlane(tid >> 6), lane = tid & 63, wr = wid >> 2, wc = wid & 3, fr = lane & 15, fq = lane >> 4;
    const int K = g.K, nt = K / BK;
    unsigned voffA[2], voffB[2];
#pragma unroll
    for (int i = 0; i < 2; ++i) { int R, C; stage_rc(tid * 16 + i * 8192, R, C); const int Rb = Epi::PERM ? ((R & ~31) + perm32(R & 31)) : R;
        voffA[i] = (unsigned)(R * K + C) * 2u; voffB[i] = (unsigned)(Rb * K + C) * 2u; }
    const size_t kstep = (size_t)(BK * 2);
    const size_t hstep = (size_t)HALF * K * 2;
    const size_t tstep = 2 * hstep;
    const unsigned ldsw = (unsigned)wid * 1024u;
    const int aoff = lds_byte(wr * 64 + fr, fq * 8), boff = lds_byte(wc * 32 + fr, fq * 8);
#define PG8_SA(b, h) (((b) * 2 + (h)) * HTB)
#define PG8_SB(b, h) ((4 + (b) * 2 + (h)) * HTB)
#define PG8_STAGE(bufoff, gbase, voff) do { _Pragma("unroll") for (int _i = 0; _i < 2; ++_i) \
        __builtin_amdgcn_global_load_lds((const unsigned*)((const char*)(gbase) + (voff)[_i]), (PG8_LAS unsigned*)(lds + (bufoff) + ldsw + _i * 8192), 16, 0, 0); } while (0)
#define PG8_LDA(dst, b, h) do { _Pragma("unroll") for (int m = 0; m < 4; ++m) _Pragma("unroll") for (int k = 0; k < 2; ++k) dst[m][k] = *(const PG8_LAS bf16x8*)(lds + PG8_SA(b, h) + aoff + m * 2048 + k * 1024); } while (0)
#define PG8_LDB(dst, b, h) do { _Pragma("unroll") for (int n = 0; n < 2; ++n) _Pragma("unroll") for (int k = 0; k < 2; ++k) dst[n][k] = *(const PG8_LAS bf16x8*)(lds + PG8_SB(b, h) + boff + n * 2048 + k * 1024); } while (0)
#define PG8_MMA(ai, bj, At, Bt) do { __builtin_amdgcn_s_setprio(1); _Pragma("unroll") for (int m = 0; m < 4; ++m) _Pragma("unroll") for (int n = 0; n < 2; ++n) _Pragma("unroll") for (int k = 0; k < 2; ++k) \
        acc[ai][bj][m][n] = __builtin_amdgcn_mfma_f32_16x16x32_bf16(Bt[n][k], At[m][k], acc[ai][bj][m][n], 0, 0, 0); __builtin_amdgcn_s_setprio(0); } while (0)
#define PG8_WAIT_V(n) asm volatile("s_waitcnt vmcnt(" #n ")" ::: "memory")
#define PG8_WAIT_L(n) asm volatile("s_waitcnt lgkmcnt(" #n ")" ::: "memory")
#define PG8_BAR __builtin_amdgcn_s_barrier()
#define PG8_SCHED __builtin_amdgcn_sched_barrier(0)
    Unit cur, nxt; int ui = 0;
    if (!S.next(0, cur)) return;
    f32x4 acc[2][2][4][2];
#pragma unroll
    for (int a = 0; a < 2; ++a)
#pragma unroll
        for (int b = 0; b < 2; ++b)
#pragma unroll
            for (int m = 0; m < 4; ++m)
#pragma unroll
                for (int n = 0; n < 2; ++n) acc[a][b][m][n] = (f32x4){0.f, 0.f, 0.f, 0.f};
    bf16x8 At[4][2], B0[2][2], B1[2][2];
    const char* cA = (const char*)g.A + (size_t)cur.pm * tstep; const char* cB = (const char*)g.Bt + (size_t)cur.pn * tstep;
    S.a_ready(cur);
    if constexpr (SP2) {
        PG8_STAGE(PG8_SB(0, 0), cB, voffB); PG8_STAGE(PG8_SB(0, 1), cB + hstep, voffB); PG8_STAGE(PG8_SA(0, 0), cA, voffA); PG8_STAGE(PG8_SA(0, 1), cA + hstep, voffA);
        if (wr == 1) PG8_BAR;
        PG8_WAIT_V(2); PG8_BAR;
        PG8_STAGE(PG8_SB(1, 0), cB + kstep, voffB); PG8_STAGE(PG8_SA(1, 0), cA + kstep, voffA); PG8_STAGE(PG8_SB(1, 1), cB + hstep + kstep, voffB);
        PG8_WAIT_V(6); PG8_BAR;
    } else {
        PG8_STAGE(PG8_SB(0, 0), cB, voffB); PG8_STAGE(PG8_SA(0, 0), cA, voffA); PG8_STAGE(PG8_SB(0, 1), cB + hstep, voffB); PG8_STAGE(PG8_SA(0, 1), cA + hstep, voffA);
        if (wr == 1) PG8_BAR;
        PG8_WAIT_V(4); PG8_BAR;
        PG8_STAGE(PG8_SB(1, 0), cB + kstep, voffB); PG8_STAGE(PG8_SA(1, 0), cA + kstep, voffA); PG8_STAGE(PG8_SB(1, 1), cB + hstep + kstep, voffB);
        PG8_WAIT_V(6); PG8_BAR;
    }
    for (;;) {
        const bool has_next = S.next(ui + 1, nxt);
        const char* nA = has_next ? (const char*)g.A + (size_t)nxt.pm * tstep : cA; const char* nB = has_next ? (const char*)g.Bt + (size_t)nxt.pn * tstep : cB;
        for (int t = 0; t < nt; t += 2) {
            const bool last = (t == nt - 2);
            const char* a1 = cA + (size_t)(t + 1) * kstep;
            const char* a2 = last ? nA : cA + (size_t)(t + 2) * kstep; const char* b2 = last ? nB : cB + (size_t)(t + 2) * kstep;
            const char* a3 = a2 + kstep; const char* b3 = b2 + kstep;
            if (last && has_next) S.a_ready(nxt);
            if constexpr (SP2) {
            PG8_LDB(B0, 0, 0); PG8_LDB(B1, 0, 1); PG8_SCHED; PG8_LDA(At, 0, 0); PG8_STAGE(PG8_SA(1, 1), a1 + hstep, voffA);
            PG8_WAIT_V(8); PG8_WAIT_L(0); PG8_BAR; PG8_MMA(0, 0, At, B0); PG8_MMA(0, 1, At, B1); PG8_BAR; PG8_SCHED;
            PG8_LDA(At, 0, 1); PG8_STAGE(PG8_SB(0, 0), b2, voffB); PG8_STAGE(PG8_SB(0, 1), b2 + hstep, voffB); PG8_STAGE(PG8_SA(0, 0), a2, voffA);
            PG8_WAIT_V(8); PG8_WAIT_L(0); PG8_BAR; PG8_MMA(1, 0, At, B0); PG8_MMA(1, 1, At, B1); PG8_BAR; PG8_SCHED;
            PG8_LDB(B0, 1, 0); PG8_LDB(B1, 1, 1); PG8_SCHED; PG8_LDA(At, 1, 0); PG8_STAGE(PG8_SA(0, 1), a2 + hstep, voffA);
            PG8_WAIT_V(8); PG8_WAIT_L(0); PG8_BAR; PG8_MMA(0, 0, At, B0); PG8_MMA(0, 1, At, B1); PG8_BAR; PG8_SCHED;
            PG8_LDA(At, 1, 1); PG8_STAGE(PG8_SB(1, 0), b3, voffB); PG8_STAGE(PG8_SB(1, 1), b3 + hstep, voffB); PG8_STAGE(PG8_SA(1, 0), a3, voffA);
            PG8_WAIT_V(8); PG8_WAIT_L(0); PG8_BAR; PG8_MMA(1, 0, At, B0); PG8_MMA(1, 1, At, B1); PG8_BAR; PG8_SCHED;
            } else {
            PG8_LDB(B0, 0, 0); PG8_SCHED; PG8_LDA(At, 0, 0); PG8_STAGE(PG8_SA(1, 1), a1 + hstep, voffA);
            PG8_WAIT_L(8); PG8_BAR; PG8_WAIT_L(0); PG8_MMA(0, 0, At, B0); PG8_BAR; PG8_SCHED;
            PG8_LDB(B1, 0, 1); PG8_STAGE(PG8_SB(0, 0), b2, voffB);
            PG8_BAR; PG8_WAIT_L(0); PG8_MMA(0, 1, At, B1); PG8_BAR;
            PG8_LDA(At, 0, 1); PG8_STAGE(PG8_SA(0, 0), a2, voffA);
            PG8_BAR; PG8_WAIT_L(0); PG8_MMA(1, 0, At, B0); PG8_BAR; PG8_SCHED;
            PG8_STAGE(PG8_SB(0, 1), b2 + hstep, voffB);
            PG8_WAIT_V(6); PG8_BAR; PG8_MMA(1, 1, At, B1); PG8_BAR;
            PG8_LDB(B0, 1, 0); PG8_SCHED; PG8_LDA(At, 1, 0); PG8_STAGE(PG8_SA(0, 1), a2 + hstep, voffA);
            PG8_WAIT_L(8); PG8_BAR; PG8_WAIT_L(0); PG8_MMA(0, 0, At, B0); PG8_BAR; PG8_SCHED;
            PG8_LDB(B1, 1, 1); PG8_STAGE(PG8_SB(1, 0), b3, voffB);
            PG8_BAR; PG8_WAIT_L(0); PG8_MMA(0, 1, At, B1); PG8_BAR;
            PG8_LDA(At, 1, 1); PG8_STAGE(PG8_SA(1, 0), a3, voffA);
            PG8_BAR; PG8_WAIT_L(0); PG8_MMA(1, 0, At, B0); PG8_BAR; PG8_SCHED;
            PG8_STAGE(PG8_SB(1, 1), b3 + hstep, voffB);
            PG8_WAIT_V(6); PG8_BAR; PG8_MMA(1, 1, At, B1); PG8_BAR;
            }
        }
        if constexpr (ALIGN_EPI) { if (wr == 0) PG8_BAR; }
        if constexpr (!Epi::AFTER_DRAIN) { E(acc, cur, wr, wc, fr, fq); S.done(cur); }
        if (!has_next) break;
#pragma unroll
        for (int a = 0; a < 2; ++a)
#pragma unroll
            for (int b = 0; b < 2; ++b)
#pragma unroll
                for (int m = 0; m < 4; ++m)
#pragma unroll
                    for (int n = 0; n < 2; ++n) acc[a][b][m][n] = (f32x4){0.f, 0.f, 0.f, 0.f};
        cur = nxt; cA = nA; cB = nB; ++ui;
        if constexpr (ALIGN_EPI) { if (wr == 1) PG8_BAR; }
    }
    PG8_WAIT_V(0);
    if constexpr (!ALIGN_EPI) { if (wr == 0) PG8_BAR; }
    PG8_BAR;
    if constexpr (Epi::AFTER_DRAIN) { E.fused(acc, cur, wr, wc, fr, fq, lds, wid, lane); S.done(cur); }
#undef PG8_SA
#undef PG8_SB
#undef PG8_STAGE
#undef PG8_LDA
#undef PG8_LDB
#undef PG8_MMA
#undef PG8_WAIT_V
#undef PG8_WAIT_L
#undef PG8_BAR
#undef PG8_SCHED
}
}
#define PG8_SP2 true
#define PG8_ALIGN true
#define GAS __attribute__((address_space(1)))
#define LAS __attribute__((address_space(3)))
typedef unsigned short bf16;
typedef unsigned v4u __attribute__((ext_vector_type(4)));
typedef float f32x4 __attribute__((ext_vector_type(4)));
typedef short bf16x8 __attribute__((ext_vector_type(8)));
typedef GAS unsigned gu32;
typedef GAS unsigned long long gu64;
#define RLX_AGENT __ATOMIC_RELAXED, __HIP_MEMORY_SCOPE_AGENT
#define LDS_WAIT() asm volatile("s_waitcnt lgkmcnt(0)" ::: "memory")
#define VM_WAIT() asm volatile("s_waitcnt vmcnt(0)" ::: "memory")
__device__ __forceinline__ unsigned long long rt() { return __builtin_amdgcn_s_memrealtime(); }
__device__ __forceinline__ unsigned f2bf(float f) { unsigned u = __builtin_bit_cast(unsigned, f); return (u + 0x7fffu + ((u >> 16) & 1u)) >> 16; }
__device__ __forceinline__ unsigned pk2(float lo, float hi) { return f2bf(lo) | (f2bf(hi) << 16); }

#define XB_TMO      128
#define XB_XCNT(j)  (256  + 64 * (j))
#define XB_XSUB(j)  (1280 + 64 * (j))
#define XB_XGEN(j)  (2304 + 64 * (j))
#define XB_TOP      3328
#define XB_TOPGEN   3392
#define XCD_BAR_WORDS 3456
#define XB_SPIN_CAP (1u << 18)

__device__ __forceinline__ unsigned xb_ld(unsigned* p)              { return __hip_atomic_load(p, __ATOMIC_RELAXED, __HIP_MEMORY_SCOPE_AGENT); }
__device__ __forceinline__ unsigned xb_add(unsigned* p, unsigned v) { return __hip_atomic_fetch_add(p, v, __ATOMIC_RELAXED, __HIP_MEMORY_SCOPE_AGENT); }
__device__ __forceinline__ unsigned xb_xcc_id() { return (unsigned)__builtin_amdgcn_s_getreg((3 << 11) | 20) & 0xFu; }
#define XB_SPIN(cond, bar) do { unsigned _sp = 0; while (cond) { __builtin_amdgcn_s_sleep(1); \
    if ((++_sp & 255u) == 0u) { if (xb_ld(&(bar)[XB_TMO])) break; if (_sp > XB_SPIN_CAP) { atomicAdd(&(bar)[XB_TMO], 1u); break; } } } } while (0)

struct XcdBarrier {
    unsigned* bar; unsigned x;
    volatile LAS unsigned* st;
};

__device__ __forceinline__ XcdBarrier xcd_barrier_post(unsigned* bar, volatile LAS unsigned* st) {
    XcdBarrier b; b.bar = bar; b.x = xb_xcc_id(); b.st = st;
    if (threadIdx.x == 0) (void)xb_add(&bar[XB_XCNT(b.x)], 1u);
    return b;
}
__device__ __forceinline__ void xcd_barrier_complete(unsigned* bar, unsigned x, unsigned& nloc, unsigned& nx) {
    const unsigned G = gridDim.x * gridDim.y * gridDim.z;
    unsigned sum, cnt, mine, sp = 0u;
    for (;;) {
        sum = 0u; cnt = 0u; mine = 0u;
#pragma unroll
        for (unsigned j = 0; j < 16; ++j) { const unsigned c = xb_ld(&bar[XB_XCNT(j)]); sum += c; cnt += (c > 0u) ? 1u : 0u; mine = (j == x) ? c : mine; }
        if (sum == G) break;
        __builtin_amdgcn_s_sleep(1);
        if ((++sp & 255u) == 0u) { if (xb_ld(&bar[XB_TMO])) break; if (sp > XB_SPIN_CAP) { atomicAdd(&bar[XB_TMO], 1u); break; } }
    }
    nloc = mine > 0u ? mine : 1u; nx = cnt > 0u ? cnt : 1u;
}

__device__ __forceinline__ void xcd_barrier(const XcdBarrier& b) {
    asm volatile("s_waitcnt vmcnt(0)" ::: "memory");
    __syncthreads();
    if (threadIdx.x == 0) {
        unsigned* bar = b.bar;
        __builtin_amdgcn_s_waitcnt(0);
        unsigned nloc = b.st[0], nx = b.st[1];
        if (nloc == 0u) { xcd_barrier_complete(bar, b.x, nloc, nx); b.st[0] = nloc; b.st[1] = nx; }
        const unsigned old = xb_add(&bar[XB_XSUB(b.x)], 1u);
        const unsigned gen = old / nloc;
        if (old + 1u == (gen + 1u) * nloc) {
            __builtin_amdgcn_fence(__ATOMIC_RELEASE, "agent");
            asm volatile("s_waitcnt vmcnt(0)" ::: "memory");
            const unsigned og = xb_add(&bar[XB_TOP], 1u);
            const unsigned tg = og / nx;
            if (og + 1u == (tg + 1u) * nx) xb_add(&bar[XB_TOPGEN], 1u);
            else XB_SPIN(xb_ld(&bar[XB_TOPGEN]) == tg, bar);
            __builtin_amdgcn_fence(__ATOMIC_ACQUIRE, "agent");
            xb_add(&bar[XB_XGEN(b.x)], 1u);
            asm volatile("s_waitcnt vmcnt(0)" ::: "memory");
        } else {
            XB_SPIN(xb_ld(&bar[XB_XGEN(b.x)]) == gen, bar);
            __builtin_amdgcn_fence(__ATOMIC_ACQUIRE, "agent");
            asm volatile("s_waitcnt vmcnt(0)" ::: "memory");
        }
    }
    __syncthreads();
}
#ifndef MK_N_LAUNCHES
#define MK_N_LAUNCHES 1
#endif
constexpr int NWAVES = 8;
constexpr int N_PHASES = 9;
constexpr int BATCH = 32, SEQ = 2048, D = 1024, M = BATCH * SEQ, DIN = 2376, DINP = 2560, FF = 4096, DSGU = 512;
constexpr float EPS = 1e-6f;
constexpr size_t MiB = 1u << 20;
constexpr size_t WS_CTL = 0, CTL_ZERO_BYTES = 1 * MiB;
constexpr size_t WS_MOD = 1 * MiB;
constexpr size_t WS_COS = 2 * MiB, WS_SIN = 4 * MiB;
constexpr size_t WS_WM = 6 * MiB;
constexpr size_t WS_PART = 7 * MiB;
constexpr size_t WS_WIN = 12 * MiB, WS_WOUT = 17 * MiB, WS_W1 = 19 * MiB, WS_W2 = 27 * MiB;
constexpr size_t WS_WI = 36 * MiB;
constexpr size_t WS_H = 40 * MiB;
constexpr size_t WS_BIG = 168 * MiB;
constexpr size_t WS_ZU = WS_BIG, WS_ZV = WS_BIG + 64 * MiB, WS_Q = WS_BIG + 128 * MiB, WS_K = WS_BIG + 192 * MiB, WS_VT = WS_BIG + 208 * MiB,
                 WS_QI = WS_BIG + 224 * MiB, WS_KI = WS_BIG + 288 * MiB, WS_MERGED = WS_BIG + 296 * MiB;
constexpr size_t WS_O = WS_BIG;
constexpr size_t WS_HB = WS_BIG;
constexpr size_t WS_SCR = WS_BIG + 512 * MiB;
constexpr size_t WS_F = WS_SCR;
constexpr size_t WS_END = WS_SCR + 256 * MiB;
constexpr size_t SCR_PER_WG = 1 * MiB, SCR_SC = 0, SCR_MK = 512 * 1024, SCR_YB = 768 * 1024;
constexpr int CW_BAR = 4096;
constexpr int RING_OFF = 0, RING_BYTES = 131072;
constexpr int LDSCTL_OFF = RING_BYTES, MISC_OFF = LDSCTL_OFF + 320, AUX_OFF = LDSCTL_OFF + 1024;
constexpr int LDS_BYTES = 147456;

typedef float f32x16 __attribute__((ext_vector_type(16)));
typedef float f32x2 __attribute__((ext_vector_type(2)));
typedef unsigned u32x2 __attribute__((ext_vector_type(2)));
#define MFMA32(a, b, c) __builtin_amdgcn_mfma_f32_32x32x16_bf16((a), (b), (c), 0, 0, 0)

struct Frame {
    LAS unsigned char* lds;
    volatile LAS unsigned* MISC;
    gu32* ctl;
    int tid, lane, wave, vcu, G;
    const float *x, *c; const int* pos; const float *w_ada, *b_ada, *g_pre_mix, *w_in, *g_sgu_v, *w_spatial, *b_spatial, *g_out_sgu, *g_out_attn, *w_out, *g_post_mix, *g_pre_ffn, *w_ff1, *w_ff2, *g_post_ffn;
    float* out;
    float *MOD, *COS, *SIN, *PART, *WI;
    bf16 *WM, *WIN, *WOUT, *W1, *W2, *H, *ZU, *ZV, *Q, *K, *VT, *QI, *KI, *MERGED, *O, *HB, *FB;
    unsigned char* scr;
};
__device__ __forceinline__ float bflo(unsigned u) { return __builtin_bit_cast(float, u << 16); }
__device__ __forceinline__ float bfhi(unsigned u) { return __builtin_bit_cast(float, u & 0xffff0000u); }
__device__ __forceinline__ unsigned pkbf(float lo, float hi) { return pg8::cvt_pk_bf16(lo, hi); }
__device__ __forceinline__ float wave_sum(float v) {
#pragma unroll
    for (int o = 1; o < 64; o <<= 1) v += __shfl_xor(v, o);
    return v;
}
__device__ __forceinline__ void block_sync_mem() {
    asm volatile("s_waitcnt vmcnt(0)" ::: "memory");
    __syncthreads();
    if (threadIdx.x == 0) { __builtin_amdgcn_fence(__ATOMIC_ACQUIRE, "agent"); asm volatile("s_waitcnt vmcnt(0)" ::: "memory"); }
    __syncthreads();
}

__device__ __forceinline__ void p0_transpose_item(const float* W, int K, int N, int Npad, bf16* WT, LAS float* scr, int item, int lane) {
    const int nblk = Npad / 32, kb = item / nblk, nb = item % nblk, k0 = 64 * kb, n0 = 32 * nb;
    const int nn = n0 + (lane & 31);
#pragma unroll 8
    for (int i = 0; i < 32; ++i) { const int kk = 2 * i + (lane >> 5); scr[kk * 33 + (lane & 31)] = (nn < N) ? W[(size_t)(k0 + kk) * N + nn] : 0.f; }
    LDS_WAIT(); asm volatile("" ::: "memory");
    const int c = lane & 7;
#pragma unroll
    for (int j = 0; j < 4; ++j) { const int n = (lane >> 3) + 8 * j; const LAS float* s = scr + (8 * c) * 33 + n;
        v4u o; o.x = pk2(s[0 * 33], s[1 * 33]); o.y = pk2(s[2 * 33], s[3 * 33]); o.z = pk2(s[4 * 33], s[5 * 33]); o.w = pk2(s[6 * 33], s[7 * 33]);
        *(GAS v4u*)(WT + (size_t)(n0 + n) * K + k0 + 8 * c) = o; }
    LDS_WAIT(); asm volatile("" ::: "memory");
}
__device__ __forceinline__ void p0_mod_unit(Frame& F, int u) {
    const int lane = F.lane, w = F.wave, tid = F.tid;
    LAS float* csl = (LAS float*)F.lds + w * 4096;
#pragma unroll 4
    for (int i = 0; i < 64; ++i) { const int idx = i * 64 + lane, b = idx >> 7, d = idx & 127; const float cv = F.c[b * D + 128 * w + d];
        csl[d * 32 + b] = cv / (1.0f + __expf(-cv)); }
    LDS_WAIT(); asm volatile("" ::: "memory");
    float acc[32];
#pragma unroll
    for (int b = 0; b < 32; ++b) acc[b] = 0.f;
    const float* wp = F.w_ada + (size_t)(128 * w) * 6144 + 64 * u + lane;
#pragma unroll 2
    for (int d = 0; d < 128; ++d) { const float wv = wp[(size_t)d * 6144];
#pragma unroll
        for (int b4 = 0; b4 < 8; ++b4) { const f32x4 cc = *(const LAS f32x4*)(csl + d * 32 + 4 * b4);
            acc[4 * b4 + 0] += cc[0] * wv; acc[4 * b4 + 1] += cc[1] * wv; acc[4 * b4 + 2] += cc[2] * wv; acc[4 * b4 + 3] += cc[3] * wv; } }
    __syncthreads();
    LAS float* red = (LAS float*)F.lds;
#pragma unroll
    for (int b = 0; b < 32; ++b) red[(w * 32 + b) * 64 + lane] = acc[b];
    __syncthreads();
#pragma unroll
    for (int k = 0; k < 4; ++k) { const int o = tid + 512 * k, b = o >> 6, col = o & 63; float s = 0.f;
#pragma unroll
        for (int ww = 0; ww < 8; ++ww) s += red[(ww * 32 + b) * 64 + col];
        F.MOD[b * 6144 + 64 * u + col] = s + F.b_ada[64 * u + col]; }
    __syncthreads();
}
__device__ __forceinline__ void p0_prologue(Frame& F) {
    for (int u = F.vcu; u < 96; u += F.G) p0_mod_unit(F, u);
    LAS float* scr = (LAS float*)(F.lds + RING_OFF + F.wave * 16384);
    const int gw = F.vcu * NWAVES + F.wave, NGW = F.G * NWAVES;
    constexpr int I_IN = (D / 64) * (DINP / 32), I_OUT = (D / 64) * (D / 32), I_1 = (D / 64) * (FF / 32), I_2 = (FF / 64) * (D / 32);
    constexpr int NITEMS = I_IN + I_OUT + I_1 + I_2;
    for (int it = gw; it < NITEMS; it += NGW) {
        int r = it;
        if (r < I_IN) { p0_transpose_item(F.w_in, D, DIN, DINP, F.WIN, scr, r, F.lane); continue; } r -= I_IN;
        if (r < I_OUT) { p0_transpose_item(F.w_out, D, D, D, F.WOUT, scr, r, F.lane); continue; } r -= I_OUT;
        if (r < I_1) { p0_transpose_item(F.w_ff1, D, FF, FF, F.W1, scr, r, F.lane); continue; } r -= I_1;
        p0_transpose_item(F.w_ff2, FF, D, D, F.W2, scr, r, F.lane);
    }
    const int gt = F.vcu * NWAVES * 64 + F.tid, NT = F.G * NWAVES * 64;
    for (int i = gt; i < 4 * 128 * 128; i += NT) { const int t = (i >> 7) & 127, s = i & 127; F.WM[i] = (bf16)f2bf(s <= t ? F.w_spatial[i] : 0.f); }
    for (int i = gt; i < M * 8; i += NT) { const int m = i >> 3, j = i & 7;
        const double rpp = (j == 0) ? 0.15915494309189535 : (j == 1) ? 0.03086376340470123 : (j == 2) ? 0.005985185712713705 : (j == 3) ? 0.001160663641240061 :
                           (j == 4) ? 0.00022507907903927653 : (j == 5) ? 4.364795279280289e-05 : (j == 6) ? 8.464330808241401e-06 : 1.6414262627950345e-06;
        const double rev = (double)F.pos[m] * rpp; const float fr = (float)(rev - __builtin_floor(rev));
        F.COS[i] = __builtin_amdgcn_cosf(fr); F.SIN[i] = __builtin_amdgcn_sinf(fr); }
}
__device__ __forceinline__ void p1_hprep(Frame& F) {
    const int gw = F.vcu * NWAVES + F.wave, NGW = F.G * NWAVES, lane = F.lane;
    for (int chunk = gw; chunk < M / 32; chunk += NGW) {
        const int b = (chunk * 32) / SEQ; const float* mod = F.MOD + b * 6144;
        f32x4 ga[4], sh[4];
#pragma unroll
        for (int j = 0; j < 4; ++j) { const int c = 4 * lane + 256 * j; const f32x4 g = *(const f32x4*)(F.g_pre_mix + c), sc = *(const f32x4*)(mod + 1024 + c); ga[j] = g * (sc + 1.0f); sh[j] = *(const f32x4*)(mod + c); }
        for (int r = 0; r < 32; ++r) { const size_t m = (size_t)chunk * 32 + r;
            const GAS f32x4* xr = (const GAS f32x4*)(F.x + m * D) + lane; f32x4 v[4]; float s = 0.f;
#pragma unroll
            for (int j = 0; j < 4; ++j) { v[j] = xr[64 * j]; s += (v[j].x * v[j].x + v[j].y * v[j].y) + (v[j].z * v[j].z + v[j].w * v[j].w); }
            const float rstd = rsqrtf(wave_sum(s) * (1.f / D) + EPS);
            GAS u32x2* o8 = (GAS u32x2*)(F.H + m * D) + lane;
#pragma unroll
            for (int j = 0; j < 4; ++j) { const f32x4 o = v[j] * rstd * ga[j] + sh[j]; u32x2 w; w.x = pkbf(o.x, o.y); w.y = pkbf(o.z, o.w); o8[64 * j] = w; } }
    }
}
__device__ __forceinline__ void p5_postmix(Frame& F) {
    const int gw = F.vcu * NWAVES + F.wave, NGW = F.G * NWAVES, lane = F.lane;
    for (int chunk = gw; chunk < M / 32; chunk += NGW) {
        const int b = (chunk * 32) / SEQ; const float* mod = F.MOD + b * 6144;
        f32x4 g1[4], ga[4], sh[4];
#pragma unroll
        for (int j = 0; j < 4; ++j) { const int c = 4 * lane + 256 * j;
            g1[j] = *(const f32x4*)(mod + 2048 + c) * *(const f32x4*)(F.g_post_mix + c);
            ga[j] = *(const f32x4*)(F.g_pre_ffn + c) * (*(const f32x4*)(mod + 4096 + c) + 1.0f); sh[j] = *(const f32x4*)(mod + 3072 + c); }
        for (int r = 0; r < 32; ++r) { const size_t m = (size_t)chunk * 32 + r;
            float ps = F.PART[m * 16 + (lane & 15)]; ps += __shfl_xor(ps, 1); ps += __shfl_xor(ps, 2); ps += __shfl_xor(ps, 4); ps += __shfl_xor(ps, 8);
            const float rstd_o = rsqrtf(ps * (1.f / D) + EPS);
            const GAS f32x4* xr = (const GAS f32x4*)(F.x + m * D) + lane; const GAS u32x2* orow = (const GAS u32x2*)(F.O + m * D) + lane;
            GAS f32x4* outr = (GAS f32x4*)(F.out + m * D) + lane;
            f32x4 v[4]; float s = 0.f;
#pragma unroll
            for (int j = 0; j < 4; ++j) { const u32x2 ow = orow[64 * j]; const f32x4 ov = {bflo(ow.x), bfhi(ow.x), bflo(ow.y), bfhi(ow.y)};
                v[j] = xr[64 * j] + g1[j] * (ov * rstd_o); outr[64 * j] = v[j];
                s += (v[j].x * v[j].x + v[j].y * v[j].y) + (v[j].z * v[j].z + v[j].w * v[j].w); }
            const float rstd = rsqrtf(wave_sum(s) * (1.f / D) + EPS);
            GAS u32x2* o8 = (GAS u32x2*)(F.H + m * D) + lane;
#pragma unroll
            for (int j = 0; j < 4; ++j) { const f32x4 o = v[j] * rstd * ga[j] + sh[j]; u32x2 w; w.x = pkbf(o.x, o.y); w.y = pkbf(o.z, o.w); o8[64 * j] = w; } }
    }
}
__device__ __forceinline__ void p8_final(Frame& F) {
    const int gw = F.vcu * NWAVES + F.wave, NGW = F.G * NWAVES, lane = F.lane;
    for (int chunk = gw; chunk < M / 32; chunk += NGW) {
        const int b = (chunk * 32) / SEQ; const float* mod = F.MOD + b * 6144;
        f32x4 g2[4];
#pragma unroll
        for (int j = 0; j < 4; ++j) { const int c = 4 * lane + 256 * j; g2[j] = *(const f32x4*)(mod + 5120 + c) * *(const f32x4*)(F.g_post_ffn + c); }
        for (int r = 0; r < 32; ++r) { const size_t m = (size_t)chunk * 32 + r;
            float ps = F.PART[m * 16 + (lane & 15)]; ps += __shfl_xor(ps, 1); ps += __shfl_xor(ps, 2); ps += __shfl_xor(ps, 4); ps += __shfl_xor(ps, 8);
            const float rstd_f = rsqrtf(ps * (1.f / D) + EPS);
            const GAS u32x2* frow = (const GAS u32x2*)(F.FB + m * D) + lane; GAS f32x4* outr = (GAS f32x4*)(F.out + m * D) + lane;
#pragma unroll
            for (int j = 0; j < 4; ++j) { const u32x2 fw = frow[64 * j]; const f32x4 fv = {bflo(fw.x), bfhi(fw.x), bflo(fw.y), bfhi(fw.y)};
                outr[64 * j] = outr[64 * j] + g2[j] * (fv * rstd_f); } }
    }
}
__device__ __forceinline__ void sgu_unit(Frame& F, int b, int n) {
    const int tid = F.tid, lane = F.lane, w = F.wave;
    const size_t R0 = (size_t)b * SEQ + (size_t)n * 128;
    LAS bf16* vn = (LAS bf16*)F.lds;
    LAS float* rpart = (LAS float*)(F.lds + AUX_OFF);
    {
        f32x4 gv0 = *(const f32x4*)(F.g_sgu_v + 8 * lane), gv1 = *(const f32x4*)(F.g_sgu_v + 8 * lane + 4);
#pragma unroll 4
        for (int i = 0; i < 16; ++i) { const int s = 16 * w + i;
            const v4u raw = *(const GAS v4u*)(F.ZV + (R0 + s) * DSGU + 8 * lane);
            f32x4 a = {bflo(raw.x), bfhi(raw.x), bflo(raw.y), bfhi(raw.y)}, c = {bflo(raw.z), bfhi(raw.z), bflo(raw.w), bfhi(raw.w)};
            float ss = (a.x * a.x + a.y * a.y) + (a.z * a.z + a.w * a.w) + (c.x * c.x + c.y * c.y) + (c.z * c.z + c.w * c.w);
            ss += __shfl_xor(ss, 1); ss += __shfl_xor(ss, 2); ss += __shfl_xor(ss, 4); ss += __shfl_xor(ss, 8);
            const float rstd = rsqrtf(ss * (1.f / 128.f) + EPS);
            a = a * rstd * gv0; c = c * rstd * gv1;
            v4u o; o.x = pkbf(a.x, a.y); o.y = pkbf(a.z, a.w); o.z = pkbf(c.x, c.y); o.w = pkbf(c.z, c.w);
            *(LAS v4u*)(vn + s * DSGU + 8 * lane) = o; }
    }
    __syncthreads();
    const int tt = w & 3, ch = w >> 2, tl = lane & 31, h = lane >> 5;
    const int t = tt * 32 + tl;
    f32x16 acc[8];
#pragma unroll
    for (int i = 0; i < 8; ++i)
#pragma unroll
        for (int r = 0; r < 16; ++r) acc[i][r] = 0.f;
    const int kmax = 2 * (tt + 1);
#pragma unroll
    for (int gi = 0; gi < 2; ++gi) { const int g = 2 * ch + gi;
        const bf16* bp = F.WM + ((size_t)(g * 128 + t)) * 128 + 8 * h;
#pragma unroll
        for (int ct = 0; ct < 4; ++ct) { const LAS bf16* colp = vn + g * 128 + ct * 32 + tl + 8 * h * DSGU;
            f32x16 a = acc[gi * 4 + ct];
#pragma unroll 2
            for (int kk = 0; kk < kmax; ++kk) {
                const LAS bf16* p = colp + kk * 16 * DSGU;
                const unsigned e0 = p[0], e1 = p[DSGU], e2 = p[2 * DSGU], e3 = p[3 * DSGU], e4 = p[4 * DSGU], e5 = p[5 * DSGU], e6 = p[6 * DSGU], e7 = p[7 * DSGU];
                v4u pk; pk.x = e0 | (e1 << 16); pk.y = e2 | (e3 << 16); pk.z = e4 | (e5 << 16); pk.w = e6 | (e7 << 16);
                const bf16x8 Bf = *(const GAS bf16x8*)(bp + kk * 16);
                a = MFMA32(__builtin_bit_cast(bf16x8, pk), Bf, a); }
            acc[gi * 4 + ct] = a; }
    }
    float ssq = 0.f;
#pragma unroll
    for (int gi = 0; gi < 2; ++gi) { const int g = 2 * ch + gi; const float bias = F.b_spatial[g * 128 + t];
#pragma unroll
        for (int ct = 0; ct < 4; ++ct)
#pragma unroll
            for (int qd = 0; qd < 4; ++qd) { const int c0 = g * 128 + ct * 32 + 8 * qd + 4 * h;
                const u32x2 zu = *(const GAS u32x2*)(F.ZU + (R0 + t) * DSGU + c0);
                const float u0 = bflo(zu.x), u1 = bfhi(zu.x), u2 = bflo(zu.y), u3 = bfhi(zu.y);
                float v0 = (acc[gi * 4 + ct][4 * qd + 0] + bias) * u0, v1 = (acc[gi * 4 + ct][4 * qd + 1] + bias) * u1, v2 = (acc[gi * 4 + ct][4 * qd + 2] + bias) * u2, v3 = (acc[gi * 4 + ct][4 * qd + 3] + bias) * u3;
                acc[gi * 4 + ct][4 * qd + 0] = v0; acc[gi * 4 + ct][4 * qd + 1] = v1; acc[gi * 4 + ct][4 * qd + 2] = v2; acc[gi * 4 + ct][4 * qd + 3] = v3;
                ssq += (v0 * v0 + v1 * v1) + (v2 * v2 + v3 * v3); } }
    ssq += __shfl_xor(ssq, 32);
    if (h == 0) rpart[ch * 128 + t] = ssq;
    __syncthreads();
    const float rstd = rsqrtf((rpart[t] + rpart[128 + t]) * (1.f / 512.f) + EPS);
#pragma unroll
    for (int gi = 0; gi < 2; ++gi) { const int g = 2 * ch + gi;
#pragma unroll
        for (int ct = 0; ct < 4; ++ct)
#pragma unroll
            for (int qd = 0; qd < 4; ++qd) { const int c0 = g * 128 + ct * 32 + 8 * qd + 4 * h;
                const f32x4 go = *(const f32x4*)(F.g_out_sgu + c0);
                u32x2 o; o.x = pkbf(acc[gi * 4 + ct][4 * qd + 0] * rstd * go.x, acc[gi * 4 + ct][4 * qd + 1] * rstd * go.y);
                o.y = pkbf(acc[gi * 4 + ct][4 * qd + 2] * rstd * go.z, acc[gi * 4 + ct][4 * qd + 3] * rstd * go.w);
                *(GAS u32x2*)(F.MERGED + (R0 + t) * D + c0) = o; } }
    __syncthreads();
}
__device__ __forceinline__ unsigned okey(unsigned x) { return (x & 0x8000u) ? (x ^ 0xffffu) : (x | 0x8000u); }
__device__ __forceinline__ void radix_scan(const v4u c, unsigned kk, int lane, unsigned& bin_out, unsigned& rem_out) {
    const unsigned T = c.x + c.y + c.z + c.w; unsigned S = T;
#pragma unroll
    for (int off = 1; off < 64; off <<= 1) { const unsigned v = __shfl_down(S, off); if (lane + off < 64) S += v; }
    const unsigned above = S - T; const bool found = (S >= kk) && (above < kk);
    unsigned bin, rem, cum = above;
    if (cum + c.w >= kk) { bin = 3; rem = kk - cum; } else { cum += c.w;
        if (cum + c.z >= kk) { bin = 2; rem = kk - cum; } else { cum += c.z;
            if (cum + c.y >= kk) { bin = 1; rem = kk - cum; } else { cum += c.y; bin = 0; rem = kk - cum; } } }
    bin += 4 * lane;
    const unsigned long long bm = __ballot(found); const int src = bm ? (__ffsll((long long)bm) - 1) : 0;
    bin_out = __shfl(bin, src); rem_out = __shfl(rem, src);
}
__device__ __forceinline__ void dsa_unit(Frame& F, int b, int qb) {
    const int lane = F.lane, w = F.wave;
    bf16* SC = (bf16*)(F.scr + SCR_SC); unsigned* MK = (unsigned*)(F.scr + SCR_MK); bf16* YB = (bf16*)(F.scr + SCR_YB);
    const int g = w & 3, kh = w >> 2, q = lane & 31, h = lane >> 5;
    const int t0 = 128 * qb + 32 * g;
    const size_t rowq = (size_t)b * SEQ + t0 + q;
    const int ntile = 4 * qb + g + 1;
#ifndef NO_PASSA
    if (qb >= 2) {
#pragma unroll 4
        for (int i = 0; i < 16; ++i) { const int idx = i * 512 + F.tid, row = idx >> 6, c = idx & 63;
            const v4u v = *(const GAS v4u*)(F.QI + ((size_t)b * SEQ + 128 * qb + row) * 512 + c * 8);
            *(LAS v4u*)(F.lds + row * 1024 + ((c ^ (row & 15)) << 4)) = v; }
        __syncthreads();
        const int qrow = 32 * g + q; const int lx = h ^ (qrow & 15);
        unsigned offs[8];
#pragma unroll
        for (int c8 = 0; c8 < 8; ++c8) offs[c8] = (unsigned)(qrow * 1024 + (((2 * c8) ^ lx) << 4));
        const f32x4 w0 = *(const f32x4*)(F.WI + rowq * 8), w1 = *(const f32x4*)(F.WI + rowq * 8 + 4);
        const float wv[8] = {w0.x, w0.y, w0.z, w0.w, w1.x, w1.y, w1.z, w1.w};
#pragma unroll 1
        for (int j = kh; j < ntile; j += 2) {
            asm volatile("" ::: "memory");
            const size_t rowk = (size_t)b * SEQ + 32 * j + q;
            bf16x8 kf[4];
#pragma unroll
            for (int kk = 0; kk < 4; ++kk) kf[kk] = *(const GAS bf16x8*)(F.KI + rowk * 64 + kk * 16 + 8 * h);
            f32x16 sc;
#pragma unroll
            for (int r = 0; r < 16; ++r) sc[r] = 0.f;
#pragma unroll
            for (int hd = 0; hd < 8; ++hd) { f32x16 d;
#pragma unroll
                for (int r = 0; r < 16; ++r) d[r] = 0.f;
#pragma unroll
                for (int kk = 0; kk < 4; ++kk) { const bf16x8 qf = *(const LAS bf16x8*)(F.lds + offs[(hd & 1) * 4 + kk] + 256 * (hd >> 1)); d = MFMA32(kf[kk], qf, d); }
#pragma unroll
                for (int r = 0; r < 16; ++r) { const float dv = d[r]; const int di = __float_as_int(dv); const float rl = __int_as_float(di & ~(di >> 31)); sc[r] = __builtin_fmaf(wv[hd], rl, sc[r]); } }
#pragma unroll
            for (int qd = 0; qd < 4; ++qd) { u32x2 o;
                o.x = __builtin_bit_cast(unsigned, __builtin_amdgcn_cvt_pkrtz(sc[4 * qd + 0], sc[4 * qd + 1]));
                o.y = __builtin_bit_cast(unsigned, __builtin_amdgcn_cvt_pkrtz(sc[4 * qd + 2], sc[4 * qd + 3]));
                *(GAS u32x2*)(SC + (size_t)(32 * g + q) * 2048 + 32 * j + 8 * qd + 4 * h) = o; }
        }
    }
#endif
    block_sync_mem();
#ifndef NO_PASSB
    {
        LAS unsigned* hist = (LAS unsigned*)F.lds + w * 256;
        for (int i = 0; i < 16; ++i) { const int ql = 16 * w + i; const int t = 128 * qb + ql;
            const int lo = 32 * lane;
            const unsigned causal = (t >= lo + 31) ? 0xffffffffu : (t < lo ? 0u : ((2u << (t - lo)) - 1u));
            unsigned word = causal;
            if (qb >= 2) {
                const GAS v4u* rp = (const GAS v4u*)(SC + (size_t)ql * 2048 + 32 * lane);
                unsigned key[32];
#pragma unroll
                for (int k = 0; k < 4; ++k) { const v4u raw = rp[k];
#pragma unroll
                    for (int c = 0; c < 4; ++c) { const unsigned dd = raw[c]; const int idx = 8 * k + 2 * c;
                        key[idx] = ((causal >> idx) & 1u) ? okey(dd & 0xffffu) : 0u; key[idx + 1] = ((causal >> (idx + 1)) & 1u) ? okey(dd >> 16) : 0u; } }
                *(LAS v4u*)(hist + 4 * lane) = (v4u){0u, 0u, 0u, 0u};
                asm volatile("s_waitcnt lgkmcnt(0)" ::: "memory");
#pragma unroll
                for (int k = 0; k < 32; ++k) __hip_atomic_fetch_add((unsigned*)(hist + (key[k] >> 8)), 1u, __ATOMIC_RELAXED, __HIP_MEMORY_SCOPE_WORKGROUP);
                asm volatile("s_waitcnt lgkmcnt(0)" ::: "memory");
                v4u cnt = *(const LAS v4u*)(hist + 4 * lane);
                unsigned b1, r1; radix_scan(cnt, 256u, lane, b1, r1);
                asm volatile("s_waitcnt lgkmcnt(0)" ::: "memory");
                *(LAS v4u*)(hist + 4 * lane) = (v4u){0u, 0u, 0u, 0u};
                asm volatile("s_waitcnt lgkmcnt(0)" ::: "memory");
#pragma unroll
                for (int k = 0; k < 32; ++k) { if ((key[k] >> 8) == b1) __hip_atomic_fetch_add((unsigned*)(hist + (key[k] & 255u)), 1u, __ATOMIC_RELAXED, __HIP_MEMORY_SCOPE_WORKGROUP); }
                asm volatile("s_waitcnt lgkmcnt(0)" ::: "memory");
                cnt = *(const LAS v4u*)(hist + 4 * lane);
                unsigned b2, r2; radix_scan(cnt, r1, lane, b2, r2);
                asm volatile("s_waitcnt lgkmcnt(0)" ::: "memory");
                const unsigned thr = (b1 << 8) | b2;
                unsigned sel = 0u;
#pragma unroll
                for (int k = 0; k < 32; ++k) sel |= (key[k] >= thr ? 1u : 0u) << k;
                word = sel & causal;
            }
            MK[ql * 64 + lane] = word;
        }
    }
#endif
    block_sync_mem();
#ifndef NO_PASSC
#pragma unroll 1
    for (int hh = 0; hh < 4; ++hh) {
        const int hA = 4 * kh + hh;
        bf16x8 qa[4];
#pragma unroll
        for (int kk = 0; kk < 4; ++kk) qa[kk] = *(const GAS bf16x8*)(F.Q + rowq * 512 + hA * 64 + kk * 16 + 8 * h);
        f32x16 oA0, oA1;
#pragma unroll
        for (int r = 0; r < 16; ++r) { oA0[r] = 0.f; oA1[r] = 0.f; }
        float mA = -1e30f, lA = 0.f;
#pragma unroll 1
        for (int j = 0; j < ntile; ++j) {
            asm volatile("" ::: "memory");
            const size_t rowk = (size_t)b * SEQ + 32 * j + q;
            bf16x8 kf[4];
#pragma unroll
            for (int kk = 0; kk < 4; ++kk) kf[kk] = *(const GAS bf16x8*)(F.K + rowk * 128 + kh * 64 + kk * 16 + 8 * h);
            const unsigned mwh = MK[(32 * g + q) * 64 + j] >> (4 * h);
            bf16x8 vt[2][2];
#pragma unroll
            for (int dt = 0; dt < 2; ++dt)
#pragma unroll
                for (int sp = 0; sp < 2; ++sp) { const bf16* vp = F.VT + ((size_t)(b * 2 + kh) * 64 + dt * 32 + q) * 2048 + 32 * j + 16 * sp + 4 * h;
                    const u32x2 lo = *(const GAS u32x2*)vp, hi = *(const GAS u32x2*)(vp + 8);
                    vt[dt][sp] = __builtin_bit_cast(bf16x8, ((v4u){lo.x, lo.y, hi.x, hi.y})); }
            f32x16 sA;
#pragma unroll
            for (int r = 0; r < 16; ++r) sA[r] = 0.f;
#pragma unroll
            for (int kk = 0; kk < 4; ++kk) sA = MFMA32(kf[kk], qa[kk], sA);
            float mx = -INFINITY;
#pragma unroll
            for (int r = 0; r < 16; ++r) { const bool on = (mwh >> ((r & 3) + 8 * (r >> 2))) & 1u; sA[r] = on ? sA[r] : -INFINITY; mx = fmaxf(mx, sA[r]); }
            mx = fmaxf(mx, __shfl_xor(mx, 32));
            const float mn = fmaxf(mA, mx); const float al = __builtin_amdgcn_exp2f(mA - mn); mA = mn; float ls = 0.f;
#pragma unroll
            for (int r = 0; r < 16; ++r) { sA[r] = __builtin_amdgcn_exp2f(sA[r] - mn); ls += sA[r]; }
            lA = lA * al + ls;
#pragma unroll
            for (int r = 0; r < 16; ++r) { oA0[r] *= al; oA1[r] *= al; }
            v4u pk; pk.x = pkbf(sA[0], sA[1]); pk.y = pkbf(sA[2], sA[3]); pk.z = pkbf(sA[4], sA[5]); pk.w = pkbf(sA[6], sA[7]); const bf16x8 pA0 = __builtin_bit_cast(bf16x8, pk);
            pk.x = pkbf(sA[8], sA[9]); pk.y = pkbf(sA[10], sA[11]); pk.z = pkbf(sA[12], sA[13]); pk.w = pkbf(sA[14], sA[15]); const bf16x8 pA1 = __builtin_bit_cast(bf16x8, pk);
            oA0 = MFMA32(vt[0][0], pA0, oA0); oA0 = MFMA32(vt[0][1], pA1, oA0); oA1 = MFMA32(vt[1][0], pA0, oA1); oA1 = MFMA32(vt[1][1], pA1, oA1);
        }
        lA += __shfl_xor(lA, 32);
        const float iA = 1.0f / lA;
        bf16* yrow = YB + (size_t)(32 * g + q) * 512 + hA * 64 + 4 * h;
#pragma unroll
        for (int qd = 0; qd < 4; ++qd) { u32x2 o;
            o.x = pkbf(oA0[4 * qd] * iA, oA0[4 * qd + 1] * iA); o.y = pkbf(oA0[4 * qd + 2] * iA, oA0[4 * qd + 3] * iA); *(GAS u32x2*)(yrow + 8 * qd) = o;
            o.x = pkbf(oA1[4 * qd] * iA, oA1[4 * qd + 1] * iA); o.y = pkbf(oA1[4 * qd + 2] * iA, oA1[4 * qd + 3] * iA); *(GAS u32x2*)(yrow + 32 + 8 * qd) = o; }
    }
#endif
    block_sync_mem();
    {
        const f32x4 go0 = *(const f32x4*)(F.g_out_attn + 8 * lane), go1 = *(const f32x4*)(F.g_out_attn + 8 * lane + 4);
        for (int i = 0; i < 16; ++i) { const int ql = 16 * w + i; const size_t row = (size_t)b * SEQ + 128 * qb + ql;
            const v4u raw = *(const GAS v4u*)(YB + (size_t)ql * 512 + 8 * lane);
            f32x4 a = {bflo(raw.x), bfhi(raw.x), bflo(raw.y), bfhi(raw.y)}, c = {bflo(raw.z), bfhi(raw.z), bflo(raw.w), bfhi(raw.w)};
            const float ss = wave_sum((a.x * a.x + a.y * a.y) + (a.z * a.z + a.w * a.w) + (c.x * c.x + c.y * c.y) + (c.z * c.z + c.w * c.w));
            const float rstd = rsqrtf(ss * (1.f / 512.f) + EPS);
            a = a * rstd * go0; c = c * rstd * go1;
            v4u o; o.x = pkbf(a.x, a.y); o.y = pkbf(a.z, a.w); o.z = pkbf(c.x, c.y); o.w = pkbf(c.z, c.w);
            *(GAS v4u*)(F.MERGED + row * D + 512 + 8 * lane) = o; }
    }
    block_sync_mem();
}

struct Args { const void* in[18]; float* out; unsigned char* ws; int ph_lo, ph_hi; };
__global__ void __launch_bounds__(NWAVES * 64, 2) fwd_kernel(Args args) {
    extern __shared__ __attribute__((aligned(16))) unsigned char lds[];
    Frame F;
    F.lds = (LAS unsigned char*)lds;
    F.MISC = (volatile LAS unsigned*)(F.lds + MISC_OFF);
    F.tid = threadIdx.x; F.lane = F.tid & 63; F.wave = __builtin_amdgcn_readfirstlane(F.tid >> 6);
    F.G = gridDim.x; { const int bx = blockIdx.x; F.vcu = (F.G % 8 == 0) ? (bx % 8) * (F.G / 8) + bx / 8 : bx; }
    unsigned char* ws = args.ws;
    F.ctl = (gu32*)(ws + WS_CTL);
    F.x = (const float*)args.in[0]; F.c = (const float*)args.in[1]; F.pos = (const int*)args.in[2]; F.w_ada = (const float*)args.in[3]; F.b_ada = (const float*)args.in[4];
    F.g_pre_mix = (const float*)args.in[5]; F.w_in = (const float*)args.in[6]; F.g_sgu_v = (const float*)args.in[7]; F.w_spatial = (const float*)args.in[8]; F.b_spatial = (const float*)args.in[9];
    F.g_out_sgu = (const float*)args.in[10]; F.g_out_attn = (const float*)args.in[11]; F.w_out = (const float*)args.in[12]; F.g_post_mix = (const float*)args.in[13]; F.g_pre_ffn = (const float*)args.in[14];
    F.w_ff1 = (const float*)args.in[15]; F.w_ff2 = (const float*)args.in[16]; F.g_post_ffn = (const float*)args.in[17];
    F.out = args.out;
    F.MOD = (float*)(ws + WS_MOD); F.COS = (float*)(ws + WS_COS); F.SIN = (float*)(ws + WS_SIN); F.PART = (float*)(ws + WS_PART); F.WI = (float*)(ws + WS_WI);
    F.WM = (bf16*)(ws + WS_WM); F.WIN = (bf16*)(ws + WS_WIN); F.WOUT = (bf16*)(ws + WS_WOUT); F.W1 = (bf16*)(ws + WS_W1); F.W2 = (bf16*)(ws + WS_W2);
    F.H = (bf16*)(ws + WS_H); F.ZU = (bf16*)(ws + WS_ZU); F.ZV = (bf16*)(ws + WS_ZV); F.Q = (bf16*)(ws + WS_Q); F.K = (bf16*)(ws + WS_K); F.VT = (bf16*)(ws + WS_VT);
    F.QI = (bf16*)(ws + WS_QI); F.KI = (bf16*)(ws + WS_KI); F.MERGED = (bf16*)(ws + WS_MERGED); F.O = (bf16*)(ws + WS_O); F.HB = (bf16*)(ws + WS_HB); F.FB = (bf16*)(ws + WS_F);
    F.scr = ws + WS_SCR + (size_t)blockIdx.x * SCR_PER_WG;
    for (int u = F.tid; u < (LDS_BYTES - LDSCTL_OFF) / 4; u += NWAVES * 64) ((LAS unsigned*)(F.lds + LDSCTL_OFF))[u] = 0u;
    __syncthreads();
    const int lo = args.ph_lo, hi = args.ph_hi;
    const bool fusedrun = (hi - lo) > 1;
    XcdBarrier bar; bar.bar = (unsigned*)(F.ctl + CW_BAR); bar.x = 0; bar.st = nullptr;
    if (fusedrun) bar = xcd_barrier_post((unsigned*)(F.ctl + CW_BAR), F.MISC + 8);
#define IN(k) (lo <= (k) && (k) < hi)
#ifdef ONLY_PHASE
#define PHASE_ON(k) ((k) == ONLY_PHASE)
#else
#define PHASE_ON(k) true
#endif
#define SEAM(k) do { if (IN(k) && IN((k) + 1)) xcd_barrier(bar); } while (0)

    if (PHASE_ON(0) && IN(0)) { p0_prologue(F); SEAM(0); }
    if (PHASE_ON(1) && IN(1)) { p1_hprep(F); SEAM(1); }
    if (PHASE_ON(2) && IN(2)) {
        pg8::Gemm g{F.H, F.WIN, M, DINP, D}; pg8::StaticOrder S; S.init(M, DINP, F.G, (int)blockIdx.x);
        pg8::EpiProj E{F.ZU, F.ZV, F.Q, F.K, F.VT, F.QI, F.KI, F.WI, F.COS, F.SIN};
        pg8::gemm_phase<pg8::EpiProj, pg8::StaticOrder, PG8_ALIGN, PG8_SP2>(F.lds + RING_OFF, g, S, E);
        SEAM(2);
    }
    if (PHASE_ON(3) && IN(3)) {
#ifndef NO_SGU
        for (int u = F.vcu; u < BATCH * 16; u += F.G) sgu_unit(F, u >> 4, u & 15);
#endif
        for (int u = F.vcu; u < BATCH * 8; u += F.G) { const int b = u >> 3, p = u & 7;
#pragma unroll 1
            for (int k = 0; k < 2; ++k) dsa_unit(F, b, k ? p : 15 - p); }
        SEAM(3);
    }
    if (PHASE_ON(4) && IN(4)) {
        pg8::Gemm g{F.MERGED, F.WOUT, M, D, D}; pg8::StaticOrder S; S.init(M, D, F.G, (int)blockIdx.x);
        pg8::EpiNormPart E{F.O, D, F.PART};
        pg8::gemm_phase<pg8::EpiNormPart, pg8::StaticOrder, PG8_ALIGN, PG8_SP2>(F.lds + RING_OFF, g, S, E);
        SEAM(4);
    }
    if (PHASE_ON(5) && IN(5)) { p5_postmix(F); SEAM(5); }
    if (PHASE_ON(6) && IN(6)) {
        pg8::Gemm g{F.H, F.W1, M, FF, D}; pg8::StaticOrder S; S.init(M, FF, F.G, (int)blockIdx.x);
        pg8::EpiRelu2 E{F.HB, FF};
        pg8::gemm_phase<pg8::EpiRelu2, pg8::StaticOrder, PG8_ALIGN, PG8_SP2>(F.lds + RING_OFF, g, S, E);
        SEAM(6);
    }
    if (PHASE_ON(7) && IN(7)) {
        pg8::Gemm g{F.HB, F.W2, M, D, FF}; pg8::StaticOrder S; S.init(M, D, F.G, (int)blockIdx.x);
        pg8::EpiNormPart E{F.FB, D, F.PART};
        pg8::gemm_phase<pg8::EpiNormPart, pg8::StaticOrder, PG8_ALIGN, PG8_SP2>(F.lds + RING_OFF, g, S, E);
        SEAM(7);
    }
    if (PHASE_ON(8) && IN(8)) { p8_final(F);
#ifdef DIAG
        {
            asm volatile("s_waitcnt vmcnt(0)" ::: "memory"); __syncthreads();
            float code = 0.f;
#pragma unroll
            for (int k = 0; k < 4; ++k) { const float e = __builtin_bit_cast(float, __hip_atomic_load(F.ctl + 8192 + DIAG_SET * 4 + k, __ATOMIC_RELAXED, __HIP_MEMORY_SCOPE_AGENT)); if (e > DIAG_TOL) code += 0.25f * (float)(1 << k); }
            const int gw = F.vcu * NWAVES + F.wave, NGW = F.G * NWAVES;
            for (int chunk = gw; chunk < M / 32; chunk += NGW) for (int r = 0; r < 32; ++r) { GAS f32x4* outr = (GAS f32x4*)(F.out + ((size_t)chunk * 32 + r) * D) + F.lane;
#pragma unroll
                for (int j = 0; j < 4; ++j) outr[64 * j] = outr[64 * j] * (1.0f + code); }
        }
#endif
    }
#undef IN
#undef SEAM
}


#ifdef DIAG
constexpr int CW_DIAG = 8192;
__device__ __forceinline__ void diag_max(gu32* ctl, int k, float err) { if (!(err == err)) err = 1e30f; atomicMax((unsigned*)(ctl + CW_DIAG + k), __builtin_bit_cast(unsigned, err)); }
__device__ __forceinline__ float relerr(float got, float want, float floor_) { return __builtin_fabsf(got - want) / (__builtin_fabsf(want) + floor_); }
__device__ __forceinline__ float bf2f(bf16 v) { return __builtin_bit_cast(float, (unsigned)v << 16); }
__device__ __forceinline__ float h2f(unsigned short v) { return (float)__builtin_bit_cast(_Float16, v); }
__device__ __forceinline__ float wave_max(float v) {
#pragma unroll
    for (int o = 1; o < 64; o <<= 1) v = fmaxf(v, __shfl_xor(v, o));
    return v;
}
__device__ __forceinline__ float gelu_ref(float p) { return p / (1.0f + __expf(-1.5957691216057308f * (p + 0.044715f * p * p * p))); }
__global__ void __launch_bounds__(512) diag_kernel(Args args) {
    __shared__ float pr[8][2400];
    unsigned char* ws = args.ws; gu32* ctl = (gu32*)(ws + WS_CTL);
    const float* x = (const float*)args.in[0]; const float* cc_ = (const float*)args.in[1]; const float* w_ada = (const float*)args.in[3]; const float* b_ada = (const float*)args.in[4];
    const float* g_pre_mix = (const float*)args.in[5]; const float* g_sgu_v = (const float*)args.in[7]; const float* b_spatial = (const float*)args.in[9]; const float* g_out_sgu = (const float*)args.in[10];
    const float* MOD = (const float*)(ws + WS_MOD); const float* COS = (const float*)(ws + WS_COS); const float* SIN = (const float*)(ws + WS_SIN); const float* WI = (const float*)(ws + WS_WI);
    const bf16 *WM = (const bf16*)(ws + WS_WM), *WIN = (const bf16*)(ws + WS_WIN), *H = (const bf16*)(ws + WS_H), *ZU = (const bf16*)(ws + WS_ZU), *ZV = (const bf16*)(ws + WS_ZV), *Q = (const bf16*)(ws + WS_Q), *K = (const bf16*)(ws + WS_K),
               *VT = (const bf16*)(ws + WS_VT), *QI = (const bf16*)(ws + WS_QI), *KI = (const bf16*)(ws + WS_KI), *MERGED = (const bf16*)(ws + WS_MERGED);
    const int tid = threadIdx.x, lane = tid & 63, w = tid >> 6, G = gridDim.x; const int bx = blockIdx.x, vcu = (G % 8 == 0) ? (bx % 8) * (G / 8) + bx / 8 : bx; const int gw = vcu * 8 + w;
    {
        const size_t m = ((size_t)gw * 97 + 13) % M; const size_t b = m >> 11, s = m & 2047;
#pragma unroll 1
        for (int i = 0; i < 38; ++i) { const int col = lane + 64 * i; float acc = 0.f;
            if (col < DIN) {
#pragma unroll 4
                for (int k = 0; k < D; ++k) acc += bf2f(H[m * D + k]) * bf2f(WIN[(size_t)col * D + k]);
                pr[w][col] = acc; } }
        __syncthreads();
#pragma unroll 1
        for (int i = 0; i < 38; ++i) { const int col = lane + 64 * i; if (col >= DIN) break;
            const float p = pr[w][col];
            if (col < 1024) { const float got = bf2f(col < 512 ? ZU[m * 512 + col] : ZV[m * 512 + col - 512]); diag_max(ctl, 4, relerr(got, gelu_ref(p), 0.05f)); }
            else if (col < 1664) { const bool isq = col < 1536; const int cc = isq ? col - 1024 : col - 1536; const int d = cc & 63; float v = p;
                if (d < 8) v = p * COS[m * 8 + d] - pr[w][col + 8] * SIN[m * 8 + d]; else if (d < 16) v = p * COS[m * 8 + d - 8] + pr[w][col - 8] * SIN[m * 8 + d - 8];
                if (isq) v *= 0.18033688011112042f;
                const float got = bf2f(isq ? Q[m * 512 + cc] : K[m * 128 + cc]); diag_max(ctl, 5, relerr(got, v, 0.05f)); }
            else if (col < 1792) { const int cc = col - 1664, kvh = cc >> 6, d = cc & 63; const float got = bf2f(VT[((b * 2 + kvh) * 64 + d) * 2048 + s]); diag_max(ctl, 6, relerr(got, p, 0.05f)); }
            else if (col < 2368) { const bool isq = col < 2304; const int cc = isq ? col - 1792 : col - 2304; const int d = cc & 63; float v = p;
                if (d < 8) v = p * COS[m * 8 + d] - pr[w][col + 8] * SIN[m * 8 + d]; else if (d < 16) v = p * COS[m * 8 + d - 8] + pr[w][col - 8] * SIN[m * 8 + d - 8];
                if (isq) v *= 0.125f;
                const float got = bf2f(isq ? QI[m * 512 + cc] : KI[m * 64 + cc]); diag_max(ctl, 5, relerr(got, v, 0.05f)); }
            else { const float got = WI[m * 8 + col - 2368]; diag_max(ctl, 6, relerr(got, p * 0.3535533905932738f, 0.05f)); } }
        { const int bb = gw & 31, e = (gw * 131 + 7) % 6144; float acc = 0.f;
          for (int k = lane; k < D; k += 64) { const float cv = cc_[bb * D + k]; acc += cv / (1.0f + __expf(-cv)) * w_ada[(size_t)k * 6144 + e]; }
          acc = wave_sum(acc) + b_ada[e]; diag_max(ctl, 7, relerr(MOD[bb * 6144 + e], acc, 0.02f)); }
        { float ss = 0.f; for (int k = lane; k < D; k += 64) { const float xv = x[m * D + k]; ss += xv * xv; }
          const float rstd = rsqrtf(wave_sum(ss) / D + EPS); const int k = (lane * 17 + 3) & 1023; const float* mod = MOD + b * 6144;
          const float want = x[m * D + k] * rstd * g_pre_mix[k] * (1.f + mod[1024 + k]) + mod[k]; diag_max(ctl, 7, relerr(bf2f(H[m * D + k]), want, 0.02f)); }
    }
    {
        const size_t m = ((size_t)gw * 61 + 29) % M; const size_t R0 = m & ~(size_t)127; const int tc = (int)(m & 127);
        float ssq = 0.f;
#pragma unroll 1
        for (int pass = 0; pass < 2; ++pass) { const float rs = rsqrtf(wave_sum(ssq) * (1.f / 512.f) + EPS);
#pragma unroll 1
            for (int e = 0; e < 8; ++e) { const int c = 8 * lane + e, g = c >> 7; float mix = 0.f;
#pragma unroll 1
                for (int s2 = 0; s2 <= tc; ++s2) {
                    float gs = 0.f; for (int k = 0; k < 128; ++k) { const float zv = bf2f(ZV[(R0 + s2) * 512 + g * 128 + k]); gs += zv * zv; }
                    const float vnv = bf2f((bf16)f2bf(bf2f(ZV[(R0 + s2) * 512 + c]) * rsqrtf(gs * (1.f / 128.f) + EPS) * g_sgu_v[c]));
                    mix += bf2f(WM[(g * 128 + tc) * 128 + s2]) * vnv; }
                const float yv = (mix + b_spatial[g * 128 + tc]) * bf2f(ZU[(R0 + tc) * 512 + c]);
                if (pass == 0) ssq += yv * yv; else diag_max(ctl, 3, relerr(bf2f(MERGED[(R0 + tc) * D + c]), yv * rs * g_out_sgu[c], 0.05f)); } }
    }
    if (vcu < 256) {
        const int b = vcu >> 3, qb = vcu & 7;
        const unsigned char* scr = ws + WS_SCR + (size_t)blockIdx.x * SCR_PER_WG;
        const unsigned short* SC = (const unsigned short*)(scr + SCR_SC); const unsigned* MK = (const unsigned*)(scr + SCR_MK); const bf16* YB = (const bf16*)(scr + SCR_YB);
#pragma unroll 1
        for (int i = 0; i < 16; ++i) { const int ql = 16 * w + i, t = 128 * qb + ql; int pc = __builtin_popcount(MK[ql * 64 + lane]);
#pragma unroll
            for (int o = 1; o < 64; o <<= 1) pc += __shfl_xor(pc, o);
            const int want = (t + 1 < 256) ? t + 1 : 256; if (pc < want || pc > want + 16) diag_max(ctl, 0, 1.0f + (float)(pc > want ? pc - want : want - pc)); }
        if (qb >= 2) { const int ql = 16 * w + 5, t = 128 * qb + ql; const size_t row = (size_t)b * SEQ + t; const int s2 = (lane * 37 + w * 11) % (t + 1); const size_t krow = (size_t)b * SEQ + s2;
            float sc2 = 0.f;
#pragma unroll 1
            for (int hd = 0; hd < 8; ++hd) { float d = 0.f; for (int dd = 0; dd < 64; ++dd) d += bf2f(QI[row * 512 + hd * 64 + dd]) * bf2f(KI[krow * 64 + dd]); sc2 += WI[row * 8 + hd] * fmaxf(d, 0.f); }
            diag_max(ctl, 1, relerr(h2f(SC[(size_t)ql * 2048 + s2]), sc2, 0.05f));
            float mins = INFINITY, maxu = -INFINITY;
#pragma unroll 1
            for (int s3 = lane; s3 <= t; s3 += 64) { const float v = h2f(SC[(size_t)ql * 2048 + s3]); if ((MK[ql * 64 + (s3 >> 5)] >> (s3 & 31)) & 1u) mins = fminf(mins, v); else maxu = fmaxf(maxu, v); }
            mins = -wave_max(-mins); maxu = wave_max(maxu); if (maxu > mins) diag_max(ctl, 0, 100.0f); }
        { const int ql = 16 * w + 9, t = 128 * qb + ql, hd = w, kvh = hd >> 2; const size_t row = (size_t)b * SEQ + t;
          const float qd = bf2f(Q[row * 512 + hd * 64 + lane]); float mrun = -1e30f, lrun = 0.f, o = 0.f;
#pragma unroll 1
          for (int s2 = 0; s2 <= t; ++s2) { if (!((MK[ql * 64 + (s2 >> 5)] >> (s2 & 31)) & 1u)) continue;
              const float lg = wave_sum(qd * bf2f(K[((size_t)b * SEQ + s2) * 128 + kvh * 64 + lane]));
              const float mn = fmaxf(mrun, lg), al = __builtin_amdgcn_exp2f(mrun - mn), p = __builtin_amdgcn_exp2f(lg - mn);
              lrun = lrun * al + p; o = o * al + p * bf2f(VT[((size_t)(b * 2 + kvh) * 64 + lane) * 2048 + s2]); mrun = mn; }
          diag_max(ctl, 2, relerr(bf2f(YB[(size_t)ql * 512 + hd * 64 + lane]), o / lrun, 0.02f)); }
    }
}
#endif

extern "C" void kernel_launch(void* const* d_in, const int* in_sizes, int n_in, void* d_out, int out_size, void* d_ws, size_t ws_size, hipStream_t stream) {
    static int grid = 0;
    if (grid == 0) {
        if (n_in != 18 || in_sizes[0] != M * D || out_size != M * D || ws_size < WS_END) { fprintf(stderr, "kernel_launch: unexpected problem shape or workspace (n_in %d, ws %zu < %zu)\n", n_in, ws_size, (size_t)WS_END); grid = -1; return; }
        int dev = 0, cus = 0, per_cu = 0;
        if (hipGetDevice(&dev) != hipSuccess || hipDeviceGetAttribute(&cus, hipDeviceAttributeMultiprocessorCount, dev) != hipSuccess) { grid = -1; return; }
        if (hipFuncSetAttribute((const void*)fwd_kernel, hipFuncAttributeMaxDynamicSharedMemorySize, LDS_BYTES) != hipSuccess) { grid = -1; return; }
        if (hipOccupancyMaxActiveBlocksPerMultiprocessor(&per_cu, (const void*)fwd_kernel, NWAVES * 64, LDS_BYTES) != hipSuccess || per_cu < 1) { fprintf(stderr, "kernel_launch: occupancy query reports %d workgroups per CU\n", per_cu); }
        (void)hipGetLastError();
        grid = cus;
    }
    if (grid < 0) return;
    if (hipMemsetAsync((char*)d_ws + WS_CTL, 0, CTL_ZERO_BYTES, stream) != hipSuccess) return;
    Args a{};
    for (int i = 0; i < 18; ++i) a.in[i] = d_in[i];
    a.out = (float*)d_out; a.ws = (unsigned char*)d_ws;
#if MK_N_LAUNCHES == 1
    a.ph_lo = 0; a.ph_hi = N_PHASES;
    hipLaunchKernelGGL(fwd_kernel, dim3(grid), dim3(NWAVES * 64), LDS_BYTES, stream, a);
#else
    for (int li = 0; li < N_PHASES; ++li) { a.ph_lo = li; a.ph_hi = li + 1; hipLaunchKernelGGL(fwd_kernel, dim3(grid), dim3(NWAVES * 64), LDS_BYTES, stream, a);
#ifdef DIAG
        if (li == 3) hipLaunchKernelGGL(diag_kernel, dim3(grid), dim3(512), 0, stream, a);
#endif
    }
#endif
}
```

```cpp
#include <hip/hip_runtime.h>
#include <cstdio>
#include <cstdint>
#define MK_N_LAUNCHES 1
namespace pg8 {
#define PG8_LAS __attribute__((address_space(3)))
typedef unsigned short bf16_t;
typedef short bf16x8 __attribute__((ext_vector_type(8)));
typedef float f32x4 __attribute__((ext_vector_type(4)));
typedef unsigned u32x4 __attribute__((ext_vector_type(4)));
constexpr int BM = 256, BK = 64, HALF = 128, HTB = HALF * BK * 2  , STAGE_BYTES = 8 * HTB, NXCD = 8, WGM = 8;

__host__ __device__ __forceinline__ int lds_byte(int r, int c) { const int st = (r >> 4) * 2 + (c >> 5), rr = r & 15, cc = c & 31, ob = rr * 64 + cc * 2; return st * 1024 + (ob ^ (((ob >> 9) & 1) << 5)); }
__host__ __device__ __forceinline__ void stage_rc(int b, int& R, int& C) { const int st = b / 1024, sb = b % 1024, swz = sb ^ (((sb >> 9) & 1) << 5); R = (st >> 1) * 16 + swz / 64; C = (st & 1) * 32 + (swz % 64) / 2; }
__host__ __device__ __forceinline__ int perm32(int rho) { const int n = rho >> 4, i = rho & 15; return 8 * (i >> 2) + 4 * n + (i & 3); }

struct Unit { int pm, pn; };
struct Gemm { const bf16_t* A; const bf16_t* Bt; int M, N, K; };

struct StaticOrder {
    int nM, nN, nwg, G, c;
    __host__ __device__ void init(int M, int N, int G_, int c_) { nM = M / BM; nN = N / BM; nwg = nM * nN; G = G_; c = c_; }
    __host__ __device__ bool next(int i, Unit& u) const {
        const long L = (long)i * G + c; if (L >= nwg) return false;
        int wgid = (int)L; { const int q = nwg / NXCD, r = nwg % NXCD, xcd = wgid % NXCD, off = wgid / NXCD; wgid = (xcd < r ? xcd * (q + 1) : r * (q + 1) + (xcd - r) * q) + off; }
        const int nig = WGM * nN, gid = wgid / nig, fm = gid * WGM, gsz = (nM - fm) < WGM ? (nM - fm) : WGM;
        u.pm = fm + ((wgid % nig) % gsz); u.pn = (wgid % nig) / gsz; return true;
    }
    __device__ __forceinline__ void a_ready(const Unit&) const {}
    __device__ __forceinline__ void done(const Unit&) const {}
};
__device__ __forceinline__ unsigned cvt_pk_bf16(float lo, float hi) { unsigned r; asm volatile("v_cvt_pk_bf16_f32 %0, %1, %2" : "=v"(r) : "v"(lo), "v"(hi)); return r; }
typedef unsigned u32x2 __attribute__((ext_vector_type(2)));
__device__ __forceinline__ float gelu_tanh(float x) {
    const float u = x * (1.0f + 0.044715f * x * x);
    const float e = __builtin_amdgcn_exp2f(-2.302208198f * u);
    return x * __builtin_amdgcn_rcpf(1.0f + e);
}
__device__ __forceinline__ void store8(bf16_t* p, const f32x4& v0, const f32x4& v1) {
    u32x4 w; w.x = cvt_pk_bf16(v0[0], v0[1]); w.y = cvt_pk_bf16(v0[2], v0[3]); w.z = cvt_pk_bf16(v1[0], v1[1]); w.w = cvt_pk_bf16(v1[2], v1[3]);
    *(u32x4*)p = w;
}
__device__ __forceinline__ void rope8(f32x4& v0, f32x4& v1, const f32x4& c0, const f32x4& c1, const f32x4& s0, const f32x4& s1, int fq) {
    f32x4 p0, p1;
#pragma unroll
    for (int i = 0; i < 4; ++i) { p0[i] = __shfl_xor(v0[i], 16); p1[i] = __shfl_xor(v1[i], 16); }
    const float sg = (fq == 0) ? -1.f : 1.f;
    if (fq < 2) { v0 = v0 * c0 + sg * (p0 * s0); v1 = v1 * c1 + sg * (p1 * s1); }
}
constexpr float QSCALE = 0.18033688011112042f;
constexpr float QISCALE = 0.125f;
constexpr float WISCALE = 0.3535533905932738f;
struct EpiProj {
    static constexpr bool PERM = true, AFTER_DRAIN = false;
    bf16_t *ZU, *ZV, *Q, *K, *VT, *QI, *KI; float* WI; const float* cs; const float* sn; unsigned* KN;
    __device__ __forceinline__ void operator()(const f32x4 (&acc)[2][2][4][2], const Unit& u, int wr, int wc, int fr, int fq) const {
        const int pn = u.pn; const int row0 = u.pm * BM + wr * 64 + fr; const int cw = wc * 32 + 8 * fq;
        if (pn < 4) {
            bf16_t* base = (pn < 2) ? ZU : ZV; const int colt = (pn & 1) * 256;
#pragma unroll
            for (int ai = 0; ai < 2; ++ai)
#pragma unroll
                for (int m = 0; m < 4; ++m) { const size_t row = (size_t)(row0 + ai * HALF + m * 16);
#pragma unroll
                    for (int bj = 0; bj < 2; ++bj) { f32x4 v0 = acc[ai][bj][m][0], v1 = acc[ai][bj][m][1];
#pragma unroll
                        for (int i = 0; i < 4; ++i) { v0[i] = gelu_tanh(v0[i]); v1[i] = gelu_tanh(v1[i]); }
                        store8(base + row * 512 + colt + bj * HALF + cw, v0, v1); } }
        } else if (pn == 4 || pn == 5 || pn == 7 || pn == 8) {
            const bool isq = pn < 6; bf16_t* base = isq ? Q : QI; const int colt = (isq ? pn - 4 : pn - 7) * 256; const float sc = isq ? QSCALE : QISCALE;
            const bool rope = (wc & 1) == 0;
#pragma unroll
            for (int ai = 0; ai < 2; ++ai)
#pragma unroll
                for (int m = 0; m < 4; ++m) { const size_t row = (size_t)(row0 + ai * HALF + m * 16);
                    f32x4 c0 = {1.f, 1.f, 1.f, 1.f}, c1 = c0, s0 = {0.f, 0.f, 0.f, 0.f}, s1 = s0;
                    if (rope) { c0 = *(const f32x4*)(cs + row * 8); c1 = *(const f32x4*)(cs + row * 8 + 4); s0 = *(const f32x4*)(sn + row * 8); s1 = *(const f32x4*)(sn + row * 8 + 4); }
#pragma unroll
                    for (int bj = 0; bj < 2; ++bj) { f32x4 v0 = acc[ai][bj][m][0], v1 = acc[ai][bj][m][1];
                        if (rope) rope8(v0, v1, c0, c1, s0, s1, fq);
                        v0 = v0 * sc; v1 = v1 * sc;
                        store8(base + row * 512 + colt + bj * HALF + cw, v0, v1); } }
        } else if (pn == 6) {
            const bool rope = (wc & 1) == 0; float kn = 0.f;
#pragma unroll
            for (int ai = 0; ai < 2; ++ai)
#pragma unroll
                for (int m = 0; m < 4; ++m) { const size_t row = (size_t)(row0 + ai * HALF + m * 16);
                    { f32x4 v0 = acc[ai][0][m][0], v1 = acc[ai][0][m][1];
                      if (rope) { const f32x4 c0 = *(const f32x4*)(cs + row * 8), c1 = *(const f32x4*)(cs + row * 8 + 4), s0 = *(const f32x4*)(sn + row * 8), s1 = *(const f32x4*)(sn + row * 8 + 4);
                                  rope8(v0, v1, c0, c1, s0, s1, fq); }
                      store8(K + row * 128 + cw, v0, v1);
                      float rs = (v0[0] * v0[0] + v0[1] * v0[1]) + (v0[2] * v0[2] + v0[3] * v0[3]) + (v1[0] * v1[0] + v1[1] * v1[1]) + (v1[2] * v1[2] + v1[3] * v1[3]);
                      rs += __shfl_xor(rs, 16); rs += __shfl_xor(rs, 32); kn = fmaxf(kn, rs); }
                    { const f32x4 v0 = acc[ai][1][m][0], v1 = acc[ai][1][m][1];
                      const size_t b = row >> 11, s = row & 2047; const int kvh = cw >> 6, d0 = cw & 63;
                      bf16_t* vp = VT + ((b * 2 + kvh) * 64 + d0) * 2048 + s;
                      const unsigned w0 = cvt_pk_bf16(v0[0], v0[1]), w1 = cvt_pk_bf16(v0[2], v0[3]), w2 = cvt_pk_bf16(v1[0], v1[1]), w3 = cvt_pk_bf16(v1[2], v1[3]);
                      vp[0 * 2048] = (bf16_t)(w0 & 0xffffu); vp[1 * 2048] = (bf16_t)(w0 >> 16); vp[2 * 2048] = (bf16_t)(w1 & 0xffffu); vp[3 * 2048] = (bf16_t)(w1 >> 16);
                      vp[4 * 2048] = (bf16_t)(w2 & 0xffffu); vp[5 * 2048] = (bf16_t)(w2 >> 16); vp[6 * 2048] = (bf16_t)(w3 & 0xffffu); vp[7 * 2048] = (bf16_t)(w3 >> 16); } }
            kn = fmaxf(kn, __shfl_xor(kn, 1)); kn = fmaxf(kn, __shfl_xor(kn, 2)); kn = fmaxf(kn, __shfl_xor(kn, 4)); kn = fmaxf(kn, __shfl_xor(kn, 8));
            if (fr == 0 && fq == 0) atomicMax(KN + ((u.pm >> 3) * 2 + (wc >> 1)) * 2 + (wc & 1), __float_as_uint(kn));
        } else {
            if (wc < 2) {
                const bool rope = wc == 0;
#pragma unroll
                for (int ai = 0; ai < 2; ++ai)
#pragma unroll
                    for (int m = 0; m < 4; ++m) { const size_t row = (size_t)(row0 + ai * HALF + m * 16);
                        f32x4 v0 = acc[ai][0][m][0], v1 = acc[ai][0][m][1];
                        if (rope) { const f32x4 c0 = *(const f32x4*)(cs + row * 8), c1 = *(const f32x4*)(cs + row * 8 + 4), s0 = *(const f32x4*)(sn + row * 8), s1 = *(const f32x4*)(sn + row * 8 + 4);
                                    rope8(v0, v1, c0, c1, s0, s1, fq); }
                        store8(KI + row * 64 + cw, v0, v1); }
            } else if (wc == 2 && fq == 0) {
#pragma unroll
                for (int ai = 0; ai < 2; ++ai)
#pragma unroll
                    for (int m = 0; m < 4; ++m) { const size_t row = (size_t)(row0 + ai * HALF + m * 16);
                        *(f32x4*)(WI + row * 8) = acc[ai][0][m][0] * WISCALE; *(f32x4*)(WI + row * 8 + 4) = acc[ai][0][m][1] * WISCALE; }
            }
        }
    }
};
struct EpiRelu2 {
    static constexpr bool PERM = true, AFTER_DRAIN = false;
    bf16_t* O; int ldc;
    __device__ __forceinline__ void operator()(const f32x4 (&acc)[2][2][4][2], const Unit& u, int wr, int wc, int fr, int fq) const {
        const int row0 = u.pm * BM + wr * 64 + fr; const int col0 = u.pn * BM + wc * 32 + 8 * fq;
#pragma unroll
        for (int ai = 0; ai < 2; ++ai)
#pragma unroll
            for (int m = 0; m < 4; ++m) { bf16_t* rowp = O + (size_t)(row0 + ai * HALF + m * 16) * ldc + col0;
#pragma unroll
                for (int bj = 0; bj < 2; ++bj) { f32x4 v0 = acc[ai][bj][m][0], v1 = acc[ai][bj][m][1];
#pragma unroll
                    for (int i = 0; i < 4; ++i) { const float a = fmaxf(v0[i], 0.f), b = fmaxf(v1[i], 0.f); v0[i] = a * a; v1[i] = b * b; }
                    store8(rowp + bj * HALF, v0, v1); } }
    }
};
struct EpiNormPart {
    static constexpr bool PERM = true, AFTER_DRAIN = false;
    bf16_t* O; int ldc; float* part;
    __device__ __forceinline__ void operator()(const f32x4 (&acc)[2][2][4][2], const Unit& u, int wr, int wc, int fr, int fq) const {
        const int row0 = u.pm * BM + wr * 64 + fr; const int col0 = u.pn * BM + wc * 32 + 8 * fq;
#pragma unroll
        for (int ai = 0; ai < 2; ++ai)
#pragma unroll
            for (int m = 0; m < 4; ++m) { const size_t row = (size_t)(row0 + ai * HALF + m * 16); bf16_t* rowp = O + row * ldc + col0; float s = 0.f;
#pragma unroll
                for (int bj = 0; bj < 2; ++bj) { const f32x4 v0 = acc[ai][bj][m][0], v1 = acc[ai][bj][m][1];
                    s += (v0[0] * v0[0] + v0[1] * v0[1]) + (v0[2] * v0[2] + v0[3] * v0[3]) + (v1[0] * v1[0] + v1[1] * v1[1]) + (v1[2] * v1[2] + v1[3] * v1[3]);
                    store8(rowp + bj * HALF, v0, v1); }
                s += __shfl_xor(s, 16); s += __shfl_xor(s, 32);
                if (fq == 0) part[row * 16 + u.pn * 4 + wc] = s; }
    }
};
template <class Epi, class Sched, bool ALIGN_EPI = false, bool SP2 = false>
__device__ __forceinline__ void gemm_phase(PG8_LAS unsigned char* lds, const Gemm g, const Sched& S, const Epi& E, const int wave_in) {
    const int lane = (int)__builtin_amdgcn_mbcnt_hi(~0u, __builtin_amdgcn_mbcnt_lo(~0u, 0u)), wid = wave_in, tid = wid * 64 + lane, wr = wid >> 2, wc = wid & 3, fr = lane & 15, fq = lane >> 4;
    const int K = g.K, nt = K / BK;
    unsigned voffA[2], voffB[2];
#pragma unroll
    for (int i = 0; i < 2; ++i) { int R, C; stage_rc(tid * 16 + i * 8192, R, C); const int Rb = Epi::PERM ? ((R & ~31) + perm32(R & 31)) : R;
        voffA[i] = (unsigned)(R * K + C) * 2u; voffB[i] = (unsigned)(Rb * K + C) * 2u; }
    const size_t kstep = (size_t)(BK * 2);
    const size_t hstep = (size_t)HALF * K * 2;
    const size_t tstep = 2 * hstep;
    const unsigned ldsw = (unsigned)wid * 1024u;
    const int aoff = lds_byte(wr * 64 + fr, fq * 8), boff = lds_byte(wc * 32 + fr, fq * 8);
#define PG8_SA(b, h) (((b) * 2 + (h)) * HTB)
#define PG8_SB(b, h) ((4 + (b) * 2 + (h)) * HTB)
#define PG8_STAGE(bufoff, gbase, voff) do { _Pragma("unroll") for (int _i = 0; _i < 2; ++_i) \
        __builtin_amdgcn_global_load_lds((const unsigned*)((const char*)(gbase) + (voff)[_i]), (PG8_LAS unsigned*)(lds + (bufoff) + ldsw + _i * 8192), 16, 0, 0); } while (0)
#define PG8_LDA(dst, b, h) do { _Pragma("unroll") for (int m = 0; m < 4; ++m) _Pragma("unroll") for (int k = 0; k < 2; ++k) dst[m][k] = *(const PG8_LAS bf16x8*)(lds + PG8_SA(b, h) + aoff + m * 2048 + k * 1024); } while (0)
#define PG8_LDB(dst, b, h) do { _Pragma("unroll") for (int n = 0; n < 2; ++n) _Pragma("unroll") for (int k = 0; k < 2; ++k) dst[n][k] = *(const PG8_LAS bf16x8*)(lds + PG8_SB(b, h) + boff + n * 2048 + k * 1024); } while (0)
#define PG8_MMA(ai, bj, At, Bt) do { __builtin_amdgcn_s_setprio(1); _Pragma("unroll") for (int m = 0; m < 4; ++m) _Pragma("unroll") for (int n = 0; n < 2; ++n) _Pragma("unroll") for (int k = 0; k < 2; ++k) \
        acc[ai][bj][m][n] = __builtin_amdgcn_mfma_f32_16x16x32_bf16(Bt[n][k], At[m][k], acc[ai][bj][m][n], 0, 0, 0); __builtin_amdgcn_s_setprio(0); } while (0)
#define PG8_WAIT_V(n) asm volatile("s_waitcnt vmcnt(" #n ")" ::: "memory")
#define PG8_WAIT_L(n) asm volatile("s_waitcnt lgkmcnt(" #n ")" ::: "memory")
#define PG8_BAR __builtin_amdgcn_s_barrier()
#define PG8_SCHED __builtin_amdgcn_sched_barrier(0)
    Unit cur, nxt; int ui = 0;
    if (!S.next(0, cur)) return;
    f32x4 acc[2][2][4][2];
#pragma unroll
    for (int a = 0; a < 2; ++a)
#pragma unroll
        for (int b = 0; b < 2; ++b)
#pragma unroll
            for (int m = 0; m < 4; ++m)
#pragma unroll
                for (int n = 0; n < 2; ++n) acc[a][b][m][n] = (f32x4){0.f, 0.f, 0.f, 0.f};
    bf16x8 At[4][2], B0[2][2], B1[2][2];
    const char* cA = (const char*)g.A + (size_t)cur.pm * tstep; const char* cB = (const char*)g.Bt + (size_t)cur.pn * tstep;
    S.a_ready(cur);
    if constexpr (SP2) {
        PG8_STAGE(PG8_SB(0, 0), cB, voffB); PG8_STAGE(PG8_SB(0, 1), cB + hstep, voffB); PG8_STAGE(PG8_SA(0, 0), cA, voffA); PG8_STAGE(PG8_SA(0, 1), cA + hstep, voffA);
        if (wr == 1) PG8_BAR;
        PG8_WAIT_V(2); PG8_BAR;
        PG8_STAGE(PG8_SB(1, 0), cB + kstep, voffB); PG8_STAGE(PG8_SA(1, 0), cA + kstep, voffA); PG8_STAGE(PG8_SB(1, 1), cB + hstep + kstep, voffB);
        PG8_WAIT_V(6); PG8_BAR;
    } else {
        PG8_STAGE(PG8_SB(0, 0), cB, voffB); PG8_STAGE(PG8_SA(0, 0), cA, voffA); PG8_STAGE(PG8_SB(0, 1), cB + hstep, voffB); PG8_STAGE(PG8_SA(0, 1), cA + hstep, voffA);
        if (wr == 1) PG8_BAR;
        PG8_WAIT_V(4); PG8_BAR;
        PG8_STAGE(PG8_SB(1, 0), cB + kstep, voffB); PG8_STAGE(PG8_SA(1, 0), cA + kstep, voffA); PG8_STAGE(PG8_SB(1, 1), cB + hstep + kstep, voffB);
        PG8_WAIT_V(6); PG8_BAR;
    }
    for (;;) {
        const bool has_next = S.next(ui + 1, nxt);
        const char* nA = has_next ? (const char*)g.A + (size_t)nxt.pm * tstep : cA; const char* nB = has_next ? (const char*)g.Bt + (size_t)nxt.pn * tstep : cB;
        for (int t = 0; t < nt; t += 2) {
            const bool last = (t == nt - 2);
            const char* a1 = cA + (size_t)(t + 1) * kstep;
            const char* a2 = last ? nA : cA + (size_t)(t + 2) * kstep; const char* b2 = last ? nB : cB + (size_t)(t + 2) * kstep;
            const char* a3 = a2 + kstep; const char* b3 = b2 + kstep;
            if (last && has_next) S.a_ready(nxt);
            if constexpr (SP2) {
            PG8_LDB(B0, 0, 0); PG8_LDB(B1, 0, 1); PG8_SCHED; PG8_LDA(At, 0, 0); PG8_STAGE(PG8_SA(1, 1), a1 + hstep, voffA);
            PG8_WAIT_V(8); PG8_WAIT_L(0); PG8_BAR; PG8_MMA(0, 0, At, B0); PG8_MMA(0, 1, At, B1); PG8_BAR; PG8_SCHED;
            PG8_LDA(At, 0, 1); PG8_STAGE(PG8_SB(0, 0), b2, voffB); PG8_STAGE(PG8_SB(0, 1), b2 + hstep, voffB); PG8_STAGE(PG8_SA(0, 0), a2, voffA);
            PG8_WAIT_V(8); PG8_WAIT_L(0); PG8_BAR; PG8_MMA(1, 0, At, B0); PG8_MMA(1, 1, At, B1); PG8_BAR; PG8_SCHED;
            PG8_LDB(B0, 1, 0); PG8_LDB(B1, 1, 1); PG8_SCHED; PG8_LDA(At, 1, 0); PG8_STAGE(PG8_SA(0, 1), a2 + hstep, voffA);
            PG8_WAIT_V(8); PG8_WAIT_L(0); PG8_BAR; PG8_MMA(0, 0, At, B0); PG8_MMA(0, 1, At, B1); PG8_BAR; PG8_SCHED;
            PG8_LDA(At, 1, 1); PG8_STAGE(PG8_SB(1, 0), b3, voffB); PG8_STAGE(PG8_SB(1, 1), b3 + hstep, voffB); PG8_STAGE(PG8_SA(1, 0), a3, voffA);
            PG8_WAIT_V(8); PG8_WAIT_L(0); PG8_BAR; PG8_MMA(1, 0, At, B0); PG8_MMA(1, 1, At, B1); PG8_BAR; PG8_SCHED;
            } else {
            PG8_LDB(B0, 0, 0); PG8_SCHED; PG8_LDA(At, 0, 0); PG8_STAGE(PG8_SA(1, 1), a1 + hstep, voffA);
            PG8_WAIT_L(8); PG8_BAR; PG8_WAIT_L(0); PG8_MMA(0, 0, At, B0); PG8_BAR; PG8_SCHED;
            PG8_LDB(B1, 0, 1); PG8_STAGE(PG8_SB(0, 0), b2, voffB);
            PG8_BAR; PG8_WAIT_L(0); PG8_MMA(0, 1, At, B1); PG8_BAR;
            PG8_LDA(At, 0, 1); PG8_STAGE(PG8_SA(0, 0), a2, voffA);
            PG8_BAR; PG8_WAIT_L(0); PG8_MMA(1, 0, At, B0); PG8_BAR; PG8_SCHED;
            PG8_STAGE(PG8_SB(0, 1), b2 + hstep, voffB);
            PG8_WAIT_V(6); PG8_BAR; PG8_MMA(1, 1, At, B1); PG8_BAR;
            PG8_LDB(B0, 1, 0); PG8_SCHED; PG8_LDA(At, 1, 0); PG8_STAGE(PG8_SA(0, 1), a2 + hstep, voffA);
            PG8_WAIT_L(8); PG8_BAR; PG8_WAIT_L(0); PG8_MMA(0, 0, At, B0); PG8_BAR; PG8_SCHED;
            PG8_LDB(B1, 1, 1); PG8_STAGE(PG8_SB(1, 0), b3, voffB);
            PG8_BAR; PG8_WAIT_L(0); PG8_MMA(0, 1, At, B1); PG8_BAR;
            PG8_LDA(At, 1, 1); PG8_STAGE(PG8_SA(1, 0), a3, voffA);
            PG8_BAR; PG8_WAIT_L(0); PG8_MMA(1, 0, At, B0); PG8_BAR; PG8_SCHED;
            PG8_STAGE(PG8_SB(1, 1), b3 + hstep, voffB);
            PG8_WAIT_V(6); PG8_BAR; PG8_MMA(1, 1, At, B1); PG8_BAR;
            }
        }
        if constexpr (ALIGN_EPI) { if (wr == 0) PG8_BAR; }
        if constexpr (!Epi::AFTER_DRAIN) { E(acc, cur, wr, wc, fr, fq); S.done(cur); }
        if (!has_next) break;
#pragma unroll
        for (int a = 0; a < 2; ++a)
#pragma unroll
            for (int b = 0; b < 2; ++b)
#pragma unroll
                for (int m = 0; m < 4; ++m)
#pragma unroll
                    for (int n = 0; n < 2; ++n) acc[a][b][m][n] = (f32x4){0.f, 0.f, 0.f, 0.f};
        cur = nxt; cA = nA; cB = nB; ++ui;
        if constexpr (ALIGN_EPI) { if (wr == 1) PG8_BAR; }
    }
    PG8_WAIT_V(0);
    if constexpr (!ALIGN_EPI) { if (wr == 0) PG8_BAR; }
    PG8_BAR;
    if constexpr (Epi::AFTER_DRAIN) { E.fused(acc, cur, wr, wc, fr, fq, lds, wid, lane); S.done(cur); }
#undef PG8_SA
#undef PG8_SB
#undef PG8_STAGE
#undef PG8_LDA
#undef PG8_LDB
#undef PG8_MMA
#undef PG8_WAIT_V
#undef PG8_WAIT_L
#undef PG8_BAR
#undef PG8_SCHED
}
}
#define PG8_SP2 true
#define PG8_ALIGN true
#define GAS __attribute__((address_space(1)))
#define LAS __attribute__((address_space(3)))
typedef unsigned short bf16;
typedef unsigned v4u __attribute__((ext_vector_type(4)));
typedef float f32x4 __attribute__((ext_vector_type(4)));
typedef short bf16x8 __attribute__((ext_vector_type(8)));
typedef GAS unsigned gu32;
typedef GAS unsigned long long gu64;
#define RLX_AGENT __ATOMIC_RELAXED, __HIP_MEMORY_SCOPE_AGENT
#define LDS_WAIT() asm volatile("s_waitcnt lgkmcnt(0)" ::: "memory")
#define VM_WAIT() asm volatile("s_waitcnt vmcnt(0)" ::: "memory")
__device__ __forceinline__ unsigned long long rt() { return __builtin_amdgcn_s_memrealtime(); }
__device__ __forceinline__ unsigned f2bf(float f) { unsigned u = __builtin_bit_cast(unsigned, f); return (u + 0x7fffu + ((u >> 16) & 1u)) >> 16; }
__device__ __forceinline__ unsigned pk2(float lo, float hi) { return f2bf(lo) | (f2bf(hi) << 16); }

#define XB_LANE() ((int)__builtin_amdgcn_mbcnt_hi(~0u, __builtin_amdgcn_mbcnt_lo(~0u, 0u)))
#define XB_TMO      128
#define XB_XCNT(j)  (256  + 64 * (j))
#define XB_XSUB(j)  (1280 + 64 * (j))
#define XB_XGEN(j)  (2304 + 64 * (j))
#define XB_TOP      3328
#define XB_TOPGEN   3392
#define XCD_BAR_WORDS 3456
#define XB_SPIN_CAP (1u << 18)

__device__ __forceinline__ unsigned xb_ld(unsigned* p)              { return __hip_atomic_load(p, __ATOMIC_RELAXED, __HIP_MEMORY_SCOPE_AGENT); }
__device__ __forceinline__ unsigned xb_add(unsigned* p, unsigned v) { return __hip_atomic_fetch_add(p, v, __ATOMIC_RELAXED, __HIP_MEMORY_SCOPE_AGENT); }
__device__ __forceinline__ unsigned xb_xcc_id() { return (unsigned)__builtin_amdgcn_s_getreg((3 << 11) | 20) & 0xFu; }
#define XB_SPIN(cond, bar) do { unsigned _sp = 0; while (cond) { __builtin_amdgcn_s_sleep(1); \
    if ((++_sp & 255u) == 0u) { if (xb_ld(&(bar)[XB_TMO])) break; if (_sp > XB_SPIN_CAP) { atomicAdd(&(bar)[XB_TMO], 1u); break; } } } } while (0)

struct XcdBarrier {
    int wave;
    unsigned* bar; unsigned x;
    volatile LAS unsigned* st;
};

__device__ __forceinline__ XcdBarrier xcd_barrier_post(unsigned* bar, volatile LAS unsigned* st, int wave_in) {
    XcdBarrier b; b.wave = wave_in; b.bar = bar; b.x = xb_xcc_id(); b.st = st;
    if (b.wave == 0 && XB_LANE() == 0) (void)xb_add(&bar[XB_XCNT(b.x)], 1u);
    return b;
}
__device__ __forceinline__ void xcd_barrier_complete(unsigned* bar, unsigned x, unsigned& nloc, unsigned& nx) {
    const unsigned G = gridDim.x * gridDim.y * gridDim.z;
    unsigned sum, cnt, mine, sp = 0u;
    for (;;) {
        sum = 0u; cnt = 0u; mine = 0u;
#pragma unroll
        for (unsigned j = 0; j < 16; ++j) { const unsigned c = xb_ld(&bar[XB_XCNT(j)]); sum += c; cnt += (c > 0u) ? 1u : 0u; mine = (j == x) ? c : mine; }
        if (sum == G) break;
        __builtin_amdgcn_s_sleep(1);
        if ((++sp & 255u) == 0u) { if (xb_ld(&bar[XB_TMO])) break; if (sp > XB_SPIN_CAP) { atomicAdd(&bar[XB_TMO], 1u); break; } }
    }
    nloc = mine > 0u ? mine : 1u; nx = cnt > 0u ? cnt : 1u;
}

__device__ __forceinline__ void xcd_barrier(const XcdBarrier& b) {
    asm volatile("s_waitcnt vmcnt(0)" ::: "memory");
    __syncthreads();
    if (b.wave == 0 && XB_LANE() == 0) {
        unsigned* bar = b.bar;
        __builtin_amdgcn_s_waitcnt(0);
        unsigned nloc = b.st[0], nx = b.st[1];
        if (nloc == 0u) { xcd_barrier_complete(bar, b.x, nloc, nx); b.st[0] = nloc; b.st[1] = nx; }
        const unsigned old = xb_add(&bar[XB_XSUB(b.x)], 1u);
        const unsigned gen = old / nloc;
        if (old + 1u == (gen + 1u) * nloc) {
            __builtin_amdgcn_fence(__ATOMIC_RELEASE, "agent");
            asm volatile("s_waitcnt vmcnt(0)" ::: "memory");
            const unsigned og = xb_add(&bar[XB_TOP], 1u);
            const unsigned tg = og / nx;
            if (og + 1u == (tg + 1u) * nx) xb_add(&bar[XB_TOPGEN], 1u);
            else XB_SPIN(xb_ld(&bar[XB_TOPGEN]) == tg, bar);
            __builtin_amdgcn_fence(__ATOMIC_ACQUIRE, "agent");
            xb_add(&bar[XB_XGEN(b.x)], 1u);
            asm volatile("s_waitcnt vmcnt(0)" ::: "memory");
        } else {
            XB_SPIN(xb_ld(&bar[XB_XGEN(b.x)]) == gen, bar);
            __builtin_amdgcn_fence(__ATOMIC_ACQUIRE, "agent");
            asm volatile("s_waitcnt vmcnt(0)" ::: "memory");
        }
    }
    __syncthreads();
}
#ifndef MK_N_LAUNCHES
#define MK_N_LAUNCHES 1
#endif
constexpr int NWAVES = 8;
constexpr int N_PHASES = 10;
constexpr int BATCH = 32, SEQ = 2048, D = 1024, M = BATCH * SEQ, DIN = 2376, DINP = 2560, FF = 4096, DSGU = 512;
constexpr float EPS = 1e-6f;
constexpr size_t MiB = 1u << 20;
constexpr size_t WS_CTL = 0, CTL_ZERO_BYTES = 1 * MiB;
constexpr size_t WS_MOD = 1 * MiB;
constexpr size_t WS_COS = 2 * MiB, WS_SIN = 4 * MiB;
constexpr size_t WS_WM = 6 * MiB;
constexpr size_t WS_PART = 7 * MiB;
constexpr size_t WS_WIN = 12 * MiB, WS_WOUT = 17 * MiB, WS_W1 = 19 * MiB, WS_W2 = 27 * MiB;
constexpr size_t WS_WI = 36 * MiB;
constexpr size_t WS_H = 40 * MiB;
constexpr size_t WS_BIG = 168 * MiB;
constexpr size_t WS_ZU = WS_BIG, WS_ZV = WS_BIG + 64 * MiB, WS_Q = WS_BIG + 128 * MiB, WS_K = WS_BIG + 192 * MiB, WS_VT = WS_BIG + 208 * MiB,
                 WS_QI = WS_BIG + 224 * MiB, WS_KI = WS_BIG + 288 * MiB, WS_MERGED = WS_BIG + 296 * MiB;
constexpr size_t WS_O = WS_BIG;
constexpr size_t WS_HB = WS_BIG;
constexpr size_t WS_SCR = WS_BIG + 512 * MiB;
constexpr size_t WS_F = WS_SCR;
constexpr size_t WS_END = WS_SCR + 256 * MiB;
constexpr size_t SCR_PER_WG = 1 * MiB, SCR_SC = 0, SCR_MK = 512 * 1024, SCR_YB = 768 * 1024;
constexpr int CW_BAR = 4096;
constexpr int CW_KN = 12288;
constexpr int RING_OFF = 0, RING_BYTES = 131072;
constexpr int LDSCTL_OFF = 159744, MISC_OFF = LDSCTL_OFF + 320, AUX_OFF = LDSCTL_OFF + 1024;
constexpr int LDS_BYTES = 163840;

typedef float f32x16 __attribute__((ext_vector_type(16)));
typedef float f32x2 __attribute__((ext_vector_type(2)));
typedef unsigned u32x2 __attribute__((ext_vector_type(2)));
#define MFMA32(a, b, c) __builtin_amdgcn_mfma_f32_32x32x16_bf16((a), (b), (c), 0, 0, 0)
#define LANE() ((int)__builtin_amdgcn_mbcnt_hi(~0u, __builtin_amdgcn_mbcnt_lo(~0u, 0u)))
#define TID(F) ((F).wave * 64 + LANE())

struct Frame {
    LAS unsigned char* lds;
    volatile LAS unsigned* MISC;
    gu32* ctl;
    int wave, vcu, G; int repA, repB, repC, repD;
    const float *x, *c; const int* pos; const float *w_ada, *b_ada, *g_pre_mix, *w_in, *g_sgu_v, *w_spatial, *b_spatial, *g_out_sgu, *g_out_attn, *w_out, *g_post_mix, *g_pre_ffn, *w_ff1, *w_ff2, *g_post_ffn;
    float* out;
    float *MOD, *COS, *SIN, *PART, *WI;
    bf16 *WM, *WIN, *WOUT, *W1, *W2, *H, *ZU, *ZV, *Q, *K, *VT, *QI, *KI, *MERGED, *O, *HB, *FB;
    unsigned char* scr;
};
__device__ __forceinline__ float bflo(unsigned u) { return __builtin_bit_cast(float, u << 16); }
__device__ __forceinline__ float bfhi(unsigned u) { return __builtin_bit_cast(float, u & 0xffff0000u); }
__device__ __forceinline__ unsigned pkbf(float lo, float hi) { return pg8::cvt_pk_bf16(lo, hi); }
__device__ __forceinline__ float wave_sum(float v) {
#pragma unroll
    for (int o = 1; o < 64; o <<= 1) v += __shfl_xor(v, o);
    return v;
}
__device__ __forceinline__ void block_sync_mem(bool wave0) {
    asm volatile("s_waitcnt vmcnt(0)" ::: "memory");
    __syncthreads();
    if (wave0 && LANE() == 0) { __builtin_amdgcn_fence(__ATOMIC_ACQUIRE, "agent"); asm volatile("s_waitcnt vmcnt(0)" ::: "memory"); }
    __syncthreads();
}

__device__ __forceinline__ void p0_transpose_item(const float* W, int K, int N, int Npad, bf16* WT, LAS float* scr, int item, int lane) {
    const int nblk = Npad / 32, kb = item / nblk, nb = item % nblk, k0 = 64 * kb, n0 = 32 * nb;
    const int nn = n0 + (lane & 31);
#pragma unroll 8
    for (int i = 0; i < 32; ++i) { const int kk = 2 * i + (lane >> 5); scr[kk * 33 + (lane & 31)] = (nn < N) ? W[(size_t)(k0 + kk) * N + nn] : 0.f; }
    LDS_WAIT(); asm volatile("" ::: "memory");
    const int c = lane & 7;
#pragma unroll
    for (int j = 0; j < 4; ++j) { const int n = (lane >> 3) + 8 * j; const LAS float* s = scr + (8 * c) * 33 + n;
        v4u o; o.x = pk2(s[0 * 33], s[1 * 33]); o.y = pk2(s[2 * 33], s[3 * 33]); o.z = pk2(s[4 * 33], s[5 * 33]); o.w = pk2(s[6 * 33], s[7 * 33]);
        *(GAS v4u*)(WT + (size_t)(n0 + n) * K + k0 + 8 * c) = o; }
    LDS_WAIT(); asm volatile("" ::: "memory");
}
__device__ __forceinline__ void p0_mod_unit(Frame& F, int u) {
    const int lane = LANE(), w = F.wave, tid = TID(F);
    LAS float* csl = (LAS float*)F.lds + w * 4096;
#pragma unroll 4
    for (int i = 0; i < 64; ++i) { const int idx = i * 64 + lane, b = idx >> 7, d = idx & 127; const float cv = F.c[b * D + 128 * w + d];
        csl[d * 32 + b] = cv / (1.0f + __expf(-cv)); }
    LDS_WAIT(); asm volatile("" ::: "memory");
    float acc[32];
#pragma unroll
    for (int b = 0; b < 32; ++b) acc[b] = 0.f;
    const float* wp = F.w_ada + (size_t)(128 * w) * 6144 + 64 * u + lane;
#pragma unroll 2
    for (int d = 0; d < 128; ++d) { const float wv = wp[(size_t)d * 6144];
#pragma unroll
        for (int b4 = 0; b4 < 8; ++b4) { const f32x4 cc = *(const LAS f32x4*)(csl + d * 32 + 4 * b4);
            acc[4 * b4 + 0] += cc[0] * wv; acc[4 * b4 + 1] += cc[1] * wv; acc[4 * b4 + 2] += cc[2] * wv; acc[4 * b4 + 3] += cc[3] * wv; } }
    __syncthreads();
    LAS float* red = (LAS float*)F.lds;
#pragma unroll
    for (int b = 0; b < 32; ++b) red[(w * 32 + b) * 64 + lane] = acc[b];
    __syncthreads();
#pragma unroll
    for (int k = 0; k < 4; ++k) { const int o = tid + 512 * k, b = o >> 6, col = o & 63; float s = 0.f;
#pragma unroll
        for (int ww = 0; ww < 8; ++ww) s += red[(ww * 32 + b) * 64 + col];
        F.MOD[b * 6144 + 64 * u + col] = s + F.b_ada[64 * u + col]; }
    __syncthreads();
}
__device__ __forceinline__ void p0_prologue(Frame& F) {
    for (int u = F.vcu; u < 96; u += F.G) p0_mod_unit(F, u);
    LAS float* scr = (LAS float*)(F.lds + RING_OFF + F.wave * 16384);
    const int gw = F.vcu * NWAVES + F.wave, NGW = F.G * NWAVES;
    constexpr int I_IN = (D / 64) * (DINP / 32), I_OUT = (D / 64) * (D / 32), I_1 = (D / 64) * (FF / 32), I_2 = (FF / 64) * (D / 32);
    constexpr int NITEMS = I_IN + I_OUT + I_1 + I_2;
    for (int it = gw; it < NITEMS; it += NGW) {
        int r = it;
        if (r < I_IN) { p0_transpose_item(F.w_in, D, DIN, DINP, F.WIN, scr, r, LANE()); continue; } r -= I_IN;
        if (r < I_OUT) { p0_transpose_item(F.w_out, D, D, D, F.WOUT, scr, r, LANE()); continue; } r -= I_OUT;
        if (r < I_1) { p0_transpose_item(F.w_ff1, D, FF, FF, F.W1, scr, r, LANE()); continue; } r -= I_1;
        p0_transpose_item(F.w_ff2, FF, D, D, F.W2, scr, r, LANE());
    }
    const int gt = F.vcu * NWAVES * 64 + TID(F), NT = F.G * NWAVES * 64;
    for (int i = gt; i < 4 * 128 * 128; i += NT) { const int t = (i >> 7) & 127, s = i & 127; F.WM[i] = (bf16)f2bf(s <= t ? F.w_spatial[i] : 0.f); }
    for (int i = gt; i < M * 8; i += NT) { const int m = i >> 3, j = i & 7;
        const double rpp = (j == 0) ? 0.15915494309189535 : (j == 1) ? 0.03086376340470123 : (j == 2) ? 0.005985185712713705 : (j == 3) ? 0.001160663641240061 :
                           (j == 4) ? 0.00022507907903927653 : (j == 5) ? 4.364795279280289e-05 : (j == 6) ? 8.464330808241401e-06 : 1.6414262627950345e-06;
        const double rev = (double)F.pos[m] * rpp; const float fr = (float)(rev - __builtin_floor(rev));
        F.COS[i] = __builtin_amdgcn_cosf(fr); F.SIN[i] = __builtin_amdgcn_sinf(fr); }
}
__device__ __forceinline__ void p1_hprep(Frame& F) {
    const int gw = F.vcu * NWAVES + F.wave, NGW = F.G * NWAVES, lane = LANE();
    for (int chunk = gw; chunk < M / 32; chunk += NGW) {
        const int b = (chunk * 32) / SEQ; const float* mod = F.MOD + b * 6144;
        f32x4 ga[4], sh[4];
#pragma unroll
        for (int j = 0; j < 4; ++j) { const int c = 4 * lane + 256 * j; const f32x4 g = *(const f32x4*)(F.g_pre_mix + c), sc = *(const f32x4*)(mod + 1024 + c); ga[j] = g * (sc + 1.0f); sh[j] = *(const f32x4*)(mod + c); }
        const GAS f32x4* xr0 = (const GAS f32x4*)(F.x + (size_t)chunk * 32 * D) + lane;
        f32x4 nx[4];
#pragma unroll
        for (int j = 0; j < 4; ++j) nx[j] = xr0[64 * j];
#pragma unroll 1
        for (int r = 0; r < 32; ++r) { const size_t m = (size_t)chunk * 32 + r;
            f32x4 v[4]; float s = 0.f;
#pragma unroll
            for (int j = 0; j < 4; ++j) { v[j] = nx[j]; s += (v[j].x * v[j].x + v[j].y * v[j].y) + (v[j].z * v[j].z + v[j].w * v[j].w); }
            if (r + 1 < 32) { const GAS f32x4* xn = xr0 + (size_t)(r + 1) * (D / 4);
#pragma unroll
                for (int j = 0; j < 4; ++j) nx[j] = xn[64 * j]; }
            const float rstd = rsqrtf(wave_sum(s) * (1.f / D) + EPS);
            GAS u32x2* o8 = (GAS u32x2*)(F.H + m * D) + lane;
#pragma unroll
            for (int j = 0; j < 4; ++j) { const f32x4 o = v[j] * rstd * ga[j] + sh[j]; u32x2 w; w.x = pkbf(o.x, o.y); w.y = pkbf(o.z, o.w); o8[64 * j] = w; } }
    }
}
__device__ __forceinline__ void p5_postmix(Frame& F) {
    const int gw = F.vcu * NWAVES + F.wave, NGW = F.G * NWAVES, lane = LANE();
    for (int chunk = gw; chunk < M / 32; chunk += NGW) {
        const int b = (chunk * 32) / SEQ; const float* mod = F.MOD + b * 6144;
        f32x4 g1[4], ga[4], sh[4];
#pragma unroll
        for (int j = 0; j < 4; ++j) { const int c = 4 * lane + 256 * j;
            g1[j] = *(const f32x4*)(mod + 2048 + c) * *(const f32x4*)(F.g_post_mix + c);
            ga[j] = *(const f32x4*)(F.g_pre_ffn + c) * (*(const f32x4*)(mod + 4096 + c) + 1.0f); sh[j] = *(const f32x4*)(mod + 3072 + c); }
        const GAS f32x4* xr0 = (const GAS f32x4*)(F.x + (size_t)chunk * 32 * D) + lane; const GAS u32x2* or0 = (const GAS u32x2*)(F.O + (size_t)chunk * 32 * D) + lane;
        f32x4 nx[4]; u32x2 no[4]; float nps = F.PART[(size_t)chunk * 32 * 16 + (lane & 15)];
#pragma unroll
        for (int j = 0; j < 4; ++j) { nx[j] = xr0[64 * j]; no[j] = or0[64 * j]; }
#pragma unroll 1
        for (int r = 0; r < 32; ++r) { const size_t m = (size_t)chunk * 32 + r;
            float ps = nps; f32x4 xv[4]; u32x2 ow[4];
#pragma unroll
            for (int j = 0; j < 4; ++j) { xv[j] = nx[j]; ow[j] = no[j]; }
            if (r + 1 < 32) { const GAS f32x4* xn = xr0 + (size_t)(r + 1) * (D / 4); const GAS u32x2* on = or0 + (size_t)(r + 1) * (D / 4); nps = F.PART[(m + 1) * 16 + (lane & 15)];
#pragma unroll
                for (int j = 0; j < 4; ++j) { nx[j] = xn[64 * j]; no[j] = on[64 * j]; } }
            ps += __shfl_xor(ps, 1); ps += __shfl_xor(ps, 2); ps += __shfl_xor(ps, 4); ps += __shfl_xor(ps, 8);
            const float rstd_o = rsqrtf(ps * (1.f / D) + EPS);
            GAS f32x4* outr = (GAS f32x4*)(F.out + m * D) + lane;
            f32x4 v[4]; float s = 0.f;
#pragma unroll
            for (int j = 0; j < 4; ++j) { const f32x4 ov = {bflo(ow[j].x), bfhi(ow[j].x), bflo(ow[j].y), bfhi(ow[j].y)};
                v[j] = xv[j] + g1[j] * (ov * rstd_o); outr[64 * j] = v[j];
                s += (v[j].x * v[j].x + v[j].y * v[j].y) + (v[j].z * v[j].z + v[j].w * v[j].w); }
            const float rstd = rsqrtf(wave_sum(s) * (1.f / D) + EPS);
            GAS u32x2* o8 = (GAS u32x2*)(F.H + m * D) + lane;
#pragma unroll
            for (int j = 0; j < 4; ++j) { const f32x4 o = v[j] * rstd * ga[j] + sh[j]; u32x2 w; w.x = pkbf(o.x, o.y); w.y = pkbf(o.z, o.w); o8[64 * j] = w; } }
    }
}
__device__ __forceinline__ void p8_final(Frame& F) {
    const int gw = F.vcu * NWAVES + F.wave, NGW = F.G * NWAVES, lane = LANE();
    for (int chunk = gw; chunk < M / 32; chunk += NGW) {
        const int b = (chunk * 32) / SEQ; const float* mod = F.MOD + b * 6144;
        f32x4 g2[4];
#pragma unroll
        for (int j = 0; j < 4; ++j) { const int c = 4 * lane + 256 * j; g2[j] = *(const f32x4*)(mod + 5120 + c) * *(const f32x4*)(F.g_post_ffn + c); }
        const GAS u32x2* fr0 = (const GAS u32x2*)(F.FB + (size_t)chunk * 32 * D) + lane; GAS f32x4* out0 = (GAS f32x4*)(F.out + (size_t)chunk * 32 * D) + lane;
        f32x4 nx[4]; u32x2 nf[4]; float nps = F.PART[(size_t)chunk * 32 * 16 + (lane & 15)];
#pragma unroll
        for (int j = 0; j < 4; ++j) { nx[j] = out0[64 * j]; nf[j] = fr0[64 * j]; }
#pragma unroll 1
        for (int r = 0; r < 32; ++r) { const size_t m = (size_t)chunk * 32 + r;
            float ps = nps; f32x4 xv[4]; u32x2 fw[4];
#pragma unroll
            for (int j = 0; j < 4; ++j) { xv[j] = nx[j]; fw[j] = nf[j]; }
            if (r + 1 < 32) { const GAS f32x4* xn = out0 + (size_t)(r + 1) * (D / 4); const GAS u32x2* fn = fr0 + (size_t)(r + 1) * (D / 4); nps = F.PART[(m + 1) * 16 + (lane & 15)];
#pragma unroll
                for (int j = 0; j < 4; ++j) { nx[j] = xn[64 * j]; nf[j] = fn[64 * j]; } }
            ps += __shfl_xor(ps, 1); ps += __shfl_xor(ps, 2); ps += __shfl_xor(ps, 4); ps += __shfl_xor(ps, 8);
            const float rstd_f = rsqrtf(ps * (1.f / D) + EPS);
            GAS f32x4* outr = out0 + (size_t)r * (D / 4);
#pragma unroll
            for (int j = 0; j < 4; ++j) { const f32x4 fv = {bflo(fw[j].x), bfhi(fw[j].x), bflo(fw[j].y), bfhi(fw[j].y)};
                outr[64 * j] = xv[j] + g2[j] * (fv * rstd_f); } }
    }
}
__device__ __forceinline__ void sgu_unit(Frame& F, int b, int n) {
    const int tid = TID(F), lane = LANE(), w = F.wave;
    const size_t R0 = (size_t)b * SEQ + (size_t)n * 128;
    LAS bf16* vn = (LAS bf16*)F.lds;
    LAS float* rpart = (LAS float*)(F.lds + AUX_OFF);
    {
        f32x4 gv0 = *(const f32x4*)(F.g_sgu_v + 8 * lane), gv1 = *(const f32x4*)(F.g_sgu_v + 8 * lane + 4);
#pragma unroll 4
        for (int i = 0; i < 16; ++i) { const int s = 16 * w + i;
            const v4u raw = *(const GAS v4u*)(F.ZV + (R0 + s) * DSGU + 8 * lane);
            f32x4 a = {bflo(raw.x), bfhi(raw.x), bflo(raw.y), bfhi(raw.y)}, c = {bflo(raw.z), bfhi(raw.z), bflo(raw.w), bfhi(raw.w)};
            float ss = (a.x * a.x + a.y * a.y) + (a.z * a.z + a.w * a.w) + (c.x * c.x + c.y * c.y) + (c.z * c.z + c.w * c.w);
            ss += __shfl_xor(ss, 1); ss += __shfl_xor(ss, 2); ss += __shfl_xor(ss, 4); ss += __shfl_xor(ss, 8);
            const float rstd = rsqrtf(ss * (1.f / 128.f) + EPS);
            a = a * rstd * gv0; c = c * rstd * gv1;
            v4u o; o.x = pkbf(a.x, a.y); o.y = pkbf(a.z, a.w); o.z = pkbf(c.x, c.y); o.w = pkbf(c.z, c.w);
            *(LAS v4u*)(vn + s * DSGU + 8 * lane) = o; }
    }
    __syncthreads();
    const int tt = w & 3, ch = w >> 2, tl = lane & 31, h = lane >> 5;
    const int t = tt * 32 + tl;
    f32x16 acc[8];
#pragma unroll
    for (int i = 0; i < 8; ++i)
#pragma unroll
        for (int r = 0; r < 16; ++r) acc[i][r] = 0.f;
    const int kmax = 2 * (tt + 1);
#pragma unroll
    for (int gi = 0; gi < 2; ++gi) { const int g = 2 * ch + gi;
        const bf16* bp = F.WM + ((size_t)(g * 128 + t)) * 128 + 8 * h;
#pragma unroll
        for (int ct = 0; ct < 4; ++ct) { const LAS bf16* colp = vn + g * 128 + ct * 32 + tl + 8 * h * DSGU;
            f32x16 a = acc[gi * 4 + ct];
#pragma unroll 2
            for (int kk = 0; kk < kmax; ++kk) {
                const LAS bf16* p = colp + kk * 16 * DSGU;
                const unsigned e0 = p[0], e1 = p[DSGU], e2 = p[2 * DSGU], e3 = p[3 * DSGU], e4 = p[4 * DSGU], e5 = p[5 * DSGU], e6 = p[6 * DSGU], e7 = p[7 * DSGU];
                v4u pk; pk.x = e0 | (e1 << 16); pk.y = e2 | (e3 << 16); pk.z = e4 | (e5 << 16); pk.w = e6 | (e7 << 16);
                const bf16x8 Bf = *(const GAS bf16x8*)(bp + kk * 16);
                a = MFMA32(__builtin_bit_cast(bf16x8, pk), Bf, a); }
            acc[gi * 4 + ct] = a; }
    }
    float ssq = 0.f;
#pragma unroll
    for (int gi = 0; gi < 2; ++gi) { const int g = 2 * ch + gi; const float bias = F.b_spatial[g * 128 + t];
#pragma unroll
        for (int ct = 0; ct < 4; ++ct)
#pragma unroll
            for (int qd = 0; qd < 4; ++qd) { const int c0 = g * 128 + ct * 32 + 8 * qd + 4 * h;
                const u32x2 zu = *(const GAS u32x2*)(F.ZU + (R0 + t) * DSGU + c0);
                const float u0 = bflo(zu.x), u1 = bfhi(zu.x), u2 = bflo(zu.y), u3 = bfhi(zu.y);
                float v0 = (acc[gi * 4 + ct][4 * qd + 0] + bias) * u0, v1 = (acc[gi * 4 + ct][4 * qd + 1] + bias) * u1, v2 = (acc[gi * 4 + ct][4 * qd + 2] + bias) * u2, v3 = (acc[gi * 4 + ct][4 * qd + 3] + bias) * u3;
                acc[gi * 4 + ct][4 * qd + 0] = v0; acc[gi * 4 + ct][4 * qd + 1] = v1; acc[gi * 4 + ct][4 * qd + 2] = v2; acc[gi * 4 + ct][4 * qd + 3] = v3;
                ssq += (v0 * v0 + v1 * v1) + (v2 * v2 + v3 * v3); } }
    ssq += __shfl_xor(ssq, 32);
    if (h == 0) rpart[ch * 128 + t] = ssq;
    __syncthreads();
    const float rstd = rsqrtf((rpart[t] + rpart[128 + t]) * (1.f / 512.f) + EPS);
#pragma unroll
    for (int gi = 0; gi < 2; ++gi) { const int g = 2 * ch + gi;
#pragma unroll
        for (int ct = 0; ct < 4; ++ct)
#pragma unroll
            for (int qd = 0; qd < 4; ++qd) { const int c0 = g * 128 + ct * 32 + 8 * qd + 4 * h;
                const f32x4 go = *(const f32x4*)(F.g_out_sgu + c0);
                u32x2 o; o.x = pkbf(acc[gi * 4 + ct][4 * qd + 0] * rstd * go.x, acc[gi * 4 + ct][4 * qd + 1] * rstd * go.y);
                o.y = pkbf(acc[gi * 4 + ct][4 * qd + 2] * rstd * go.z, acc[gi * 4 + ct][4 * qd + 3] * rstd * go.w);
                *(GAS u32x2*)(F.MERGED + (R0 + t) * D + c0) = o; } }
    __syncthreads();
}
__device__ __forceinline__ unsigned okey(unsigned x) { return (x & 0x8000u) ? (x ^ 0xffffu) : (x | 0x8000u); }
__device__ __forceinline__ unsigned wave_incl_scan(unsigned v) {
    v += (unsigned)__builtin_amdgcn_update_dpp(0, (int)v, 0x111, 0xf, 0xf, false);
    v += (unsigned)__builtin_amdgcn_update_dpp(0, (int)v, 0x112, 0xf, 0xf, false);
    v += (unsigned)__builtin_amdgcn_update_dpp(0, (int)v, 0x114, 0xf, 0xf, false);
    v += (unsigned)__builtin_amdgcn_update_dpp(0, (int)v, 0x118, 0xf, 0xf, false);
    v += (unsigned)__builtin_amdgcn_update_dpp(0, (int)v, 0x142, 0xa, 0xf, false);
    v += (unsigned)__builtin_amdgcn_update_dpp(0, (int)v, 0x143, 0xc, 0xf, false);
    return v;
}
__device__ __forceinline__ void radix_scan(const v4u c, unsigned kk, int lane, unsigned& bin_out, unsigned& rem_out) {
    const unsigned T = c.x + c.y + c.z + c.w; const unsigned S = wave_incl_scan(T);
    const unsigned above = S - T; const bool found = (S >= kk) && (above < kk);
    unsigned bin, rem, cum = above;
    if (cum + c.x >= kk) { bin = 0; rem = kk - cum; } else { cum += c.x;
        if (cum + c.y >= kk) { bin = 1; rem = kk - cum; } else { cum += c.y;
            if (cum + c.z >= kk) { bin = 2; rem = kk - cum; } else { cum += c.z; bin = 3; rem = kk - cum; } } }
    bin += 4 * lane;
    const unsigned long long bm = __ballot(found); const int src = bm ? (__ffsll((long long)bm) - 1) : 0;
    bin_out = (unsigned)__builtin_amdgcn_readlane((int)bin, src); rem_out = (unsigned)__builtin_amdgcn_readlane((int)rem, src);
}
constexpr int LDS_SCSTG = 131072;
constexpr int LDS_MASK = 32768, LDS_KVR = 65536, KV_NS = 5, KV_PD = 3;
#define DMA16(gsrc, ldst) __builtin_amdgcn_global_load_lds((const unsigned*)(gsrc), (LAS unsigned*)(ldst), 16, 0, 0)
#define WAIT_VM(n) asm volatile("s_waitcnt vmcnt(" #n ")" ::: "memory")
#define WG_BAR() do { __builtin_amdgcn_s_barrier(); asm volatile("" ::: "memory"); } while (0)
__device__ __forceinline__ void dsa_unit(Frame& F, int b, int qb) {
    const int w = F.wave;
    bf16* SC = (bf16*)(F.scr + SCR_SC); bf16* YB = (bf16*)(F.scr + SCR_YB);
    const int g = w & 3, kh = w >> 2;
    const int t0 = 128 * qb + 32 * g;
    const int ntile = 4 * qb + g + 1;
    LAS unsigned* maskl = (LAS unsigned*)(F.lds + LDS_MASK);
#define LANE_HERE() int lane = LANE(); asm volatile("" : "+v"(lane)); const int q = lane & 31, h = lane >> 5; const size_t rowq = (size_t)b * SEQ + t0 + q; (void)h; (void)rowq
#ifndef NO_PASSA
    for (int rp = 0; rp < F.repA; ++rp)
    if (qb >= 2) { LANE_HERE();
#pragma unroll 4
        for (int i = 0; i < 16; ++i) { const int idx = i * 512 + 64 * w + lane, row = idx >> 6, c = idx & 63;
            const v4u v = *(const GAS v4u*)(F.QI + ((size_t)b * SEQ + 128 * qb + row) * 512 + c * 8);
            *(LAS v4u*)(F.lds + row * 1024 + ((c ^ (row & 15)) << 4)) = v; }
        const int qrow = 32 * g + q; const int lx = h ^ (qrow & 15);
        unsigned offs[8];
#pragma unroll
        for (int c8 = 0; c8 < 8; ++c8) offs[c8] = (unsigned)(qrow * 1024 + (((2 * c8) ^ lx) << 4));
        const f32x4 w0 = *(const f32x4*)(F.WI + rowq * 8), w1 = *(const f32x4*)(F.WI + rowq * 8 + 4);
        const float wv[8] = {w0.x, w0.y, w0.z, w0.w, w1.x, w1.y, w1.z, w1.w};
        const bf16* kbase = F.KI + ((size_t)b * SEQ + q) * 64 + 8 * h;
        asm volatile("s_waitcnt vmcnt(0) lgkmcnt(0)" ::: "memory"); __syncthreads();
        bf16x8 kf[4], kf1[4];
#pragma unroll
        for (int kk = 0; kk < 4; ++kk) kf[kk] = *(const GAS bf16x8*)(kbase + (size_t)(32 * kh) * 64 + kk * 16);
#pragma unroll 1
        for (int j = kh; j < ntile; j += 2) {
            asm volatile("" ::: "memory");
            {
#pragma unroll
                for (int kk = 0; kk < 4; ++kk) kf1[kk] = *(const GAS bf16x8*)(kbase + (size_t)(32 * (j + 2)) * 64 + kk * 16);
                f32x16 sc;
#pragma unroll
                for (int r = 0; r < 16; ++r) sc[r] = 0.f;
#pragma unroll
                for (int hd = 0; hd < 8; ++hd) { f32x16 d;
#pragma unroll
                    for (int r = 0; r < 16; ++r) d[r] = 0.f;
#pragma unroll
                    for (int kk = 0; kk < 4; ++kk) { const bf16x8 qf = *(const LAS bf16x8*)(F.lds + offs[(hd & 1) * 4 + kk] + 256 * (hd >> 1)); d = MFMA32(kf[kk], qf, d); }
#pragma unroll
                    for (int r = 0; r < 16; ++r) { const float dv = d[r]; const int di = __float_as_int(dv); const float rl = __int_as_float(di & ~(di >> 31)); sc[r] = __builtin_fmaf(wv[hd], rl, sc[r]); }
                    if (hd & 1) { asm volatile("" : "+v"(sc)); __builtin_amdgcn_sched_barrier(0); } }
                if (j >= 4 * qb) {
                    const int dl = t0 + q - 32 * j - 4 * h;
#pragma unroll
                    for (int r = 0; r < 16; ++r) sc[r] = ((r & 3) + 8 * (r >> 2) <= dl) ? sc[r] : -INFINITY;
                }
                {   LAS unsigned char* stg = F.lds + LDS_SCSTG + w * 2560;
#pragma unroll
                    for (int qd = 0; qd < 4; ++qd) { u32x2 o;
                        o.x = __builtin_bit_cast(unsigned, __builtin_amdgcn_cvt_pkrtz(sc[4 * qd + 0], sc[4 * qd + 1]));
                        o.y = __builtin_bit_cast(unsigned, __builtin_amdgcn_cvt_pkrtz(sc[4 * qd + 2], sc[4 * qd + 3]));
                        *(LAS u32x2*)(stg + q * 80 + 16 * qd + 8 * h) = o; }
                    asm volatile("s_waitcnt lgkmcnt(0)" ::: "memory");
                    const int rr = lane >> 2, cc = lane & 3;
                    const v4u v0 = *(const LAS v4u*)(stg + rr * 80 + 16 * cc), v1 = *(const LAS v4u*)(stg + (rr + 16) * 80 + 16 * cc);
                    *(GAS v4u*)(SC + (size_t)(32 * g + rr) * 2048 + 32 * j + 8 * cc) = v0;
                    *(GAS v4u*)(SC + (size_t)(32 * g + rr + 16) * 2048 + 32 * j + 8 * cc) = v1;
                    asm volatile("s_waitcnt lgkmcnt(0)" ::: "memory");
                }
#pragma unroll
                for (int kk = 0; kk < 4; ++kk) kf[kk] = kf1[kk];
            }
        }
    }
#endif
    block_sync_mem(F.wave == 0);
#ifndef NO_PASSB
    for (int rp = 0; rp < F.repB; ++rp)
    { LANE_HERE();
        v4u nxt[4];
        if (qb >= 2) { const GAS v4u* rp_ = (const GAS v4u*)(SC + (size_t)(16 * w) * 2048 + 32 * lane);
#pragma unroll
            for (int k = 0; k < 4; ++k) nxt[k] = rp_[k]; }
#pragma unroll 1
        for (int i = 0; i < 16; ++i) { const int ql = 16 * w + i; const int t = 128 * qb + ql;
            const int lo = 32 * lane;
            const unsigned causal = (t >= lo + 31) ? 0xffffffffu : (t < lo ? 0u : ((2u << (t - lo)) - 1u));
            unsigned word = causal;
            if (qb >= 2) {
                v4u cur[4];
#pragma unroll
                for (int k = 0; k < 4; ++k) cur[k] = nxt[k];
                if (i + 1 < 16) { const GAS v4u* rp_ = (const GAS v4u*)(SC + (size_t)(ql + 1) * 2048 + 32 * lane);
#pragma unroll
                    for (int k = 0; k < 4; ++k) nxt[k] = rp_[k]; }
                const unsigned vmask = (lane <= 4 * qb + (ql >> 5)) ? 0xffffffffu : 0u;
                unsigned nk[16];
#pragma unroll
                for (int k = 0; k < 4; ++k)
#pragma unroll
                    for (int c = 0; c < 4; ++c) { const unsigned x = cur[k][c]; const unsigned sgn = (x >> 15) & 0x00010001u; nk[4 * k + c] = ~((x ^ ((sgn * 0x7fffu) | 0x80008000u)) & vmask); }
                unsigned P = 0u, accb = 0u;
#pragma unroll 1
                for (int bit = 15; bit >= -1; --bit) { const unsigned T = (bit >= 0) ? (P | ((1u << bit) - 1u)) : P;
                    accb = 0u;
#pragma unroll
                    for (int k = 15; k >= 0; --k) { accb = __builtin_amdgcn_alignbit(accb, T - (nk[k] >> 16), 31); accb = __builtin_amdgcn_alignbit(accb, T - (nk[k] & 0xffffu), 31); }
                    if (bit >= 0) { const unsigned notsel = (unsigned)__builtin_amdgcn_readlane((int)wave_incl_scan((unsigned)__builtin_popcount(accb)), 63);
                                    P = (2048u - notsel >= 256u) ? P : (P | (1u << bit)); } }
                word = ~accb & causal;
            }
            maskl[ql * 64 + lane] = word;
#ifdef DIAG
            ((unsigned*)(F.scr + SCR_MK))[ql * 64 + lane] = word;
#endif
        }
    }
    for (int rp = 0; rp < F.repD; ++rp) if (qb >= 2) { LANE_HERE(); unsigned acc = 0u;
#pragma unroll 1
        for (int i = 0; i < 16; ++i) { const GAS v4u* rp_ = (const GAS v4u*)(SC + (size_t)(16 * w + i) * 2048 + 32 * lane);
#pragma unroll
            for (int k = 0; k < 4; ++k) { const v4u v = rp_[k]; acc ^= v.x ^ v.y ^ v.z ^ v.w; } asm volatile("s_waitcnt vmcnt(0)" ::: "memory"); }
        if (acc == 0x12345678u) ((unsigned*)(F.scr + SCR_MK))[lane] = acc; }
#endif
#ifndef NO_PASSC
    for (int rp = 0; rp < F.repC; ++rp)
    { LANE_HERE();
        const int kr_ = 8 * g + (lane >> 3), kc_ = (lane & 7) ^ ((kr_ >> 1) & 7);
        const bf16* ksrc = F.K + ((size_t)b * SEQ + kr_) * 128 + kh * 64 + kc_ * 8;
        const int vd_ = 16 * g + (lane >> 2), vu_ = (lane & 3) ^ ((vd_ >> 2) & 3);
        const bf16* vsrc = F.VT + ((size_t)(b * 2 + kh) * 64 + vd_) * 2048 + vu_ * 8;
        const int kdst = LDS_KVR + kh * 4096 + g * 1024, vdst = LDS_KVR + 8192 + kh * 4096 + g * 1024;
        unsigned koff[4], voff[4];
#pragma unroll
        for (int kk = 0; kk < 4; ++kk) koff[kk] = (unsigned)(LDS_KVR + kh * 4096 + q * 128 + (((2 * kk + h) ^ ((q >> 1) & 7)) << 4));
#pragma unroll
        for (int u = 0; u < 4; ++u) voff[u] = (unsigned)(LDS_KVR + 8192 + kh * 4096 + q * 64 + ((u ^ ((q >> 2) & 3)) << 4) + 8 * h);
        const float kn2 = __builtin_bit_cast(float, __hip_atomic_load(F.ctl + CW_KN + (b * 2 + kh) * 2, __ATOMIC_RELAXED, __HIP_MEMORY_SCOPE_AGENT)) + __builtin_bit_cast(float, __hip_atomic_load(F.ctl + CW_KN + (b * 2 + kh) * 2 + 1, __ATOMIC_RELAXED, __HIP_MEMORY_SCOPE_AGENT));
        const float kmax = __builtin_sqrtf(kn2) * 1.01f;
        const int NT = 4 * (qb + 1);
#pragma unroll 1
        for (int hp = 0; hp < 2; ++hp) {
            const int hA = 4 * kh + 2 * hp;
            bf16x8 qa[4], qc[4]; float qn0 = 0.f, qn1 = 0.f;
#pragma unroll
            for (int kk = 0; kk < 4; ++kk) { qa[kk] = *(const GAS bf16x8*)(F.Q + rowq * 512 + hA * 64 + kk * 16 + 8 * h); qc[kk] = *(const GAS bf16x8*)(F.Q + rowq * 512 + (hA + 1) * 64 + kk * 16 + 8 * h);
#pragma unroll
                for (int e = 0; e < 8; ++e) { const float a = __builtin_bit_cast(float, (unsigned)(unsigned short)qa[kk][e] << 16), c = __builtin_bit_cast(float, (unsigned)(unsigned short)qc[kk][e] << 16); qn0 += a * a; qn1 += c * c; } }
            qn0 += __shfl_xor(qn0, 32); qn1 += __shfl_xor(qn1, 32);
            const float mb = fminf(__builtin_sqrtf(fmaxf(qn0, qn1)) * kmax, 64.0f);
            const unsigned negmb = __float_as_uint(-mb);
            f32x16 oA0, oA1, oB0, oB1;
#pragma unroll
            for (int r = 0; r < 16; ++r) { oA0[r] = 0.f; oA1[r] = 0.f; oB0[r] = 0.f; oB1[r] = 0.f; }
            float lA = 0.f, lB = 0.f;
            asm volatile("s_waitcnt vmcnt(0) lgkmcnt(0)" ::: "memory"); __syncthreads();
#pragma unroll
            for (int p = 0; p < KV_PD; ++p) if (p < NT) { DMA16(ksrc + (size_t)p * 32 * 128, F.lds + kdst + p * 16384); DMA16(vsrc + p * 32, F.lds + vdst + p * 16384); }
#pragma unroll 1
            for (int j = 0; j < NT; ++j) {
                const int slot = (j % KV_NS) * 16384;
                if (j + KV_PD < NT) { const int ns = ((j + KV_PD) % KV_NS) * 16384; DMA16(ksrc + (size_t)(j + KV_PD) * 32 * 128, F.lds + kdst + ns); DMA16(vsrc + (j + KV_PD) * 32, F.lds + vdst + ns); WAIT_VM(6); }
                else { const int rem = NT - 1 - j; if (rem >= 2) { WAIT_VM(4); } else if (rem == 1) { WAIT_VM(2); } else { WAIT_VM(0); } }
                WG_BAR();
                if (j < ntile) {
                    const int mwh = (int)(maskl[(32 * g + q) * 64 + j] >> (4 * h));
                    f32x16 ci;
#pragma unroll
                    for (int r = 0; r < 16; ++r) { const int mr = __builtin_amdgcn_sbfe(mwh, (r & 3) + 8 * (r >> 2), 1); ci[r] = __uint_as_float(((unsigned)mr & negmb) | (~(unsigned)mr & 0xff800000u)); }
                    bf16x8 kf[4];
#pragma unroll
                    for (int kk = 0; kk < 4; ++kk) kf[kk] = *(const LAS bf16x8*)(F.lds + koff[kk] + slot);
                    bf16x8 vt[2][2];
#pragma unroll
                    for (int dt = 0; dt < 2; ++dt)
#pragma unroll
                        for (int sp = 0; sp < 2; ++sp) { const u32x2 lo = *(const LAS u32x2*)(F.lds + voff[2 * sp] + dt * 2048 + slot), hi = *(const LAS u32x2*)(F.lds + voff[2 * sp + 1] + dt * 2048 + slot);
                            vt[dt][sp] = __builtin_bit_cast(bf16x8, ((v4u){lo.x, lo.y, hi.x, hi.y})); }
                    bf16x8 pA0, pA1, pB0, pB1;
                    {   f32x16 sA = MFMA32(kf[0], qa[0], ci);
#pragma unroll
                        for (int kk = 1; kk < 4; ++kk) sA = MFMA32(kf[kk], qa[kk], sA);
                        float l0 = 0.f, l1 = 0.f;
#pragma unroll
                        for (int r = 0; r < 16; r += 2) { sA[r] = __builtin_amdgcn_exp2f(sA[r]); sA[r + 1] = __builtin_amdgcn_exp2f(sA[r + 1]); l0 += sA[r]; l1 += sA[r + 1]; }
                        lA += l0 + l1;
                        v4u pk; pk.x = pkbf(sA[0], sA[1]); pk.y = pkbf(sA[2], sA[3]); pk.z = pkbf(sA[4], sA[5]); pk.w = pkbf(sA[6], sA[7]); pA0 = __builtin_bit_cast(bf16x8, pk);
                        pk.x = pkbf(sA[8], sA[9]); pk.y = pkbf(sA[10], sA[11]); pk.z = pkbf(sA[12], sA[13]); pk.w = pkbf(sA[14], sA[15]); pA1 = __builtin_bit_cast(bf16x8, pk); }
                    asm volatile("" : "+v"(pA0), "+v"(pA1), "+v"(lA)); __builtin_amdgcn_sched_barrier(0);
                    {   f32x16 sB = MFMA32(kf[0], qc[0], ci);
#pragma unroll
                        for (int kk = 1; kk < 4; ++kk) sB = MFMA32(kf[kk], qc[kk], sB);
                        float l0 = 0.f, l1 = 0.f;
#pragma unroll
                        for (int r = 0; r < 16; r += 2) { sB[r] = __builtin_amdgcn_exp2f(sB[r]); sB[r + 1] = __builtin_amdgcn_exp2f(sB[r + 1]); l0 += sB[r]; l1 += sB[r + 1]; }
                        lB += l0 + l1;
                        v4u pk; pk.x = pkbf(sB[0], sB[1]); pk.y = pkbf(sB[2], sB[3]); pk.z = pkbf(sB[4], sB[5]); pk.w = pkbf(sB[6], sB[7]); pB0 = __builtin_bit_cast(bf16x8, pk);
                        pk.x = pkbf(sB[8], sB[9]); pk.y = pkbf(sB[10], sB[11]); pk.z = pkbf(sB[12], sB[13]); pk.w = pkbf(sB[14], sB[15]); pB1 = __builtin_bit_cast(bf16x8, pk); }
                    oA0 = MFMA32(vt[0][0], pA0, oA0); oA0 = MFMA32(vt[0][1], pA1, oA0); oA1 = MFMA32(vt[1][0], pA0, oA1); oA1 = MFMA32(vt[1][1], pA1, oA1);
                    oB0 = MFMA32(vt[0][0], pB0, oB0); oB0 = MFMA32(vt[0][1], pB1, oB0); oB1 = MFMA32(vt[1][0], pB0, oB1); oB1 = MFMA32(vt[1][1], pB1, oB1);
                }
            }
            lA += __shfl_xor(lA, 32); lB += __shfl_xor(lB, 32);
            const float iA = 1.0f / lA, iB = 1.0f / lB;
            bf16* yrow = YB + (size_t)(32 * g + q) * 512 + hA * 64 + 4 * h;
#pragma unroll
            for (int qd = 0; qd < 4; ++qd) { u32x2 o;
                o.x = pkbf(oA0[4 * qd] * iA, oA0[4 * qd + 1] * iA); o.y = pkbf(oA0[4 * qd + 2] * iA, oA0[4 * qd + 3] * iA); *(GAS u32x2*)(yrow + 8 * qd) = o;
                o.x = pkbf(oA1[4 * qd] * iA, oA1[4 * qd + 1] * iA); o.y = pkbf(oA1[4 * qd + 2] * iA, oA1[4 * qd + 3] * iA); *(GAS u32x2*)(yrow + 32 + 8 * qd) = o;
                o.x = pkbf(oB0[4 * qd] * iB, oB0[4 * qd + 1] * iB); o.y = pkbf(oB0[4 * qd + 2] * iB, oB0[4 * qd + 3] * iB); *(GAS u32x2*)(yrow + 64 + 8 * qd) = o;
                o.x = pkbf(oB1[4 * qd] * iB, oB1[4 * qd + 1] * iB); o.y = pkbf(oB1[4 * qd + 2] * iB, oB1[4 * qd + 3] * iB); *(GAS u32x2*)(yrow + 96 + 8 * qd) = o; }
        }
    }
#endif
    block_sync_mem(F.wave == 0);
    { LANE_HERE();
        const f32x4 go0 = *(const f32x4*)(F.g_out_attn + 8 * lane), go1 = *(const f32x4*)(F.g_out_attn + 8 * lane + 4);
#pragma unroll 2
        for (int i = 0; i < 16; ++i) { const int ql = 16 * w + i; const size_t row = (size_t)b * SEQ + 128 * qb + ql;
            const v4u raw = *(const GAS v4u*)(YB + (size_t)ql * 512 + 8 * lane);
            f32x4 a = {bflo(raw.x), bfhi(raw.x), bflo(raw.y), bfhi(raw.y)}, c = {bflo(raw.z), bfhi(raw.z), bflo(raw.w), bfhi(raw.w)};
            const float ss = wave_sum((a.x * a.x + a.y * a.y) + (a.z * a.z + a.w * a.w) + (c.x * c.x + c.y * c.y) + (c.z * c.z + c.w * c.w));
            const float rstd = rsqrtf(ss * (1.f / 512.f) + EPS);
            a = a * rstd * go0; c = c * rstd * go1;
            v4u o; o.x = pkbf(a.x, a.y); o.y = pkbf(a.z, a.w); o.z = pkbf(c.x, c.y); o.w = pkbf(c.z, c.w);
            *(GAS v4u*)(F.MERGED + row * D + 512 + 8 * lane) = o; }
    }
    block_sync_mem(F.wave == 0);
}
#undef DMA16
#undef WAIT_VM
#undef WG_BAR
#undef LANE_HERE

struct Args { const void* in[18]; float* out; unsigned char* ws; int ph_lo, ph_hi; int rep[4]; };
__global__ void __launch_bounds__(NWAVES * 64, 2) fwd_kernel(Args args) {
    extern __shared__ __attribute__((aligned(16))) unsigned char lds[];
    Frame F;
    F.lds = (LAS unsigned char*)lds;
    F.MISC = (volatile LAS unsigned*)(F.lds + MISC_OFF);
    F.wave = __builtin_amdgcn_readfirstlane((int)threadIdx.x >> 6);
    F.G = gridDim.x; { const int bx = blockIdx.x; F.vcu = (F.G % 8 == 0) ? (bx % 8) * (F.G / 8) + bx / 8 : bx; }
    unsigned char* ws = args.ws;
    F.ctl = (gu32*)(ws + WS_CTL);
    F.x = (const float*)args.in[0]; F.c = (const float*)args.in[1]; F.pos = (const int*)args.in[2]; F.w_ada = (const float*)args.in[3]; F.b_ada = (const float*)args.in[4];
    F.g_pre_mix = (const float*)args.in[5]; F.w_in = (const float*)args.in[6]; F.g_sgu_v = (const float*)args.in[7]; F.w_spatial = (const float*)args.in[8]; F.b_spatial = (const float*)args.in[9];
    F.g_out_sgu = (const float*)args.in[10]; F.g_out_attn = (const float*)args.in[11]; F.w_out = (const float*)args.in[12]; F.g_post_mix = (const float*)args.in[13]; F.g_pre_ffn = (const float*)args.in[14];
    F.w_ff1 = (const float*)args.in[15]; F.w_ff2 = (const float*)args.in[16]; F.g_post_ffn = (const float*)args.in[17];
    F.out = args.out; F.repA = args.rep[0]; F.repB = args.rep[1]; F.repC = args.rep[2]; F.repD = args.rep[3];
    F.MOD = (float*)(ws + WS_MOD); F.COS = (float*)(ws + WS_COS); F.SIN = (float*)(ws + WS_SIN); F.PART = (float*)(ws + WS_PART); F.WI = (float*)(ws + WS_WI);
    F.WM = (bf16*)(ws + WS_WM); F.WIN = (bf16*)(ws + WS_WIN); F.WOUT = (bf16*)(ws + WS_WOUT); F.W1 = (bf16*)(ws + WS_W1); F.W2 = (bf16*)(ws + WS_W2);
    F.H = (bf16*)(ws + WS_H); F.ZU = (bf16*)(ws + WS_ZU); F.ZV = (bf16*)(ws + WS_ZV); F.Q = (bf16*)(ws + WS_Q); F.K = (bf16*)(ws + WS_K); F.VT = (bf16*)(ws + WS_VT);
    F.QI = (bf16*)(ws + WS_QI); F.KI = (bf16*)(ws + WS_KI); F.MERGED = (bf16*)(ws + WS_MERGED); F.O = (bf16*)(ws + WS_O); F.HB = (bf16*)(ws + WS_HB); F.FB = (bf16*)(ws + WS_F);
    F.scr = ws + WS_SCR + (size_t)blockIdx.x * SCR_PER_WG;
    for (int u = TID(F); u < (LDS_BYTES - LDSCTL_OFF) / 4; u += NWAVES * 64) ((LAS unsigned*)(F.lds + LDSCTL_OFF))[u] = 0u;
    __syncthreads();
    const int lo = args.ph_lo, hi = args.ph_hi;
    const bool fusedrun = (hi - lo) > 1;
    XcdBarrier bar; bar.wave = F.wave; bar.bar = (unsigned*)(F.ctl + CW_BAR); bar.x = 0; bar.st = nullptr;
    if (fusedrun) bar = xcd_barrier_post((unsigned*)(F.ctl + CW_BAR), F.MISC + 8, F.wave);
#define IN(k) (lo <= (k) && (k) < hi)
#ifdef PROBE_DUP
#define NREP(k) (((k) == PROBE_DUP) ? 2 : 1)
#else
#define NREP(k) 1
#endif
#ifdef ONLY_PHASE
#define PHASE_ON(k) ((k) == ONLY_PHASE)
#else
#define PHASE_ON(k) true
#endif
#define SEAM(k) do { if (IN(k) && IN((k) + 1)) xcd_barrier(bar); } while (0)

    if (PHASE_ON(0) && IN(0)) { p0_prologue(F); SEAM(0); }
    if (PHASE_ON(1) && IN(1)) { p1_hprep(F); SEAM(1); }
    if (PHASE_ON(2) && IN(2)) {
        pg8::Gemm g{F.H, F.WIN, M, DINP, D}; pg8::StaticOrder S; S.init(M, DINP, F.G, (int)blockIdx.x);
        pg8::EpiProj E{F.ZU, F.ZV, F.Q, F.K, F.VT, F.QI, F.KI, F.WI, F.COS, F.SIN, (unsigned*)(F.ctl + CW_KN)};
        pg8::gemm_phase<pg8::EpiProj, pg8::StaticOrder, PG8_ALIGN, PG8_SP2>(F.lds + RING_OFF, g, S, E, F.wave);
        SEAM(2);
    }
    if (PHASE_ON(3) && IN(3)) {
        for (int u = F.vcu; u < BATCH * 16; u += F.G) sgu_unit(F, u >> 4, u & 15);
    }
    if (PHASE_ON(4) && IN(4)) {
        for (int u = F.vcu; u < BATCH * 8; u += F.G) { const int b = u >> 3, p = u & 7;
#pragma unroll 1
            for (int k = 0; k < 2; ++k) dsa_unit(F, b, k ? p : 15 - p); }
        SEAM(4);
    }
    if (PHASE_ON(5) && IN(5)) {
        pg8::Gemm g{F.MERGED, F.WOUT, M, D, D}; pg8::StaticOrder S; S.init(M, D, F.G, (int)blockIdx.x);
        pg8::EpiNormPart E{F.O, D, F.PART};
        pg8::gemm_phase<pg8::EpiNormPart, pg8::StaticOrder, PG8_ALIGN, PG8_SP2>(F.lds + RING_OFF, g, S, E, F.wave);
        SEAM(5);
    }
    if (PHASE_ON(6) && IN(6)) { p5_postmix(F); SEAM(6); }
    if (PHASE_ON(7) && IN(7)) {
        pg8::Gemm g{F.H, F.W1, M, FF, D}; pg8::StaticOrder S; S.init(M, FF, F.G, (int)blockIdx.x);
        pg8::EpiRelu2 E{F.HB, FF};
        pg8::gemm_phase<pg8::EpiRelu2, pg8::StaticOrder, PG8_ALIGN, PG8_SP2>(F.lds + RING_OFF, g, S, E, F.wave);
        SEAM(7);
    }
    if (PHASE_ON(8) && IN(8)) {
        pg8::Gemm g{F.HB, F.W2, M, D, FF}; pg8::StaticOrder S; S.init(M, D, F.G, (int)blockIdx.x);
        pg8::EpiNormPart E{F.FB, D, F.PART};
        pg8::gemm_phase<pg8::EpiNormPart, pg8::StaticOrder, PG8_ALIGN, PG8_SP2>(F.lds + RING_OFF, g, S, E, F.wave);
        SEAM(8);
    }
    if (PHASE_ON(9) && IN(9)) { p8_final(F);
#ifdef DIAG
        {
            asm volatile("s_waitcnt vmcnt(0)" ::: "memory"); __syncthreads();
            float code = 0.f;
#pragma unroll
            for (int k = 0; k < 4; ++k) { const float e = __builtin_bit_cast(float, __hip_atomic_load(F.ctl + 8192 + DIAG_SET * 4 + k, __ATOMIC_RELAXED, __HIP_MEMORY_SCOPE_AGENT)); if (e > DIAG_TOL) code += 0.25f * (float)(1 << k); }
            const int gw = F.vcu * NWAVES + F.wave, NGW = F.G * NWAVES;
            for (int chunk = gw; chunk < M / 32; chunk += NGW) for (int r = 0; r < 32; ++r) { GAS f32x4* outr = (GAS f32x4*)(F.out + ((size_t)chunk * 32 + r) * D) + LANE();
#pragma unroll
                for (int j = 0; j < 4; ++j) outr[64 * j] = outr[64 * j] * (1.0f + code); }
        }
#endif
    }
#undef IN
#undef SEAM
}


#ifdef DIAG
constexpr int CW_DIAG = 8192;
__device__ __forceinline__ void diag_max(gu32* ctl, int k, float err) { if (!(err == err)) err = 1e30f; atomicMax((unsigned*)(ctl + CW_DIAG + k), __builtin_bit_cast(unsigned, err)); }
__device__ __forceinline__ float relerr(float got, float want, float floor_) { return __builtin_fabsf(got - want) / (__builtin_fabsf(want) + floor_); }
__device__ __forceinline__ float bf2f(bf16 v) { return __builtin_bit_cast(float, (unsigned)v << 16); }
__device__ __forceinline__ float h2f(unsigned short v) { return (float)__builtin_bit_cast(_Float16, v); }
__device__ __forceinline__ float wave_max(float v) {
#pragma unroll
    for (int o = 1; o < 64; o <<= 1) v = fmaxf(v, __shfl_xor(v, o));
    return v;
}
__device__ __forceinline__ float gelu_ref(float p) { return p / (1.0f + __expf(-1.5957691216057308f * (p + 0.044715f * p * p * p))); }
__global__ void __launch_bounds__(512) diag_kernel(Args args) {
    __shared__ float pr[8][2400];
    unsigned char* ws = args.ws; gu32* ctl = (gu32*)(ws + WS_CTL);
    const float* x = (const float*)args.in[0]; const float* cc_ = (const float*)args.in[1]; const float* w_ada = (const float*)args.in[3]; const float* b_ada = (const float*)args.in[4];
    const float* g_pre_mix = (const float*)args.in[5]; const float* g_sgu_v = (const float*)args.in[7]; const float* b_spatial = (const float*)args.in[9]; const float* g_out_sgu = (const float*)args.in[10];
    const float* MOD = (const float*)(ws + WS_MOD); const float* COS = (const float*)(ws + WS_COS); const float* SIN = (const float*)(ws + WS_SIN); const float* WI = (const float*)(ws + WS_WI);
    const bf16 *WM = (const bf16*)(ws + WS_WM), *WIN = (const bf16*)(ws + WS_WIN), *H = (const bf16*)(ws + WS_H), *ZU = (const bf16*)(ws + WS_ZU), *ZV = (const bf16*)(ws + WS_ZV), *Q = (const bf16*)(ws + WS_Q), *K = (const bf16*)(ws + WS_K),
               *VT = (const bf16*)(ws + WS_VT), *QI = (const bf16*)(ws + WS_QI), *KI = (const bf16*)(ws + WS_KI), *MERGED = (const bf16*)(ws + WS_MERGED);
    const int tid = threadIdx.x, lane = tid & 63, w = tid >> 6, G = gridDim.x; const int bx = blockIdx.x, vcu = (G % 8 == 0) ? (bx % 8) * (G / 8) + bx / 8 : bx; const int gw = vcu * 8 + w;
    {
        const size_t m = ((size_t)gw * 97 + 13) % M; const size_t b = m >> 11, s = m & 2047;
#pragma unroll 1
        for (int i = 0; i < 38; ++i) { const int col = lane + 64 * i; float acc = 0.f;
            if (col < DIN) {
#pragma unroll 4
                for (int k = 0; k < D; ++k) acc += bf2f(H[m * D + k]) * bf2f(WIN[(size_t)col * D + k]);
                pr[w][col] = acc; } }
        __syncthreads();
#pragma unroll 1
        for (int i = 0; i < 38; ++i) { const int col = lane + 64 * i; if (col >= DIN) break;
            const float p = pr[w][col];
            if (col < 1024) { const float got = bf2f(col < 512 ? ZU[m * 512 + col] : ZV[m * 512 + col - 512]); diag_max(ctl, 4, relerr(got, gelu_ref(p), 0.05f)); }
            else if (col < 1664) { const bool isq = col < 1536; const int cc = isq ? col - 1024 : col - 1536; const int d = cc & 63; float v = p;
                if (d < 8) v = p * COS[m * 8 + d] - pr[w][col + 8] * SIN[m * 8 + d]; else if (d < 16) v = p * COS[m * 8 + d - 8] + pr[w][col - 8] * SIN[m * 8 + d - 8];
                if (isq) v *= 0.18033688011112042f;
                const float got = bf2f(isq ? Q[m * 512 + cc] : K[m * 128 + cc]); diag_max(ctl, 5, relerr(got, v, 0.05f)); }
            else if (col < 1792) { const int cc = col - 1664, kvh = cc >> 6, d = cc & 63; const float got = bf2f(VT[((b * 2 + kvh) * 64 + d) * 2048 + s]); diag_max(ctl, 6, relerr(got, p, 0.05f)); }
            else if (col < 2368) { const bool isq = col < 2304; const int cc = isq ? col - 1792 : col - 2304; const int d = cc & 63; float v = p;
                if (d < 8) v = p * COS[m * 8 + d] - pr[w][col + 8] * SIN[m * 8 + d]; else if (d < 16) v = p * COS[m * 8 + d - 8] + pr[w][col - 8] * SIN[m * 8 + d - 8];
                if (isq) v *= 0.125f;
                const float got = bf2f(isq ? QI[m * 512 + cc] : KI[m * 64 + cc]); diag_max(ctl, 5, relerr(got, v, 0.05f)); }
            else { const float got = WI[m * 8 + col - 2368]; diag_max(ctl, 6, relerr(got, p * 0.3535533905932738f, 0.05f)); } }
        { const int bb = gw & 31, e = (gw * 131 + 7) % 6144; float acc = 0.f;
          for (int k = lane; k < D; k += 64) { const float cv = cc_[bb * D + k]; acc += cv / (1.0f + __expf(-cv)) * w_ada[(size_t)k * 6144 + e]; }
          acc = wave_sum(acc) + b_ada[e]; diag_max(ctl, 7, relerr(MOD[bb * 6144 + e], acc, 0.02f)); }
        { float ss = 0.f; for (int k = lane; k < D; k += 64) { const float xv = x[m * D + k]; ss += xv * xv; }
          const float rstd = rsqrtf(wave_sum(ss) / D + EPS); const int k = (lane * 17 + 3) & 1023; const float* mod = MOD + b * 6144;
          const float want = x[m * D + k] * rstd * g_pre_mix[k] * (1.f + mod[1024 + k]) + mod[k]; diag_max(ctl, 7, relerr(bf2f(H[m * D + k]), want, 0.02f)); }
    }
    {
        const size_t m = ((size_t)gw * 61 + 29) % M; const size_t R0 = m & ~(size_t)127; const int tc = (int)(m & 127);
        float ssq = 0.f;
#pragma unroll 1
        for (int pass = 0; pass < 2; ++pass) { const float rs = rsqrtf(wave_sum(ssq) * (1.f / 512.f) + EPS);
#pragma unroll 1
            for (int e = 0; e < 8; ++e) { const int c = 8 * lane + e, g = c >> 7; float mix = 0.f;
#pragma unroll 1
                for (int s2 = 0; s2 <= tc; ++s2) {
                    float gs = 0.f; for (int k = 0; k < 128; ++k) { const float zv = bf2f(ZV[(R0 + s2) * 512 + g * 128 + k]); gs += zv * zv; }
                    const float vnv = bf2f((bf16)f2bf(bf2f(ZV[(R0 + s2) * 512 + c]) * rsqrtf(gs * (1.f / 128.f) + EPS) * g_sgu_v[c]));
                    mix += bf2f(WM[(g * 128 + tc) * 128 + s2]) * vnv; }
                const float yv = (mix + b_spatial[g * 128 + tc]) * bf2f(ZU[(R0 + tc) * 512 + c]);
                if (pass == 0) ssq += yv * yv; else diag_max(ctl, 3, relerr(bf2f(MERGED[(R0 + tc) * D + c]), yv * rs * g_out_sgu[c], 0.05f)); } }
    }
    if (vcu < 256) {
        const int b = vcu >> 3, qb = vcu & 7;
        const unsigned char* scr = ws + WS_SCR + (size_t)blockIdx.x * SCR_PER_WG;
        const unsigned short* SC = (const unsigned short*)(scr + SCR_SC); const unsigned* MK = (const unsigned*)(scr + SCR_MK); const bf16* YB = (const bf16*)(scr + SCR_YB);
#pragma unroll 1
        for (int i = 0; i < 16; ++i) { const int ql = 16 * w + i, t = 128 * qb + ql; int pc = __builtin_popcount(MK[ql * 64 + lane]);
#pragma unroll
            for (int o = 1; o < 64; o <<= 1) pc += __shfl_xor(pc, o);
            const int want = (t + 1 < 256) ? t + 1 : 256; if (pc < want || pc > want + 16) diag_max(ctl, 0, 1.0f + (float)(pc > want ? pc - want : want - pc)); }
        if (qb >= 2) { const int ql = 16 * w + 5, t = 128 * qb + ql; const size_t row = (size_t)b * SEQ + t; const int s2 = (lane * 37 + w * 11) % (t + 1); const size_t krow = (size_t)b * SEQ + s2;
            float sc2 = 0.f;
#pragma unroll 1
            for (int hd = 0; hd < 8; ++hd) { float d = 0.f; for (int dd = 0; dd < 64; ++dd) d += bf2f(QI[row * 512 + hd * 64 + dd]) * bf2f(KI[krow * 64 + dd]); sc2 += WI[row * 8 + hd] * fmaxf(d, 0.f); }
            diag_max(ctl, 1, relerr(h2f(SC[(size_t)ql * 2048 + s2]), sc2, 0.05f));
            float mins = INFINITY, maxu = -INFINITY;
#pragma unroll 1
            for (int s3 = lane; s3 <= t; s3 += 64) { const float v = h2f(SC[(size_t)ql * 2048 + s3]); if ((MK[ql * 64 + (s3 >> 5)] >> (s3 & 31)) & 1u) mins = fminf(mins, v); else maxu = fmaxf(maxu, v); }
            mins = -wave_max(-mins); maxu = wave_max(maxu); if (maxu > mins) diag_max(ctl, 0, 100.0f); }
        { const int ql = 16 * w + 9, t = 128 * qb + ql, hd = w, kvh = hd >> 2; const size_t row = (size_t)b * SEQ + t;
          const float qd = bf2f(Q[row * 512 + hd * 64 + lane]); float mrun = -1e30f, lrun = 0.f, o = 0.f;
#pragma unroll 1
          for (int s2 = 0; s2 <= t; ++s2) { if (!((MK[ql * 64 + (s2 >> 5)] >> (s2 & 31)) & 1u)) continue;
              const float lg = wave_sum(qd * bf2f(K[((size_t)b * SEQ + s2) * 128 + kvh * 64 + lane]));
              const float mn = fmaxf(mrun, lg), al = __builtin_amdgcn_exp2f(mrun - mn), p = __builtin_amdgcn_exp2f(lg - mn);
              lrun = lrun * al + p; o = o * al + p * bf2f(VT[((size_t)(b * 2 + kvh) * 64 + lane) * 2048 + s2]); mrun = mn; }
          diag_max(ctl, 2, relerr(bf2f(YB[(size_t)ql * 512 + hd * 64 + lane]), o / lrun, 0.02f)); }
    }
}
#endif

extern "C" void kernel_launch(void* const* d_in, const int* in_sizes, int n_in, void* d_out, int out_size, void* d_ws, size_t ws_size, hipStream_t stream) {
    static int grid = 0;
    if (grid == 0) {
        if (n_in != 18 || in_sizes[0] != M * D || out_size != M * D || ws_size < WS_END) { fprintf(stderr, "kernel_launch: unexpected problem shape or workspace (n_in %d, ws %zu < %zu)\n", n_in, ws_size, (size_t)WS_END); grid = -1; return; }
        int dev = 0, cus = 0, per_cu = 0;
        if (hipGetDevice(&dev) != hipSuccess || hipDeviceGetAttribute(&cus, hipDeviceAttributeMultiprocessorCount, dev) != hipSuccess) { grid = -1; return; }
        if (hipFuncSetAttribute((const void*)fwd_kernel, hipFuncAttributeMaxDynamicSharedMemorySize, LDS_BYTES) != hipSuccess) { grid = -1; return; }
        if (hipOccupancyMaxActiveBlocksPerMultiprocessor(&per_cu, (const void*)fwd_kernel, NWAVES * 64, LDS_BYTES) != hipSuccess || per_cu < 1) { fprintf(stderr, "kernel_launch: occupancy query reports %d workgroups per CU\n", per_cu); }
        (void)hipGetLastError();
        grid = cus;
    }
    if (grid < 0) return;
    if (hipMemsetAsync((char*)d_ws + WS_CTL, 0, CTL_ZERO_BYTES, stream) != hipSuccess) return;
    Args a{};
    a.rep[0] = 1; a.rep[1] = 1; a.rep[2] = 1; a.rep[3] = 0;
#ifdef PROBE_REP
    a.rep[PROBE_REP] += 1;
#endif
    for (int i = 0; i < 18; ++i) a.in[i] = d_in[i];
    a.out = (float*)d_out; a.ws = (unsigned char*)d_ws;
#if defined(PROBE_SPLIT)
    a.ph_lo = 0; a.ph_hi = PROBE_SPLIT + 1; hipLaunchKernelGGL(fwd_kernel, dim3(grid), dim3(NWAVES * 64), LDS_BYTES, stream, a);
    (void)hipMemsetAsync((char*)d_ws + WS_CTL, 0, CTL_ZERO_BYTES, stream);
    a.ph_lo = PROBE_SPLIT; a.ph_hi = N_PHASES; hipLaunchKernelGGL(fwd_kernel, dim3(grid), dim3(NWAVES * 64), LDS_BYTES, stream, a);
#elif MK_N_LAUNCHES == 1
    a.ph_lo = 0; a.ph_hi = N_PHASES;
    hipLaunchKernelGGL(fwd_kernel, dim3(grid), dim3(NWAVES * 64), LDS_BYTES, stream, a);
#else
    for (int li = 0; li < N_PHASES; ++li) { a.ph_lo = li; a.ph_hi = li + 1; hipLaunchKernelGGL(fwd_kernel, dim3(grid), dim3(NWAVES * 64), LDS_BYTES, stream, a);
#ifdef DIAG
        if (li == 4) hipLaunchKernelGGL(diag_kernel, dim3(grid), dim3(512), 0, stream, a);
#endif
    }
#endif
}
```

```cpp
#include <hip/hip_runtime.h>
#include <cstdio>
#include <cstdint>
#define MK_N_LAUNCHES 1
namespace pg8 {
#define PG8_LAS __attribute__((address_space(3)))
typedef unsigned short bf16_t;
typedef short bf16x8 __attribute__((ext_vector_type(8)));
typedef float f32x4 __attribute__((ext_vector_type(4)));
typedef unsigned u32x4 __attribute__((ext_vector_type(4)));
constexpr int BM = 256, BK = 64, HALF = 128, HTB = HALF * BK * 2  , STAGE_BYTES = 8 * HTB, NXCD = 8, WGM = 8;

__host__ __device__ __forceinline__ int lds_byte(int r, int c) { const int st = (r >> 4) * 2 + (c >> 5), rr = r & 15, cc = c & 31, ob = rr * 64 + cc * 2; return st * 1024 + (ob ^ (((ob >> 9) & 1) << 5)); }
__host__ __device__ __forceinline__ void stage_rc(int b, int& R, int& C) { const int st = b / 1024, sb = b % 1024, swz = sb ^ (((sb >> 9) & 1) << 5); R = (st >> 1) * 16 + swz / 64; C = (st & 1) * 32 + (swz % 64) / 2; }
__host__ __device__ __forceinline__ int perm32(int rho) { const int n = rho >> 4, i = rho & 15; return 8 * (i >> 2) + 4 * n + (i & 3); }

struct Unit { int pm, pn; };
struct Gemm { const bf16_t* A; const bf16_t* Bt; int M, N, K; };

struct StaticOrder {
    int nM, nN, nwg, G, c;
    __host__ __device__ void init(int M, int N, int G_, int c_) { nM = M / BM; nN = N / BM; nwg = nM * nN; G = G_; c = c_; }
    __host__ __device__ bool next(int i, Unit& u) const {
        const long L = (long)i * G + c; if (L >= nwg) return false;
        int wgid = (int)L; { const int q = nwg / NXCD, r = nwg % NXCD, xcd = wgid % NXCD, off = wgid / NXCD; wgid = (xcd < r ? xcd * (q + 1) : r * (q + 1) + (xcd - r) * q) + off; }
        const int nig = WGM * nN, gid = wgid / nig, fm = gid * WGM, gsz = (nM - fm) < WGM ? (nM - fm) : WGM;
        u.pm = fm + ((wgid % nig) % gsz); u.pn = (wgid % nig) / gsz; return true;
    }
    __device__ __forceinline__ void a_ready(const Unit&) const {}
    __device__ __forceinline__ void done(const Unit&) const {}
};
__device__ __forceinline__ unsigned cvt_pk_bf16(float lo, float hi) { unsigned r; asm volatile("v_cvt_pk_bf16_f32 %0, %1, %2" : "=v"(r) : "v"(lo), "v"(hi)); return r; }
typedef unsigned u32x2 __attribute__((ext_vector_type(2)));
__device__ __forceinline__ float gelu_tanh(float x) {
    const float u = x * (1.0f + 0.044715f * x * x);
    const float e = __builtin_amdgcn_exp2f(-2.302208198f * u);
    return x * __builtin_amdgcn_rcpf(1.0f + e);
}
__device__ __forceinline__ void store8(bf16_t* p, const f32x4& v0, const f32x4& v1) {
    u32x4 w; w.x = cvt_pk_bf16(v0[0], v0[1]); w.y = cvt_pk_bf16(v0[2], v0[3]); w.z = cvt_pk_bf16(v1[0], v1[1]); w.w = cvt_pk_bf16(v1[2], v1[3]);
    *(u32x4*)p = w;
}
__device__ __forceinline__ void rope8(f32x4& v0, f32x4& v1, const f32x4& c0, const f32x4& c1, const f32x4& s0, const f32x4& s1, int fq) {
    f32x4 p0, p1;
#pragma unroll
    for (int i = 0; i < 4; ++i) { p0[i] = __shfl_xor(v0[i], 16); p1[i] = __shfl_xor(v1[i], 16); }
    const float sg = (fq == 0) ? -1.f : 1.f;
    if (fq < 2) { v0 = v0 * c0 + sg * (p0 * s0); v1 = v1 * c1 + sg * (p1 * s1); }
}
constexpr float QSCALE = 0.18033688011112042f;
constexpr float QISCALE = 0.125f;
constexpr float WISCALE = 0.3535533905932738f;
struct EpiProj {
    static constexpr bool PERM = true, AFTER_DRAIN = false;
    bf16_t *ZU, *ZV, *Q, *K, *VT, *QI, *KI; float* WI; const float* cs; const float* sn; unsigned* KN;
    __device__ __forceinline__ void operator()(const f32x4 (&acc)[2][2][4][2], const Unit& u, int wr, int wc, int fr, int fq) const {
        const int pn = u.pn; const int row0 = u.pm * BM + wr * 64 + fr; const int cw = wc * 32 + 8 * fq;
        if (pn < 4) {
            bf16_t* base = (pn < 2) ? ZU : ZV; const int colt = (pn & 1) * 256;
#pragma unroll
            for (int ai = 0; ai < 2; ++ai)
#pragma unroll
                for (int m = 0; m < 4; ++m) { const size_t row = (size_t)(row0 + ai * HALF + m * 16);
#pragma unroll
                    for (int bj = 0; bj < 2; ++bj) { f32x4 v0 = acc[ai][bj][m][0], v1 = acc[ai][bj][m][1];
#pragma unroll
                        for (int i = 0; i < 4; ++i) { v0[i] = gelu_tanh(v0[i]); v1[i] = gelu_tanh(v1[i]); }
                        store8(base + row * 512 + colt + bj * HALF + cw, v0, v1); } }
        } else if (pn == 4 || pn == 5 || pn == 7 || pn == 8) {
            const bool isq = pn < 6; bf16_t* base = isq ? Q : QI; const int colt = (isq ? pn - 4 : pn - 7) * 256; const float sc = isq ? QSCALE : QISCALE;
            const bool rope = (wc & 1) == 0;
#pragma unroll
            for (int ai = 0; ai < 2; ++ai)
#pragma unroll
                for (int m = 0; m < 4; ++m) { const size_t row = (size_t)(row0 + ai * HALF + m * 16);
                    f32x4 c0 = {1.f, 1.f, 1.f, 1.f}, c1 = c0, s0 = {0.f, 0.f, 0.f, 0.f}, s1 = s0;
                    if (rope) { c0 = *(const f32x4*)(cs + row * 8); c1 = *(const f32x4*)(cs + row * 8 + 4); s0 = *(const f32x4*)(sn + row * 8); s1 = *(const f32x4*)(sn + row * 8 + 4); }
#pragma unroll
                    for (int bj = 0; bj < 2; ++bj) { f32x4 v0 = acc[ai][bj][m][0], v1 = acc[ai][bj][m][1];
                        if (rope) rope8(v0, v1, c0, c1, s0, s1, fq);
                        v0 = v0 * sc; v1 = v1 * sc;
                        store8(base + row * 512 + colt + bj * HALF + cw, v0, v1); } }
        } else if (pn == 6) {
            const bool rope = (wc & 1) == 0; float kn = 0.f;
#pragma unroll
            for (int ai = 0; ai < 2; ++ai)
#pragma unroll
                for (int m = 0; m < 4; ++m) { const size_t row = (size_t)(row0 + ai * HALF + m * 16);
                    { f32x4 v0 = acc[ai][0][m][0], v1 = acc[ai][0][m][1];
                      if (rope) { const f32x4 c0 = *(const f32x4*)(cs + row * 8), c1 = *(const f32x4*)(cs + row * 8 + 4), s0 = *(const f32x4*)(sn + row * 8), s1 = *(const f32x4*)(sn + row * 8 + 4);
                                  rope8(v0, v1, c0, c1, s0, s1, fq); }
                      store8(K + row * 128 + cw, v0, v1);
                      float rs = (v0[0] * v0[0] + v0[1] * v0[1]) + (v0[2] * v0[2] + v0[3] * v0[3]) + (v1[0] * v1[0] + v1[1] * v1[1]) + (v1[2] * v1[2] + v1[3] * v1[3]);
                      rs += __shfl_xor(rs, 16); rs += __shfl_xor(rs, 32); kn = fmaxf(kn, rs); }
                    { const f32x4 v0 = acc[ai][1][m][0], v1 = acc[ai][1][m][1];
                      const size_t b = row >> 11, s = row & 2047; const int kvh = cw >> 6, d0 = cw & 63;
                      bf16_t* vp = VT + ((b * 2 + kvh) * 64 + d0) * 2048 + s;
                      const unsigned w0 = cvt_pk_bf16(v0[0], v0[1]), w1 = cvt_pk_bf16(v0[2], v0[3]), w2 = cvt_pk_bf16(v1[0], v1[1]), w3 = cvt_pk_bf16(v1[2], v1[3]);
                      vp[0 * 2048] = (bf16_t)(w0 & 0xffffu); vp[1 * 2048] = (bf16_t)(w0 >> 16); vp[2 * 2048] = (bf16_t)(w1 & 0xffffu); vp[3 * 2048] = (bf16_t)(w1 >> 16);
                      vp[4 * 2048] = (bf16_t)(w2 & 0xffffu); vp[5 * 2048] = (bf16_t)(w2 >> 16); vp[6 * 2048] = (bf16_t)(w3 & 0xffffu); vp[7 * 2048] = (bf16_t)(w3 >> 16); } }
            kn = fmaxf(kn, __shfl_xor(kn, 1)); kn = fmaxf(kn, __shfl_xor(kn, 2)); kn = fmaxf(kn, __shfl_xor(kn, 4)); kn = fmaxf(kn, __shfl_xor(kn, 8));
            if (fr == 0 && fq == 0) atomicMax(KN + ((u.pm >> 3) * 2 + (wc >> 1)) * 2 + (wc & 1), __float_as_uint(kn));
        } else {
            if (wc < 2) {
                const bool rope = wc == 0;
#pragma unroll
                for (int ai = 0; ai < 2; ++ai)
#pragma unroll
                    for (int m = 0; m < 4; ++m) { const size_t row = (size_t)(row0 + ai * HALF + m * 16);
                        f32x4 v0 = acc[ai][0][m][0], v1 = acc[ai][0][m][1];
                        if (rope) { const f32x4 c0 = *(const f32x4*)(cs + row * 8), c1 = *(const f32x4*)(cs + row * 8 + 4), s0 = *(const f32x4*)(sn + row * 8), s1 = *(const f32x4*)(sn + row * 8 + 4);
                                    rope8(v0, v1, c0, c1, s0, s1, fq); }
                        store8(KI + row * 64 + cw, v0, v1); }
            } else if (wc == 2 && fq == 0) {
#pragma unroll
                for (int ai = 0; ai < 2; ++ai)
#pragma unroll
                    for (int m = 0; m < 4; ++m) { const size_t row = (size_t)(row0 + ai * HALF + m * 16);
                        *(f32x4*)(WI + row * 8) = acc[ai][0][m][0] * WISCALE; *(f32x4*)(WI + row * 8 + 4) = acc[ai][0][m][1] * WISCALE; }
            }
        }
    }
};
struct EpiRelu2 {
    static constexpr bool PERM = true, AFTER_DRAIN = false;
    bf16_t* O; int ldc;
    __device__ __forceinline__ void operator()(const f32x4 (&acc)[2][2][4][2], const Unit& u, int wr, int wc, int fr, int fq) const {
        const int row0 = u.pm * BM + wr * 64 + fr; const int col0 = u.pn * BM + wc * 32 + 8 * fq;
#pragma unroll
        for (int ai = 0; ai < 2; ++ai)
#pragma unroll
            for (int m = 0; m < 4; ++m) { bf16_t* rowp = O + (size_t)(row0 + ai * HALF + m * 16) * ldc + col0;
#pragma unroll
                for (int bj = 0; bj < 2; ++bj) { f32x4 v0 = acc[ai][bj][m][0], v1 = acc[ai][bj][m][1];
#pragma unroll
                    for (int i = 0; i < 4; ++i) { const float a = fmaxf(v0[i], 0.f), b = fmaxf(v1[i], 0.f); v0[i] = a * a; v1[i] = b * b; }
                    store8(rowp + bj * HALF, v0, v1); } }
    }
};
struct EpiNormPart {
    static constexpr bool PERM = true, AFTER_DRAIN = false;
    bf16_t* O; int ldc; float* part;
    __device__ __forceinline__ void operator()(const f32x4 (&acc)[2][2][4][2], const Unit& u, int wr, int wc, int fr, int fq) const {
        const int row0 = u.pm * BM + wr * 64 + fr; const int col0 = u.pn * BM + wc * 32 + 8 * fq;
#pragma unroll
        for (int ai = 0; ai < 2; ++ai)
#pragma unroll
            for (int m = 0; m < 4; ++m) { const size_t row = (size_t)(row0 + ai * HALF + m * 16); bf16_t* rowp = O + row * ldc + col0; float s = 0.f;
#pragma unroll
                for (int bj = 0; bj < 2; ++bj) { const f32x4 v0 = acc[ai][bj][m][0], v1 = acc[ai][bj][m][1];
                    s += (v0[0] * v0[0] + v0[1] * v0[1]) + (v0[2] * v0[2] + v0[3] * v0[3]) + (v1[0] * v1[0] + v1[1] * v1[1]) + (v1[2] * v1[2] + v1[3] * v1[3]);
                    store8(rowp + bj * HALF, v0, v1); }
                s += __shfl_xor(s, 16); s += __shfl_xor(s, 32);
                if (fq == 0) part[row * 16 + u.pn * 4 + wc] = s; }
    }
};
template <class Epi, class Sched, bool ALIGN_EPI = false, bool SP2 = false>
__device__ __forceinline__ void gemm_phase(PG8_LAS unsigned char* lds, const Gemm g, const Sched& S, const Epi& E, const int wave_in) {
    const int lane = (int)__builtin_amdgcn_mbcnt_hi(~0u, __builtin_amdgcn_mbcnt_lo(~0u, 0u)), wid = wave_in, tid = wid * 64 + lane, wr = wid >> 2, wc = wid & 3, fr = lane & 15, fq = lane >> 4;
    const int K = g.K, nt = K / BK;
    unsigned voffA[2], voffB[2];
#pragma unroll
    for (int i = 0; i < 2; ++i) { int R, C; stage_rc(tid * 16 + i * 8192, R, C); const int Rb = Epi::PERM ? ((R & ~31) + perm32(R & 31)) : R;
        voffA[i] = (unsigned)(R * K + C) * 2u; voffB[i] = (unsigned)(Rb * K + C) * 2u; }
    const size_t kstep = (size_t)(BK * 2);
    const size_t hstep = (size_t)HALF * K * 2;
    const size_t tstep = 2 * hstep;
    const unsigned ldsw = (unsigned)wid * 1024u;
    const int aoff = lds_byte(wr * 64 + fr, fq * 8), boff = lds_byte(wc * 32 + fr, fq * 8);
#define PG8_SA(b, h) (((b) * 2 + (h)) * HTB)
#define PG8_SB(b, h) ((4 + (b) * 2 + (h)) * HTB)
#define PG8_STAGE(bufoff, gbase, voff) do { _Pragma("unroll") for (int _i = 0; _i < 2; ++_i) \
        __builtin_amdgcn_global_load_lds((const unsigned*)((const char*)(gbase) + (voff)[_i]), (PG8_LAS unsigned*)(lds + (bufoff) + ldsw + _i * 8192), 16, 0, 0); } while (0)
#define PG8_LDA(dst, b, h) do { _Pragma("unroll") for (int m = 0; m < 4; ++m) _Pragma("unroll") for (int k = 0; k < 2; ++k) dst[m][k] = *(const PG8_LAS bf16x8*)(lds + PG8_SA(b, h) + aoff + m * 2048 + k * 1024); } while (0)
#define PG8_LDB(dst, b, h) do { _Pragma("unroll") for (int n = 0; n < 2; ++n) _Pragma("unroll") for (int k = 0; k < 2; ++k) dst[n][k] = *(const PG8_LAS bf16x8*)(lds + PG8_SB(b, h) + boff + n * 2048 + k * 1024); } while (0)
#define PG8_MMA(ai, bj, At, Bt) do { __builtin_amdgcn_s_setprio(1); _Pragma("unroll") for (int m = 0; m < 4; ++m) _Pragma("unroll") for (int n = 0; n < 2; ++n) _Pragma("unroll") for (int k = 0; k < 2; ++k) \
        acc[ai][bj][m][n] = __builtin_amdgcn_mfma_f32_16x16x32_bf16(Bt[n][k], At[m][k], acc[ai][bj][m][n], 0, 0, 0); __builtin_amdgcn_s_setprio(0); } while (0)
#define PG8_WAIT_V(n) asm volatile("s_waitcnt vmcnt(" #n ")" ::: "memory")
#define PG8_WAIT_L(n) asm volatile("s_waitcnt lgkmcnt(" #n ")" ::: "memory")
#define PG8_BAR __builtin_amdgcn_s_barrier()
#define PG8_SCHED __builtin_amdgcn_sched_barrier(0)
    Unit cur, nxt; int ui = 0;
    if (!S.next(0, cur)) return;
    f32x4 acc[2][2][4][2];
#pragma unroll
    for (int a = 0; a < 2; ++a)
#pragma unroll
        for (int b = 0; b < 2; ++b)
#pragma unroll
            for (int m = 0; m < 4; ++m)
#pragma unroll
                for (int n = 0; n < 2; ++n) acc[a][b][m][n] = (f32x4){0.f, 0.f, 0.f, 0.f};
    bf16x8 At[4][2], B0[2][2], B1[2][2];
    const char* cA = (const char*)g.A + (size_t)cur.pm * tstep; const char* cB = (const char*)g.Bt + (size_t)cur.pn * tstep;
    S.a_ready(cur);
    if constexpr (SP2) {
        PG8_STAGE(PG8_SB(0, 0), cB, voffB); PG8_STAGE(PG8_SB(0, 1), cB + hstep, voffB); PG8_STAGE(PG8_SA(0, 0), cA, voffA); PG8_STAGE(PG8_SA(0, 1), cA + hstep, voffA);
        if (wr == 1) PG8_BAR;
        PG8_WAIT_V(2); PG8_BAR;
        PG8_STAGE(PG8_SB(1, 0), cB + kstep, voffB); PG8_STAGE(PG8_SA(1, 0), cA + kstep, voffA); PG8_STAGE(PG8_SB(1, 1), cB + hstep + kstep, voffB);
        PG8_WAIT_V(6); PG8_BAR;
    } else {
        PG8_STAGE(PG8_SB(0, 0), cB, voffB); PG8_STAGE(PG8_SA(0, 0), cA, voffA); PG8_STAGE(PG8_SB(0, 1), cB + hstep, voffB); PG8_STAGE(PG8_SA(0, 1), cA + hstep, voffA);
        if (wr == 1) PG8_BAR;
        PG8_WAIT_V(4); PG8_BAR;
        PG8_STAGE(PG8_SB(1, 0), cB + kstep, voffB); PG8_STAGE(PG8_SA(1, 0), cA + kstep, voffA); PG8_STAGE(PG8_SB(1, 1), cB + hstep + kstep, voffB);
        PG8_WAIT_V(6); PG8_BAR;
    }
    for (;;) {
        const bool has_next = S.next(ui + 1, nxt);
        const char* nA = has_next ? (const char*)g.A + (size_t)nxt.pm * tstep : cA; const char* nB = has_next ? (const char*)g.Bt + (size_t)nxt.pn * tstep : cB;
        for (int t = 0; t < nt; t += 2) {
            const bool last = (t == nt - 2);
            const char* a1 = cA + (size_t)(t + 1) * kstep;
            const char* a2 = last ? nA : cA + (size_t)(t + 2) * kstep; const char* b2 = last ? nB : cB + (size_t)(t + 2) * kstep;
            const char* a3 = a2 + kstep; const char* b3 = b2 + kstep;
            if (last && has_next) S.a_ready(nxt);
            if constexpr (SP2) {
            PG8_LDB(B0, 0, 0); PG8_LDB(B1, 0, 1); PG8_SCHED; PG8_LDA(At, 0, 0); PG8_STAGE(PG8_SA(1, 1), a1 + hstep, voffA);
            PG8_WAIT_V(8); PG8_WAIT_L(0); PG8_BAR; PG8_MMA(0, 0, At, B0); PG8_MMA(0, 1, At, B1); PG8_BAR; PG8_SCHED;
            PG8_LDA(At, 0, 1); PG8_STAGE(PG8_SB(0, 0), b2, voffB); PG8_STAGE(PG8_SB(0, 1), b2 + hstep, voffB); PG8_STAGE(PG8_SA(0, 0), a2, voffA);
            PG8_WAIT_V(8); PG8_WAIT_L(0); PG8_BAR; PG8_MMA(1, 0, At, B0); PG8_MMA(1, 1, At, B1); PG8_BAR; PG8_SCHED;
            PG8_LDB(B0, 1, 0); PG8_LDB(B1, 1, 1); PG8_SCHED; PG8_LDA(At, 1, 0); PG8_STAGE(PG8_SA(0, 1), a2 + hstep, voffA);
            PG8_WAIT_V(8); PG8_WAIT_L(0); PG8_BAR; PG8_MMA(0, 0, At, B0); PG8_MMA(0, 1, At, B1); PG8_BAR; PG8_SCHED;
            PG8_LDA(At, 1, 1); PG8_STAGE(PG8_SB(1, 0), b3, voffB); PG8_STAGE(PG8_SB(1, 1), b3 + hstep, voffB); PG8_STAGE(PG8_SA(1, 0), a3, voffA);
            PG8_WAIT_V(8); PG8_WAIT_L(0); PG8_BAR; PG8_MMA(1, 0, At, B0); PG8_MMA(1, 1, At, B1); PG8_BAR; PG8_SCHED;
            } else {
            PG8_LDB(B0, 0, 0); PG8_SCHED; PG8_LDA(At, 0, 0); PG8_STAGE(PG8_SA(1, 1), a1 + hstep, voffA);
            PG8_WAIT_L(8); PG8_BAR; PG8_WAIT_L(0); PG8_MMA(0, 0, At, B0); PG8_BAR; PG8_SCHED;
            PG8_LDB(B1, 0, 1); PG8_STAGE(PG8_SB(0, 0), b2, voffB);
            PG8_BAR; PG8_WAIT_L(0); PG8_MMA(0, 1, At, B1); PG8_BAR;
            PG8_LDA(At, 0, 1); PG8_STAGE(PG8_SA(0, 0), a2, voffA);
            PG8_BAR; PG8_WAIT_L(0); PG8_MMA(1, 0, At, B0); PG8_BAR; PG8_SCHED;
            PG8_STAGE(PG8_SB(0, 1), b2 + hstep, voffB);
            PG8_WAIT_V(6); PG8_BAR; PG8_MMA(1, 1, At, B1); PG8_BAR;
            PG8_LDB(B0, 1, 0); PG8_SCHED; PG8_LDA(At, 1, 0); PG8_STAGE(PG8_SA(0, 1), a2 + hstep, voffA);
            PG8_WAIT_L(8); PG8_BAR; PG8_WAIT_L(0); PG8_MMA(0, 0, At, B0); PG8_BAR; PG8_SCHED;
            PG8_LDB(B1, 1, 1); PG8_STAGE(PG8_SB(1, 0), b3, voffB);
            PG8_BAR; PG8_WAIT_L(0); PG8_MMA(0, 1, At, B1); PG8_BAR;
            PG8_LDA(At, 1, 1); PG8_STAGE(PG8_SA(1, 0), a3, voffA);
            PG8_BAR; PG8_WAIT_L(0); PG8_MMA(1, 0, At, B0); PG8_BAR; PG8_SCHED;
            PG8_STAGE(PG8_SB(1, 1), b3 + hstep, voffB);
            PG8_WAIT_V(6); PG8_BAR; PG8_MMA(1, 1, At, B1); PG8_BAR;
            }
        }
        if constexpr (ALIGN_EPI) { if (wr == 0) PG8_BAR; }
        if constexpr (!Epi::AFTER_DRAIN) { E(acc, cur, wr, wc, fr, fq); S.done(cur); }
        if (!has_next) break;
#pragma unroll
        for (int a = 0; a < 2; ++a)
#pragma unroll
            for (int b = 0; b < 2; ++b)
#pragma unroll
                for (int m = 0; m < 4; ++m)
#pragma unroll
                    for (int n = 0; n < 2; ++n) acc[a][b][m][n] = (f32x4){0.f, 0.f, 0.f, 0.f};
        cur = nxt; cA = nA; cB = nB; ++ui;
        if constexpr (ALIGN_EPI) { if (wr == 1) PG8_BAR; }
    }
    PG8_WAIT_V(0);
    if constexpr (!ALIGN_EPI) { if (wr == 0) PG8_BAR; }
    PG8_BAR;
    if constexpr (Epi::AFTER_DRAIN) { E.fused(acc, cur, wr, wc, fr, fq, lds, wid, lane); S.done(cur); }
#undef PG8_SA
#undef PG8_SB
#undef PG8_STAGE
#undef PG8_LDA
#undef PG8_LDB
#undef PG8_MMA
#undef PG8_WAIT_V
#undef PG8_WAIT_L
#undef PG8_BAR
#undef PG8_SCHED
}
}
#define PG8_SP2 true
#define PG8_ALIGN true
#define GAS __attribute__((address_space(1)))
#define LAS __attribute__((address_space(3)))
typedef unsigned short bf16;
typedef unsigned v4u __attribute__((ext_vector_type(4)));
typedef float f32x4 __attribute__((ext_vector_type(4)));
typedef short bf16x8 __attribute__((ext_vector_type(8)));
typedef GAS unsigned gu32;
typedef GAS unsigned long long gu64;
#define RLX_AGENT __ATOMIC_RELAXED, __HIP_MEMORY_SCOPE_AGENT
#define LDS_WAIT() asm volatile("s_waitcnt lgkmcnt(0)" ::: "memory")
#define VM_WAIT() asm volatile("s_waitcnt vmcnt(0)" ::: "memory")
__device__ __forceinline__ unsigned long long rt() { return __builtin_amdgcn_s_memrealtime(); }
__device__ __forceinline__ unsigned f2bf(float f) { unsigned u = __builtin_bit_cast(unsigned, f); return (u + 0x7fffu + ((u >> 16) & 1u)) >> 16; }
__device__ __forceinline__ unsigned pk2(float lo, float hi) { return f2bf(lo) | (f2bf(hi) << 16); }

#define XB_LANE() ((int)__builtin_amdgcn_mbcnt_hi(~0u, __builtin_amdgcn_mbcnt_lo(~0u, 0u)))
#define XB_TMO      128
#define XB_XCNT(j)  (256  + 64 * (j))
#define XB_XSUB(j)  (1280 + 64 * (j))
#define XB_XGEN(j)  (2304 + 64 * (j))
#define XB_TOP      3328
#define XB_TOPGEN   3392
#define XCD_BAR_WORDS 3456
#define XB_SPIN_CAP (1u << 18)

__device__ __forceinline__ unsigned xb_ld(unsigned* p)              { return __hip_atomic_load(p, __ATOMIC_RELAXED, __HIP_MEMORY_SCOPE_AGENT); }
__device__ __forceinline__ unsigned xb_add(unsigned* p, unsigned v) { return __hip_atomic_fetch_add(p, v, __ATOMIC_RELAXED, __HIP_MEMORY_SCOPE_AGENT); }
__device__ __forceinline__ unsigned xb_xcc_id() { return (unsigned)__builtin_amdgcn_s_getreg((3 << 11) | 20) & 0xFu; }
#define XB_SPIN(cond, bar) do { unsigned _sp = 0; while (cond) { __builtin_amdgcn_s_sleep(1); \
    if ((++_sp & 255u) == 0u) { if (xb_ld(&(bar)[XB_TMO])) break; if (_sp > XB_SPIN_CAP) { atomicAdd(&(bar)[XB_TMO], 1u); break; } } } } while (0)

struct XcdBarrier {
    int wave;
    unsigned* bar; unsigned x;
    volatile LAS unsigned* st;
};

__device__ __forceinline__ XcdBarrier xcd_barrier_post(unsigned* bar, volatile LAS unsigned* st, int wave_in) {
    XcdBarrier b; b.wave = wave_in; b.bar = bar; b.x = xb_xcc_id(); b.st = st;
    if (b.wave == 0 && XB_LANE() == 0) (void)xb_add(&bar[XB_XCNT(b.x)], 1u);
    return b;
}
__device__ __forceinline__ void xcd_barrier_complete(unsigned* bar, unsigned x, unsigned& nloc, unsigned& nx) {
    const unsigned G = gridDim.x * gridDim.y * gridDim.z;
    unsigned sum, cnt, mine, sp = 0u;
    for (;;) {
        sum = 0u; cnt = 0u; mine = 0u;
#pragma unroll
        for (unsigned j = 0; j < 16; ++j) { const unsigned c = xb_ld(&bar[XB_XCNT(j)]); sum += c; cnt += (c > 0u) ? 1u : 0u; mine = (j == x) ? c : mine; }
        if (sum == G) break;
        __builtin_amdgcn_s_sleep(1);
        if ((++sp & 255u) == 0u) { if (xb_ld(&bar[XB_TMO])) break; if (sp > XB_SPIN_CAP) { atomicAdd(&bar[XB_TMO], 1u); break; } }
    }
    nloc = mine > 0u ? mine : 1u; nx = cnt > 0u ? cnt : 1u;
}

__device__ __forceinline__ void xcd_barrier(const XcdBarrier& b) {
    asm volatile("s_waitcnt vmcnt(0)" ::: "memory");
    __syncthreads();
    if (b.wave == 0 && XB_LANE() == 0) {
        unsigned* bar = b.bar;
        __builtin_amdgcn_s_waitcnt(0);
        unsigned nloc = b.st[0], nx = b.st[1];
        if (nloc == 0u) { xcd_barrier_complete(bar, b.x, nloc, nx); b.st[0] = nloc; b.st[1] = nx; }
        const unsigned old = xb_add(&bar[XB_XSUB(b.x)], 1u);
        const unsigned gen = old / nloc;
        if (old + 1u == (gen + 1u) * nloc) {
            __builtin_amdgcn_fence(__ATOMIC_RELEASE, "agent");
            asm volatile("s_waitcnt vmcnt(0)" ::: "memory");
            const unsigned og = xb_add(&bar[XB_TOP], 1u);
            const unsigned tg = og / nx;
            if (og + 1u == (tg + 1u) * nx) xb_add(&bar[XB_TOPGEN], 1u);
            else XB_SPIN(xb_ld(&bar[XB_TOPGEN]) == tg, bar);
            __builtin_amdgcn_fence(__ATOMIC_ACQUIRE, "agent");
            xb_add(&bar[XB_XGEN(b.x)], 1u);
            asm volatile("s_waitcnt vmcnt(0)" ::: "memory");
        } else {
            XB_SPIN(xb_ld(&bar[XB_XGEN(b.x)]) == gen, bar);
            __builtin_amdgcn_fence(__ATOMIC_ACQUIRE, "agent");
            asm volatile("s_waitcnt vmcnt(0)" ::: "memory");
        }
    }
    __syncthreads();
}
#ifndef MK_N_LAUNCHES
#define MK_N_LAUNCHES 1
#endif
constexpr int NWAVES = 8;
constexpr int N_PHASES = 10;
constexpr int BATCH = 32, SEQ = 2048, D = 1024, M = BATCH * SEQ, DIN = 2376, DINP = 2560, FF = 4096, DSGU = 512;
constexpr float EPS = 1e-6f;
constexpr size_t MiB = 1u << 20;
constexpr size_t WS_CTL = 0, CTL_ZERO_BYTES = 1 * MiB;
constexpr size_t WS_MOD = 1 * MiB;
constexpr size_t WS_COS = 2 * MiB, WS_SIN = 4 * MiB;
constexpr size_t WS_WM = 6 * MiB;
constexpr size_t WS_PART = 7 * MiB;
constexpr size_t WS_WIN = 12 * MiB, WS_WOUT = 17 * MiB, WS_W1 = 19 * MiB, WS_W2 = 27 * MiB;
constexpr size_t WS_WI = 36 * MiB;
constexpr size_t WS_H = 40 * MiB;
constexpr size_t WS_BIG = 168 * MiB;
constexpr size_t WS_ZU = WS_BIG, WS_ZV = WS_BIG + 64 * MiB, WS_Q = WS_BIG + 128 * MiB, WS_K = WS_BIG + 192 * MiB, WS_VT = WS_BIG + 208 * MiB,
                 WS_QI = WS_BIG + 224 * MiB, WS_KI = WS_BIG + 288 * MiB, WS_MERGED = WS_BIG + 296 * MiB;
constexpr size_t WS_O = WS_BIG;
constexpr size_t WS_HB = WS_BIG;
constexpr size_t WS_SCR = WS_BIG + 512 * MiB;
constexpr size_t WS_F = WS_SCR;
constexpr size_t WS_END = WS_SCR + 256 * MiB;
constexpr size_t SCR_PER_WG = 1 * MiB, SCR_SC = 0, SCR_MK = 512 * 1024, SCR_YB = 768 * 1024;
constexpr int CW_BAR = 4096;
constexpr int CW_KN = 12288;
constexpr int RING_OFF = 0, RING_BYTES = 131072;
constexpr int LDSCTL_OFF = 159744, MISC_OFF = LDSCTL_OFF + 320, AUX_OFF = LDSCTL_OFF + 1024;
constexpr int LDS_BYTES = 163840;

typedef float f32x16 __attribute__((ext_vector_type(16)));
typedef float f32x2 __attribute__((ext_vector_type(2)));
typedef unsigned u32x2 __attribute__((ext_vector_type(2)));
#define MFMA32(a, b, c) __builtin_amdgcn_mfma_f32_32x32x16_bf16((a), (b), (c), 0, 0, 0)
#define LANE() ((int)__builtin_amdgcn_mbcnt_hi(~0u, __builtin_amdgcn_mbcnt_lo(~0u, 0u)))
#define TID(F) ((F).wave * 64 + LANE())

struct Frame {
    LAS unsigned char* lds;
    volatile LAS unsigned* MISC;
    gu32* ctl;
    int wave, vcu, G; int repA, repB, repC, repD, repE, repF, repG, repH;
    const float *x, *c; const int* pos; const float *w_ada, *b_ada, *g_pre_mix, *w_in, *g_sgu_v, *w_spatial, *b_spatial, *g_out_sgu, *g_out_attn, *w_out, *g_post_mix, *g_pre_ffn, *w_ff1, *w_ff2, *g_post_ffn;
    float* out;
    float *MOD, *COS, *SIN, *PART, *WI;
    bf16 *WM, *WIN, *WOUT, *W1, *W2, *H, *ZU, *ZV, *Q, *K, *VT, *QI, *KI, *MERGED, *O, *HB, *FB;
    unsigned char* scr;
};
__device__ __forceinline__ float bflo(unsigned u) { return __builtin_bit_cast(float, u << 16); }
__device__ __forceinline__ float bfhi(unsigned u) { return __builtin_bit_cast(float, u & 0xffff0000u); }
__device__ __forceinline__ unsigned pkbf(float lo, float hi) { return pg8::cvt_pk_bf16(lo, hi); }
__device__ __forceinline__ float wave_sum(float v) {
#pragma unroll
    for (int o = 1; o < 64; o <<= 1) v += __shfl_xor(v, o);
    return v;
}
__device__ __forceinline__ void block_sync_mem(bool wave0) {
    asm volatile("s_waitcnt vmcnt(0)" ::: "memory");
    __syncthreads();
    if (wave0 && LANE() == 0) { __builtin_amdgcn_fence(__ATOMIC_ACQUIRE, "agent"); asm volatile("s_waitcnt vmcnt(0)" ::: "memory"); }
    __syncthreads();
}

__device__ __forceinline__ void p0_transpose_item(const float* W, int K, int N, int Npad, bf16* WT, LAS float* scr, int item, int lane) {
    const int nblk = Npad / 32, kb = item / nblk, nb = item % nblk, k0 = 64 * kb, n0 = 32 * nb;
    const int nn = n0 + (lane & 31);
#pragma unroll 8
    for (int i = 0; i < 32; ++i) { const int kk = 2 * i + (lane >> 5); scr[kk * 33 + (lane & 31)] = (nn < N) ? W[(size_t)(k0 + kk) * N + nn] : 0.f; }
    LDS_WAIT(); asm volatile("" ::: "memory");
    const int c = lane & 7;
#pragma unroll
    for (int j = 0; j < 4; ++j) { const int n = (lane >> 3) + 8 * j; const LAS float* s = scr + (8 * c) * 33 + n;
        v4u o; o.x = pk2(s[0 * 33], s[1 * 33]); o.y = pk2(s[2 * 33], s[3 * 33]); o.z = pk2(s[4 * 33], s[5 * 33]); o.w = pk2(s[6 * 33], s[7 * 33]);
        *(GAS v4u*)(WT + (size_t)(n0 + n) * K + k0 + 8 * c) = o; }
    LDS_WAIT(); asm volatile("" ::: "memory");
}
__device__ __forceinline__ void p0_mod_unit(Frame& F, int u) {
    const int lane = LANE(), w = F.wave, tid = TID(F);
    LAS float* csl = (LAS float*)F.lds + w * 4096;
#pragma unroll 4
    for (int i = 0; i < 64; ++i) { const int idx = i * 64 + lane, b = idx >> 7, d = idx & 127; const float cv = F.c[b * D + 128 * w + d];
        csl[d * 32 + b] = cv / (1.0f + __expf(-cv)); }
    LDS_WAIT(); asm volatile("" ::: "memory");
    float acc[32];
#pragma unroll
    for (int b = 0; b < 32; ++b) acc[b] = 0.f;
    const float* wp = F.w_ada + (size_t)(128 * w) * 6144 + 64 * u + lane;
#pragma unroll 2
    for (int d = 0; d < 128; ++d) { const float wv = wp[(size_t)d * 6144];
#pragma unroll
        for (int b4 = 0; b4 < 8; ++b4) { const f32x4 cc = *(const LAS f32x4*)(csl + d * 32 + 4 * b4);
            acc[4 * b4 + 0] += cc[0] * wv; acc[4 * b4 + 1] += cc[1] * wv; acc[4 * b4 + 2] += cc[2] * wv; acc[4 * b4 + 3] += cc[3] * wv; } }
    __syncthreads();
    LAS float* red = (LAS float*)F.lds;
#pragma unroll
    for (int b = 0; b < 32; ++b) red[(w * 32 + b) * 64 + lane] = acc[b];
    __syncthreads();
#pragma unroll
    for (int k = 0; k < 4; ++k) { const int o = tid + 512 * k, b = o >> 6, col = o & 63; float s = 0.f;
#pragma unroll
        for (int ww = 0; ww < 8; ++ww) s += red[(ww * 32 + b) * 64 + col];
        F.MOD[b * 6144 + 64 * u + col] = s + F.b_ada[64 * u + col]; }
    __syncthreads();
}
__device__ __forceinline__ void p0_prologue(Frame& F) {
    for (int u = F.vcu; u < 96; u += F.G) p0_mod_unit(F, u);
    LAS float* scr = (LAS float*)(F.lds + RING_OFF + F.wave * 16384);
    const int gw = F.vcu * NWAVES + F.wave, NGW = F.G * NWAVES;
    constexpr int I_IN = (D / 64) * (DINP / 32), I_OUT = (D / 64) * (D / 32), I_1 = (D / 64) * (FF / 32), I_2 = (FF / 64) * (D / 32);
    constexpr int NITEMS = I_IN + I_OUT + I_1 + I_2;
    for (int it = gw; it < NITEMS; it += NGW) {
        int r = it;
        if (r < I_IN) { p0_transpose_item(F.w_in, D, DIN, DINP, F.WIN, scr, r, LANE()); continue; } r -= I_IN;
        if (r < I_OUT) { p0_transpose_item(F.w_out, D, D, D, F.WOUT, scr, r, LANE()); continue; } r -= I_OUT;
        if (r < I_1) { p0_transpose_item(F.w_ff1, D, FF, FF, F.W1, scr, r, LANE()); continue; } r -= I_1;
        p0_transpose_item(F.w_ff2, FF, D, D, F.W2, scr, r, LANE());
    }
    const int gt = F.vcu * NWAVES * 64 + TID(F), NT = F.G * NWAVES * 64;
    for (int i = gt; i < 4 * 128 * 128; i += NT) { const int t = (i >> 7) & 127, s = i & 127; F.WM[i] = (bf16)f2bf(s <= t ? F.w_spatial[i] : 0.f); }
    for (int i = gt; i < M * 8; i += NT) { const int m = i >> 3, j = i & 7;
        const double rpp = (j == 0) ? 0.15915494309189535 : (j == 1) ? 0.03086376340470123 : (j == 2) ? 0.005985185712713705 : (j == 3) ? 0.001160663641240061 :
                           (j == 4) ? 0.00022507907903927653 : (j == 5) ? 4.364795279280289e-05 : (j == 6) ? 8.464330808241401e-06 : 1.6414262627950345e-06;
        const double rev = (double)F.pos[m] * rpp; const float fr = (float)(rev - __builtin_floor(rev));
        F.COS[i] = __builtin_amdgcn_cosf(fr); F.SIN[i] = __builtin_amdgcn_sinf(fr); }
}
__device__ __forceinline__ void p1_hprep(Frame& F) {
    const int gw = F.vcu * NWAVES + F.wave, NGW = F.G * NWAVES, lane = LANE();
    for (int chunk = gw; chunk < M / 32; chunk += NGW) {
        const int b = (chunk * 32) / SEQ; const float* mod = F.MOD + b * 6144;
        f32x4 ga[4], sh[4];
#pragma unroll
        for (int j = 0; j < 4; ++j) { const int c = 4 * lane + 256 * j; const f32x4 g = *(const f32x4*)(F.g_pre_mix + c), sc = *(const f32x4*)(mod + 1024 + c); ga[j] = g * (sc + 1.0f); sh[j] = *(const f32x4*)(mod + c); }
        const GAS f32x4* xr0 = (const GAS f32x4*)(F.x + (size_t)chunk * 32 * D) + lane;
        f32x4 nx[4];
#pragma unroll
        for (int j = 0; j < 4; ++j) nx[j] = xr0[64 * j];
#pragma unroll 1
        for (int r = 0; r < 32; ++r) { const size_t m = (size_t)chunk * 32 + r;
            f32x4 v[4]; float s = 0.f;
#pragma unroll
            for (int j = 0; j < 4; ++j) { v[j] = nx[j]; s += (v[j].x * v[j].x + v[j].y * v[j].y) + (v[j].z * v[j].z + v[j].w * v[j].w); }
            if (r + 1 < 32) { const GAS f32x4* xn = xr0 + (size_t)(r + 1) * (D / 4);
#pragma unroll
                for (int j = 0; j < 4; ++j) nx[j] = xn[64 * j]; }
            const float rstd = rsqrtf(wave_sum(s) * (1.f / D) + EPS);
            GAS u32x2* o8 = (GAS u32x2*)(F.H + m * D) + lane;
#pragma unroll
            for (int j = 0; j < 4; ++j) { const f32x4 o = v[j] * rstd * ga[j] + sh[j]; u32x2 w; w.x = pkbf(o.x, o.y); w.y = pkbf(o.z, o.w); o8[64 * j] = w; } }
    }
}
__device__ __forceinline__ void p5_postmix(Frame& F) {
    const int gw = F.vcu * NWAVES + F.wave, NGW = F.G * NWAVES, lane = LANE();
    for (int chunk = gw; chunk < M / 32; chunk += NGW) {
        const int b = (chunk * 32) / SEQ; const float* mod = F.MOD + b * 6144;
        f32x4 g1[4], ga[4], sh[4];
#pragma unroll
        for (int j = 0; j < 4; ++j) { const int c = 4 * lane + 256 * j;
            g1[j] = *(const f32x4*)(mod + 2048 + c) * *(const f32x4*)(F.g_post_mix + c);
            ga[j] = *(const f32x4*)(F.g_pre_ffn + c) * (*(const f32x4*)(mod + 4096 + c) + 1.0f); sh[j] = *(const f32x4*)(mod + 3072 + c); }
        const GAS f32x4* xr0 = (const GAS f32x4*)(F.x + (size_t)chunk * 32 * D) + lane; const GAS u32x2* or0 = (const GAS u32x2*)(F.O + (size_t)chunk * 32 * D) + lane;
        f32x4 nx[4]; u32x2 no[4]; float nps = F.PART[(size_t)chunk * 32 * 16 + (lane & 15)];
#pragma unroll
        for (int j = 0; j < 4; ++j) { nx[j] = xr0[64 * j]; no[j] = or0[64 * j]; }
#pragma unroll 1
        for (int r = 0; r < 32; ++r) { const size_t m = (size_t)chunk * 32 + r;
            float ps = nps; f32x4 xv[4]; u32x2 ow[4];
#pragma unroll
            for (int j = 0; j < 4; ++j) { xv[j] = nx[j]; ow[j] = no[j]; }
            if (r + 1 < 32) { const GAS f32x4* xn = xr0 + (size_t)(r + 1) * (D / 4); const GAS u32x2* on = or0 + (size_t)(r + 1) * (D / 4); nps = F.PART[(m + 1) * 16 + (lane & 15)];
#pragma unroll
                for (int j = 0; j < 4; ++j) { nx[j] = xn[64 * j]; no[j] = on[64 * j]; } }
            ps += __shfl_xor(ps, 1); ps += __shfl_xor(ps, 2); ps += __shfl_xor(ps, 4); ps += __shfl_xor(ps, 8);
            const float rstd_o = rsqrtf(ps * (1.f / D) + EPS);
            GAS f32x4* outr = (GAS f32x4*)(F.out + m * D) + lane;
            f32x4 v[4]; float s = 0.f;
#pragma unroll
            for (int j = 0; j < 4; ++j) { const f32x4 ov = {bflo(ow[j].x), bfhi(ow[j].x), bflo(ow[j].y), bfhi(ow[j].y)};
                v[j] = xv[j] + g1[j] * (ov * rstd_o); outr[64 * j] = v[j];
                s += (v[j].x * v[j].x + v[j].y * v[j].y) + (v[j].z * v[j].z + v[j].w * v[j].w); }
            const float rstd = rsqrtf(wave_sum(s) * (1.f / D) + EPS);
            GAS u32x2* o8 = (GAS u32x2*)(F.H + m * D) + lane;
#pragma unroll
            for (int j = 0; j < 4; ++j) { const f32x4 o = v[j] * rstd * ga[j] + sh[j]; u32x2 w; w.x = pkbf(o.x, o.y); w.y = pkbf(o.z, o.w); o8[64 * j] = w; } }
    }
}
__device__ __forceinline__ void p8_final(Frame& F) {
    const int gw = F.vcu * NWAVES + F.wave, NGW = F.G * NWAVES, lane = LANE();
    for (int chunk = gw; chunk < M / 32; chunk += NGW) {
        const int b = (chunk * 32) / SEQ; const float* mod = F.MOD + b * 6144;
        f32x4 g2[4];
#pragma unroll
        for (int j = 0; j < 4; ++j) { const int c = 4 * lane + 256 * j; g2[j] = *(const f32x4*)(mod + 5120 + c) * *(const f32x4*)(F.g_post_ffn + c); }
        const GAS u32x2* fr0 = (const GAS u32x2*)(F.FB + (size_t)chunk * 32 * D) + lane; GAS f32x4* out0 = (GAS f32x4*)(F.out + (size_t)chunk * 32 * D) + lane;
        f32x4 nx[4]; u32x2 nf[4]; float nps = F.PART[(size_t)chunk * 32 * 16 + (lane & 15)];
#pragma unroll
        for (int j = 0; j < 4; ++j) { nx[j] = out0[64 * j]; nf[j] = fr0[64 * j]; }
#pragma unroll 1
        for (int r = 0; r < 32; ++r) { const size_t m = (size_t)chunk * 32 + r;
            float ps = nps; f32x4 xv[4]; u32x2 fw[4];
#pragma unroll
            for (int j = 0; j < 4; ++j) { xv[j] = nx[j]; fw[j] = nf[j]; }
            if (r + 1 < 32) { const GAS f32x4* xn = out0 + (size_t)(r + 1) * (D / 4); const GAS u32x2* fn = fr0 + (size_t)(r + 1) * (D / 4); nps = F.PART[(m + 1) * 16 + (lane & 15)];
#pragma unroll
                for (int j = 0; j < 4; ++j) { nx[j] = xn[64 * j]; nf[j] = fn[64 * j]; } }
            ps += __shfl_xor(ps, 1); ps += __shfl_xor(ps, 2); ps += __shfl_xor(ps, 4); ps += __shfl_xor(ps, 8);
            const float rstd_f = rsqrtf(ps * (1.f / D) + EPS);
            GAS f32x4* outr = out0 + (size_t)r * (D / 4);
#pragma unroll
            for (int j = 0; j < 4; ++j) { const f32x4 fv = {bflo(fw[j].x), bfhi(fw[j].x), bflo(fw[j].y), bfhi(fw[j].y)};
                outr[64 * j] = xv[j] + g2[j] * (fv * rstd_f); } }
    }
}
__device__ __forceinline__ void sgu_unit(Frame& F, int b, int n) {
    const int tid = TID(F), lane = LANE(), w = F.wave;
    const size_t R0 = (size_t)b * SEQ + (size_t)n * 128;
    LAS bf16* vn = (LAS bf16*)F.lds;
    LAS float* rpart = (LAS float*)(F.lds + AUX_OFF);
    {
        f32x4 gv0 = *(const f32x4*)(F.g_sgu_v + 8 * lane), gv1 = *(const f32x4*)(F.g_sgu_v + 8 * lane + 4);
#pragma unroll 4
        for (int i = 0; i < 16; ++i) { const int s = 16 * w + i;
            const v4u raw = *(const GAS v4u*)(F.ZV + (R0 + s) * DSGU + 8 * lane);
            f32x4 a = {bflo(raw.x), bfhi(raw.x), bflo(raw.y), bfhi(raw.y)}, c = {bflo(raw.z), bfhi(raw.z), bflo(raw.w), bfhi(raw.w)};
            float ss = (a.x * a.x + a.y * a.y) + (a.z * a.z + a.w * a.w) + (c.x * c.x + c.y * c.y) + (c.z * c.z + c.w * c.w);
            ss += __shfl_xor(ss, 1); ss += __shfl_xor(ss, 2); ss += __shfl_xor(ss, 4); ss += __shfl_xor(ss, 8);
            const float rstd = rsqrtf(ss * (1.f / 128.f) + EPS);
            a = a * rstd * gv0; c = c * rstd * gv1;
            v4u o; o.x = pkbf(a.x, a.y); o.y = pkbf(a.z, a.w); o.z = pkbf(c.x, c.y); o.w = pkbf(c.z, c.w);
            *(LAS v4u*)(vn + s * DSGU + 8 * lane) = o; }
    }
    __syncthreads();
    const int tt = w & 3, ch = w >> 2, tl = lane & 31, h = lane >> 5;
    const int t = tt * 32 + tl;
    f32x16 acc[8];
#pragma unroll
    for (int i = 0; i < 8; ++i)
#pragma unroll
        for (int r = 0; r < 16; ++r) acc[i][r] = 0.f;
    const int kmax = 2 * (tt + 1);
#pragma unroll
    for (int gi = 0; gi < 2; ++gi) { const int g = 2 * ch + gi;
        const bf16* bp = F.WM + ((size_t)(g * 128 + t)) * 128 + 8 * h;
#pragma unroll
        for (int ct = 0; ct < 4; ++ct) { const LAS bf16* colp = vn + g * 128 + ct * 32 + tl + 8 * h * DSGU;
            f32x16 a = acc[gi * 4 + ct];
#pragma unroll 2
            for (int kk = 0; kk < kmax; ++kk) {
                const LAS bf16* p = colp + kk * 16 * DSGU;
                const unsigned e0 = p[0], e1 = p[DSGU], e2 = p[2 * DSGU], e3 = p[3 * DSGU], e4 = p[4 * DSGU], e5 = p[5 * DSGU], e6 = p[6 * DSGU], e7 = p[7 * DSGU];
                v4u pk; pk.x = e0 | (e1 << 16); pk.y = e2 | (e3 << 16); pk.z = e4 | (e5 << 16); pk.w = e6 | (e7 << 16);
                const bf16x8 Bf = *(const GAS bf16x8*)(bp + kk * 16);
                a = MFMA32(__builtin_bit_cast(bf16x8, pk), Bf, a); }
            acc[gi * 4 + ct] = a; }
    }
    float ssq = 0.f;
#pragma unroll
    for (int gi = 0; gi < 2; ++gi) { const int g = 2 * ch + gi; const float bias = F.b_spatial[g * 128 + t];
#pragma unroll
        for (int ct = 0; ct < 4; ++ct)
#pragma unroll
            for (int qd = 0; qd < 4; ++qd) { const int c0 = g * 128 + ct * 32 + 8 * qd + 4 * h;
                const u32x2 zu = *(const GAS u32x2*)(F.ZU + (R0 + t) * DSGU + c0);
                const float u0 = bflo(zu.x), u1 = bfhi(zu.x), u2 = bflo(zu.y), u3 = bfhi(zu.y);
                float v0 = (acc[gi * 4 + ct][4 * qd + 0] + bias) * u0, v1 = (acc[gi * 4 + ct][4 * qd + 1] + bias) * u1, v2 = (acc[gi * 4 + ct][4 * qd + 2] + bias) * u2, v3 = (acc[gi * 4 + ct][4 * qd + 3] + bias) * u3;
                acc[gi * 4 + ct][4 * qd + 0] = v0; acc[gi * 4 + ct][4 * qd + 1] = v1; acc[gi * 4 + ct][4 * qd + 2] = v2; acc[gi * 4 + ct][4 * qd + 3] = v3;
                ssq += (v0 * v0 + v1 * v1) + (v2 * v2 + v3 * v3); } }
    ssq += __shfl_xor(ssq, 32);
    if (h == 0) rpart[ch * 128 + t] = ssq;
    __syncthreads();
    const float rstd = rsqrtf((rpart[t] + rpart[128 + t]) * (1.f / 512.f) + EPS);
#pragma unroll
    for (int gi = 0; gi < 2; ++gi) { const int g = 2 * ch + gi;
#pragma unroll
        for (int ct = 0; ct < 4; ++ct)
#pragma unroll
            for (int qd = 0; qd < 4; ++qd) { const int c0 = g * 128 + ct * 32 + 8 * qd + 4 * h;
                const f32x4 go = *(const f32x4*)(F.g_out_sgu + c0);
                u32x2 o; o.x = pkbf(acc[gi * 4 + ct][4 * qd + 0] * rstd * go.x, acc[gi * 4 + ct][4 * qd + 1] * rstd * go.y);
                o.y = pkbf(acc[gi * 4 + ct][4 * qd + 2] * rstd * go.z, acc[gi * 4 + ct][4 * qd + 3] * rstd * go.w);
                *(GAS u32x2*)(F.MERGED + (R0 + t) * D + c0) = o; } }
    __syncthreads();
}
__device__ __forceinline__ unsigned okey(unsigned x) { return (x & 0x8000u) ? (x ^ 0xffffu) : (x | 0x8000u); }
__device__ __forceinline__ unsigned wave_incl_scan(unsigned v) {
    v += (unsigned)__builtin_amdgcn_update_dpp(0, (int)v, 0x111, 0xf, 0xf, false);
    v += (unsigned)__builtin_amdgcn_update_dpp(0, (int)v, 0x112, 0xf, 0xf, false);
    v += (unsigned)__builtin_amdgcn_update_dpp(0, (int)v, 0x114, 0xf, 0xf, false);
    v += (unsigned)__builtin_amdgcn_update_dpp(0, (int)v, 0x118, 0xf, 0xf, false);
    v += (unsigned)__builtin_amdgcn_update_dpp(0, (int)v, 0x142, 0xa, 0xf, false);
    v += (unsigned)__builtin_amdgcn_update_dpp(0, (int)v, 0x143, 0xc, 0xf, false);
    return v;
}
__device__ __forceinline__ void radix_scan(const v4u c, unsigned kk, int lane, unsigned& bin_out, unsigned& rem_out) {
    const unsigned T = c.x + c.y + c.z + c.w; const unsigned S = wave_incl_scan(T);
    const unsigned above = S - T; const bool found = (S >= kk) && (above < kk);
    unsigned bin, rem, cum = above;
    if (cum + c.x >= kk) { bin = 0; rem = kk - cum; } else { cum += c.x;
        if (cum + c.y >= kk) { bin = 1; rem = kk - cum; } else { cum += c.y;
            if (cum + c.z >= kk) { bin = 2; rem = kk - cum; } else { cum += c.z; bin = 3; rem = kk - cum; } } }
    bin += 4 * lane;
    const unsigned long long bm = __ballot(found); const int src = bm ? (__ffsll((long long)bm) - 1) : 0;
    bin_out = (unsigned)__builtin_amdgcn_readlane((int)bin, src); rem_out = (unsigned)__builtin_amdgcn_readlane((int)rem, src);
}
constexpr int LDS_SCSTG = 131072;
constexpr int LDS_MASK = 32768, LDS_KVR = 65536, KV_NS = 5, KV_PD = 3;
#define DMA16(gsrc, ldst) __builtin_amdgcn_global_load_lds((const unsigned*)(gsrc), (LAS unsigned*)(ldst), 16, 0, 0)
#define WAIT_VM(n) asm volatile("s_waitcnt vmcnt(" #n ")" ::: "memory")
#define WG_BAR() do { __builtin_amdgcn_s_barrier(); asm volatile("" ::: "memory"); } while (0)
__device__ __forceinline__ void dsa_unit(Frame& F, int b, int qb) {
    const int w = F.wave;
    bf16* SC = (bf16*)(F.scr + SCR_SC); bf16* YB = (bf16*)(F.scr + SCR_YB);
    const int g = w & 3, kh = w >> 2;
    const int t0 = 128 * qb + 32 * g;
    const int ntile = 4 * qb + g + 1;
    LAS unsigned* maskl = (LAS unsigned*)(F.lds + LDS_MASK);
#define LANE_HERE() int lane = LANE(); asm volatile("" : "+v"(lane)); const int q = lane & 31, h = lane >> 5; const size_t rowq = (size_t)b * SEQ + t0 + q; (void)h; (void)rowq
#ifndef NO_PASSA
    for (int rp = 0; rp < F.repA; ++rp)
    if (qb >= 2) { LANE_HERE();
        for (int rq = 0; rq < F.repE; ++rq)
#pragma unroll 4
        for (int i = 0; i < 16; ++i) { const int idx = i * 512 + 64 * w + lane, row = idx >> 6, c = idx & 63;
            const v4u v = *(const GAS v4u*)(F.QI + ((size_t)b * SEQ + 128 * qb + row) * 512 + c * 8);
            *(LAS v4u*)(F.lds + row * 1024 + ((c ^ (row & 15)) << 4)) = v; }
        const int qrow = 32 * g + q; const int lx = h ^ (qrow & 15);
        unsigned offs[8];
#pragma unroll
        for (int c8 = 0; c8 < 8; ++c8) offs[c8] = (unsigned)(qrow * 1024 + (((2 * c8) ^ lx) << 4));
        const f32x4 w0 = *(const f32x4*)(F.WI + rowq * 8), w1 = *(const f32x4*)(F.WI + rowq * 8 + 4);
        const float wv[8] = {w0.x, w0.y, w0.z, w0.w, w1.x, w1.y, w1.z, w1.w};
        const bf16* kbase = F.KI + ((size_t)b * SEQ + q) * 64 + 8 * h;
        asm volatile("s_waitcnt vmcnt(0) lgkmcnt(0)" ::: "memory"); __syncthreads();
        bf16x8 kf[4], kf1[4];
#pragma unroll
        for (int kk = 0; kk < 4; ++kk) kf[kk] = *(const GAS bf16x8*)(kbase + (size_t)(32 * kh) * 64 + kk * 16);
#pragma unroll 1
        for (int j = kh; j < ntile; j += 2) {
            asm volatile("" ::: "memory");
            {
#pragma unroll
                for (int kk = 0; kk < 4; ++kk) kf1[kk] = *(const GAS bf16x8*)(kbase + (size_t)(32 * (j + 2)) * 64 + kk * 16);
                f32x16 sc, dp, dc;
#pragma unroll
                for (int r = 0; r < 16; ++r) { sc[r] = 0.f; dp[r] = 0.f; }
                bf16x8 qc_[4], qn_[4];
#pragma unroll
                for (int kk = 0; kk < 4; ++kk) qc_[kk] = *(const LAS bf16x8*)(F.lds + offs[kk]);
#pragma unroll
                for (int hd = 0; hd < 8; ++hd) {
                    if (hd < 7) {
#pragma unroll
                        for (int kk = 0; kk < 4; ++kk) qn_[kk] = *(const LAS bf16x8*)(F.lds + offs[((hd + 1) & 1) * 4 + kk] + 256 * ((hd + 1) >> 1)); }
#pragma unroll
                    for (int r = 0; r < 16; ++r) dc[r] = 0.f;
#pragma unroll
                    for (int kk = 0; kk < 4; ++kk) dc = MFMA32(kf[kk], qc_[kk], dc);
                    if (hd > 0) {
#pragma unroll
                        for (int r = 0; r < 16; ++r) { const float dv = dp[r]; const int di = __float_as_int(dv); const float rl = __int_as_float(di & ~(di >> 31)); sc[r] = __builtin_fmaf(wv[hd - 1], rl, sc[r]); } }
                    dp = dc;
#pragma unroll
                    for (int kk = 0; kk < 4; ++kk) qc_[kk] = qn_[kk];
                }
#pragma unroll
                for (int r = 0; r < 16; ++r) { const float dv = dp[r]; const int di = __float_as_int(dv); const float rl = __int_as_float(di & ~(di >> 31)); sc[r] = __builtin_fmaf(wv[7], rl, sc[r]); }
#pragma unroll
                for (int it = 0; it < 32; ++it) { __builtin_amdgcn_sched_group_barrier(0x008, 1, 0); __builtin_amdgcn_sched_group_barrier(0x100, 1, 0); __builtin_amdgcn_sched_group_barrier(0x002, 8, 0); }
                if (j >= 4 * qb) {
                    const int dl = t0 + q - 32 * j - 4 * h;
#pragma unroll
                    for (int r = 0; r < 16; ++r) sc[r] = ((r & 3) + 8 * (r >> 2) <= dl) ? sc[r] : -INFINITY;
                }
                {   LAS unsigned char* stg = F.lds + LDS_SCSTG + w * 2560;
#pragma unroll
                    for (int qd = 0; qd < 4; ++qd) { u32x2 o;
                        o.x = __builtin_bit_cast(unsigned, __builtin_amdgcn_cvt_pkrtz(sc[4 * qd + 0], sc[4 * qd + 1]));
                        o.y = __builtin_bit_cast(unsigned, __builtin_amdgcn_cvt_pkrtz(sc[4 * qd + 2], sc[4 * qd + 3]));
                        *(LAS u32x2*)(stg + q * 80 + 16 * qd + 8 * h) = o; }
                    asm volatile("s_waitcnt lgkmcnt(0)" ::: "memory");
                    const int rr = lane >> 2, cc = lane & 3;
                    const v4u v0 = *(const LAS v4u*)(stg + rr * 80 + 16 * cc), v1 = *(const LAS v4u*)(stg + (rr + 16) * 80 + 16 * cc);
                    *(GAS v4u*)(SC + (size_t)(32 * g + rr) * 2048 + 32 * j + 8 * cc) = v0;
                    *(GAS v4u*)(SC + (size_t)(32 * g + rr + 16) * 2048 + 32 * j + 8 * cc) = v1;
                    asm volatile("s_waitcnt lgkmcnt(0)" ::: "memory");
                }
#pragma unroll
                for (int kk = 0; kk < 4; ++kk) kf[kk] = kf1[kk];
            }
        }
    }
#endif
    block_sync_mem(F.wave == 0);
#ifndef NO_PASSB
    for (int rp = 0; rp < F.repB; ++rp)
    { LANE_HERE();
        v4u nxt[4];
        if (qb >= 2) { const GAS v4u* rp_ = (const GAS v4u*)(SC + (size_t)(16 * w) * 2048 + 32 * lane);
#pragma unroll
            for (int k = 0; k < 4; ++k) nxt[k] = rp_[k]; }
#pragma unroll 1
        for (int i = 0; i < 16; ++i) { const int ql = 16 * w + i; const int t = 128 * qb + ql;
            const int lo = 32 * lane;
            const unsigned causal = (t >= lo + 31) ? 0xffffffffu : (t < lo ? 0u : ((2u << (t - lo)) - 1u));
            unsigned word = causal;
            if (qb >= 2) {
                v4u cur[4];
#pragma unroll
                for (int k = 0; k < 4; ++k) cur[k] = nxt[k];
                if (i + 1 < 16) { const GAS v4u* rp_ = (const GAS v4u*)(SC + (size_t)(ql + 1) * 2048 + 32 * lane);
#pragma unroll
                    for (int k = 0; k < 4; ++k) nxt[k] = rp_[k]; }
                const unsigned vmask = (lane <= 4 * qb + (ql >> 5)) ? 0xffffffffu : 0u;
                unsigned W[16];
#pragma unroll
                for (int k = 0; k < 4; ++k)
#pragma unroll
                    for (int c = 0; c < 4; ++c) { const unsigned x = cur[k][c]; const unsigned sgn = (x >> 15) & 0x00010001u; W[4 * k + c] = ~(x ^ ((sgn * 0x7fffu) | 0x80008000u)); }
#define BT_STAGE(J, M) _Pragma("unroll") for (int k = 0; k < 16; ++k) if (!(k & (J))) { const unsigned A = W[k], Bv = W[k + (J)]; \
                    W[k] = ((Bv << (J)) & ((M) << (J))) | (A & ~((M) << (J))); W[k + (J)] = ((A >> (J)) & (M)) | (Bv & ~(M)); }
                BT_STAGE(8, 0x00ff00ffu) BT_STAGE(4, 0x0f0f0f0fu) BT_STAGE(2, 0x33333333u) BT_STAGE(1, 0x55555555u)
#undef BT_STAGE
                unsigned C = vmask, S = 0u, csel = 0u;
#pragma unroll
                for (int bit = 15; bit >= 0; --bit) { const unsigned zeros = C & ~W[bit];
                    const unsigned z = (unsigned)__builtin_amdgcn_readlane((int)wave_incl_scan((unsigned)__builtin_popcount(zeros)), 63);
                    const bool take0 = (csel + z >= 256u);
                    csel = take0 ? csel : csel + z;
                    S = take0 ? S : (S | zeros);
                    C = take0 ? zeros : (C & W[bit]); }
                S |= C;
                unsigned e = S & 0xffffu, o = S >> 16;
                e = (e | (e << 8)) & 0x00ff00ffu; e = (e | (e << 4)) & 0x0f0f0f0fu; e = (e | (e << 2)) & 0x33333333u; e = (e | (e << 1)) & 0x55555555u;
                o = (o | (o << 8)) & 0x00ff00ffu; o = (o | (o << 4)) & 0x0f0f0f0fu; o = (o | (o << 2)) & 0x33333333u; o = (o | (o << 1)) & 0x55555555u;
                word = (e | (o << 1)) & causal;
            }
            maskl[ql * 64 + lane] = word;
#ifdef DIAG
            ((unsigned*)(F.scr + SCR_MK))[ql * 64 + lane] = word;
#endif
        }
    }
    for (int rp = 0; rp < F.repD; ++rp) if (qb >= 2) { LANE_HERE(); unsigned acc = 0u;
#pragma unroll 1
        for (int i = 0; i < 16; ++i) { const GAS v4u* rp_ = (const GAS v4u*)(SC + (size_t)(16 * w + i) * 2048 + 32 * lane);
#pragma unroll
            for (int k = 0; k < 4; ++k) { const v4u v = rp_[k]; acc ^= v.x ^ v.y ^ v.z ^ v.w; } asm volatile("s_waitcnt vmcnt(0)" ::: "memory"); }
        if (acc == 0x12345678u) ((unsigned*)(F.scr + SCR_MK))[lane] = acc; }
#endif
#ifndef NO_PASSC
    for (int rp = 0; rp < F.repC; ++rp)
    { LANE_HERE();
        const int kr_ = 8 * g + (lane >> 3), kc_ = (lane & 7) ^ ((kr_ >> 1) & 7);
        const bf16* ksrc = F.K + ((size_t)b * SEQ + kr_) * 128 + kh * 64 + kc_ * 8;
        const int vd_ = 16 * g + (lane >> 2), vu_ = (lane & 3) ^ ((vd_ >> 2) & 3);
        const bf16* vsrc = F.VT + ((size_t)(b * 2 + kh) * 64 + vd_) * 2048 + vu_ * 8;
        const int kdst = LDS_KVR + kh * 4096 + g * 1024, vdst = LDS_KVR + 8192 + kh * 4096 + g * 1024;
        unsigned koff[4], voff[4];
#pragma unroll
        for (int kk = 0; kk < 4; ++kk) koff[kk] = (unsigned)(LDS_KVR + kh * 4096 + q * 128 + (((2 * kk + h) ^ ((q >> 1) & 7)) << 4));
#pragma unroll
        for (int u = 0; u < 4; ++u) voff[u] = (unsigned)(LDS_KVR + 8192 + kh * 4096 + q * 64 + ((u ^ ((q >> 2) & 3)) << 4) + 8 * h);
        const float kn2 = __builtin_bit_cast(float, __hip_atomic_load(F.ctl + CW_KN + (b * 2 + kh) * 2, __ATOMIC_RELAXED, __HIP_MEMORY_SCOPE_AGENT)) + __builtin_bit_cast(float, __hip_atomic_load(F.ctl + CW_KN + (b * 2 + kh) * 2 + 1, __ATOMIC_RELAXED, __HIP_MEMORY_SCOPE_AGENT));
        const float kmax = __builtin_sqrtf(kn2) * 1.01f;
        const int NT = 4 * (qb + 1);
#pragma unroll 1
        for (int hp = 0; hp < 2; ++hp) {
            const int hA = 4 * kh + 2 * hp;
            bf16x8 qa[4], qc[4]; float qn0 = 0.f, qn1 = 0.f;
#pragma unroll
            for (int kk = 0; kk < 4; ++kk) { qa[kk] = *(const GAS bf16x8*)(F.Q + rowq * 512 + hA * 64 + kk * 16 + 8 * h); qc[kk] = *(const GAS bf16x8*)(F.Q + rowq * 512 + (hA + 1) * 64 + kk * 16 + 8 * h);
#pragma unroll
                for (int e = 0; e < 8; ++e) { const float a = __builtin_bit_cast(float, (unsigned)(unsigned short)qa[kk][e] << 16), c = __builtin_bit_cast(float, (unsigned)(unsigned short)qc[kk][e] << 16); qn0 += a * a; qn1 += c * c; } }
            qn0 += __shfl_xor(qn0, 32); qn1 += __shfl_xor(qn1, 32);
            const float mb = fminf(__builtin_sqrtf(fmaxf(qn0, qn1)) * kmax, 64.0f);
            const unsigned negmb = __float_as_uint(-mb);
            f32x16 oA0, oA1, oB0, oB1;
#pragma unroll
            for (int r = 0; r < 16; ++r) { oA0[r] = 0.f; oA1[r] = 0.f; oB0[r] = 0.f; oB1[r] = 0.f; }
            float lA = 0.f, lB = 0.f;
            asm volatile("s_waitcnt vmcnt(0) lgkmcnt(0)" ::: "memory"); __syncthreads();
            f32x16 sA, sB;
#define PHASE_A(J, SLOT) do { \
                const int mwh = (int)(maskl[(32 * g + q) * 64 + (J)] >> (4 * h)); f32x16 ci; \
                _Pragma("unroll") for (int r = 0; r < 16; ++r) { const int mr = __builtin_amdgcn_sbfe(mwh, (r & 3) + 8 * (r >> 2), 1); ci[r] = __uint_as_float(((unsigned)mr & negmb) | (~(unsigned)mr & 0xff800000u)); } \
                bf16x8 kf[4]; \
                _Pragma("unroll") for (int kk = 0; kk < 4; ++kk) kf[kk] = *(const LAS bf16x8*)(F.lds + koff[kk] + (SLOT)); \
                sA = MFMA32(kf[0], qa[0], ci); sB = MFMA32(kf[0], qc[0], ci); \
                _Pragma("unroll") for (int kk = 1; kk < 4; ++kk) { sA = MFMA32(kf[kk], qa[kk], sA); sB = MFMA32(kf[kk], qc[kk], sB); } } while (0)
#define PHASE_B(SLOT) do { \
                bf16x8 vt[2][2]; \
                _Pragma("unroll") for (int dt = 0; dt < 2; ++dt) _Pragma("unroll") for (int sp = 0; sp < 2; ++sp) { \
                    const u32x2 lo = *(const LAS u32x2*)(F.lds + voff[2 * sp] + dt * 2048 + (SLOT)), hi = *(const LAS u32x2*)(F.lds + voff[2 * sp + 1] + dt * 2048 + (SLOT)); \
                    vt[dt][sp] = __builtin_bit_cast(bf16x8, ((v4u){lo.x, lo.y, hi.x, hi.y})); } \
                float l0 = 0.f, l1 = 0.f; \
                _Pragma("unroll") for (int r = 0; r < 16; r += 2) { sA[r] = __builtin_amdgcn_exp2f(sA[r]); sA[r + 1] = __builtin_amdgcn_exp2f(sA[r + 1]); l0 += sA[r]; l1 += sA[r + 1]; } \
                lA += l0 + l1; l0 = 0.f; l1 = 0.f; \
                _Pragma("unroll") for (int r = 0; r < 16; r += 2) { sB[r] = __builtin_amdgcn_exp2f(sB[r]); sB[r + 1] = __builtin_amdgcn_exp2f(sB[r + 1]); l0 += sB[r]; l1 += sB[r + 1]; } \
                lB += l0 + l1; \
                v4u pk; pk.x = pkbf(sA[0], sA[1]); pk.y = pkbf(sA[2], sA[3]); pk.z = pkbf(sA[4], sA[5]); pk.w = pkbf(sA[6], sA[7]); const bf16x8 pA0 = __builtin_bit_cast(bf16x8, pk); \
                pk.x = pkbf(sA[8], sA[9]); pk.y = pkbf(sA[10], sA[11]); pk.z = pkbf(sA[12], sA[13]); pk.w = pkbf(sA[14], sA[15]); const bf16x8 pA1 = __builtin_bit_cast(bf16x8, pk); \
                pk.x = pkbf(sB[0], sB[1]); pk.y = pkbf(sB[2], sB[3]); pk.z = pkbf(sB[4], sB[5]); pk.w = pkbf(sB[6], sB[7]); const bf16x8 pB0 = __builtin_bit_cast(bf16x8, pk); \
                pk.x = pkbf(sB[8], sB[9]); pk.y = pkbf(sB[10], sB[11]); pk.z = pkbf(sB[12], sB[13]); pk.w = pkbf(sB[14], sB[15]); const bf16x8 pB1 = __builtin_bit_cast(bf16x8, pk); \
                oA0 = MFMA32(vt[0][0], pA0, oA0); oA0 = MFMA32(vt[0][1], pA1, oA0); oA1 = MFMA32(vt[1][0], pA0, oA1); oA1 = MFMA32(vt[1][1], pA1, oA1); \
                oB0 = MFMA32(vt[0][0], pB0, oB0); oB0 = MFMA32(vt[0][1], pB1, oB0); oB1 = MFMA32(vt[1][0], pB0, oB1); oB1 = MFMA32(vt[1][1], pB1, oB1); } while (0)
#pragma unroll
            for (int p = 0; p < KV_PD; ++p) { DMA16(ksrc + (size_t)p * 32 * 128, F.lds + kdst + p * 16384); DMA16(vsrc + p * 32, F.lds + vdst + p * 16384); }
            if (kh == 1) WG_BAR();
#pragma unroll 1
            for (int j = 0; j < NT; ++j) {
                const int slot = (j % KV_NS) * 16384;
                if (j + KV_PD < NT) { const int ns = ((j + KV_PD) % KV_NS) * 16384; DMA16(ksrc + (size_t)(j + KV_PD) * 32 * 128, F.lds + kdst + ns); DMA16(vsrc + (j + KV_PD) * 32, F.lds + vdst + ns); WAIT_VM(4); }
                else { const int rem = NT - 1 - j; if (rem >= 2) { WAIT_VM(2); } else { WAIT_VM(0); } }
                WG_BAR();
                if (j < ntile) PHASE_A(j, slot);
                WG_BAR();
                if (j < ntile) PHASE_B(slot);
            }
            if (kh == 0) WG_BAR();
#undef PHASE_A
#undef PHASE_B
            lA += __shfl_xor(lA, 32); lB += __shfl_xor(lB, 32);
            const float iA = 1.0f / lA, iB = 1.0f / lB;
            bf16* yrow = YB + (size_t)(32 * g + q) * 512 + hA * 64 + 4 * h;
#pragma unroll
            for (int qd = 0; qd < 4; ++qd) { u32x2 o;
                o.x = pkbf(oA0[4 * qd] * iA, oA0[4 * qd + 1] * iA); o.y = pkbf(oA0[4 * qd + 2] * iA, oA0[4 * qd + 3] * iA); *(GAS u32x2*)(yrow + 8 * qd) = o;
                o.x = pkbf(oA1[4 * qd] * iA, oA1[4 * qd + 1] * iA); o.y = pkbf(oA1[4 * qd + 2] * iA, oA1[4 * qd + 3] * iA); *(GAS u32x2*)(yrow + 32 + 8 * qd) = o;
                o.x = pkbf(oB0[4 * qd] * iB, oB0[4 * qd + 1] * iB); o.y = pkbf(oB0[4 * qd + 2] * iB, oB0[4 * qd + 3] * iB); *(GAS u32x2*)(yrow + 64 + 8 * qd) = o;
                o.x = pkbf(oB1[4 * qd] * iB, oB1[4 * qd + 1] * iB); o.y = pkbf(oB1[4 * qd + 2] * iB, oB1[4 * qd + 3] * iB); *(GAS u32x2*)(yrow + 96 + 8 * qd) = o; }
        }
    }
#endif
    block_sync_mem(F.wave == 0);
    { LANE_HERE();
        const f32x4 go0 = *(const f32x4*)(F.g_out_attn + 8 * lane), go1 = *(const f32x4*)(F.g_out_attn + 8 * lane + 4);
#pragma unroll 2
        for (int i = 0; i < 16; ++i) { const int ql = 16 * w + i; const size_t row = (size_t)b * SEQ + 128 * qb + ql;
            const v4u raw = *(const GAS v4u*)(YB + (size_t)ql * 512 + 8 * lane);
            f32x4 a = {bflo(raw.x), bfhi(raw.x), bflo(raw.y), bfhi(raw.y)}, c = {bflo(raw.z), bfhi(raw.z), bflo(raw.w), bfhi(raw.w)};
            const float ss = wave_sum((a.x * a.x + a.y * a.y) + (a.z * a.z + a.w * a.w) + (c.x * c.x + c.y * c.y) + (c.z * c.z + c.w * c.w));
            const float rstd = rsqrtf(ss * (1.f / 512.f) + EPS);
            a = a * rstd * go0; c = c * rstd * go1;
            v4u o; o.x = pkbf(a.x, a.y); o.y = pkbf(a.z, a.w); o.z = pkbf(c.x, c.y); o.w = pkbf(c.z, c.w);
            *(GAS v4u*)(F.MERGED + row * D + 512 + 8 * lane) = o; }
    }
    block_sync_mem(F.wave == 0);
}
#undef DMA16
#undef WAIT_VM
#undef WG_BAR
#undef LANE_HERE

struct Args { const void* in[18]; float* out; unsigned char* ws; int ph_lo, ph_hi; int rep[8]; };
__global__ void __launch_bounds__(NWAVES * 64, 2) fwd_kernel(Args args) {
    extern __shared__ __attribute__((aligned(16))) unsigned char lds[];
    Frame F;
    F.lds = (LAS unsigned char*)lds;
    F.MISC = (volatile LAS unsigned*)(F.lds + MISC_OFF);
    F.wave = __builtin_amdgcn_readfirstlane((int)threadIdx.x >> 6);
    F.G = gridDim.x; { const int bx = blockIdx.x; F.vcu = (F.G % 8 == 0) ? (bx % 8) * (F.G / 8) + bx / 8 : bx; }
    unsigned char* ws = args.ws;
    F.ctl = (gu32*)(ws + WS_CTL);
    F.x = (const float*)args.in[0]; F.c = (const float*)args.in[1]; F.pos = (const int*)args.in[2]; F.w_ada = (const float*)args.in[3]; F.b_ada = (const float*)args.in[4];
    F.g_pre_mix = (const float*)args.in[5]; F.w_in = (const float*)args.in[6]; F.g_sgu_v = (const float*)args.in[7]; F.w_spatial = (const float*)args.in[8]; F.b_spatial = (const float*)args.in[9];
    F.g_out_sgu = (const float*)args.in[10]; F.g_out_attn = (const float*)args.in[11]; F.w_out = (const float*)args.in[12]; F.g_post_mix = (const float*)args.in[13]; F.g_pre_ffn = (const float*)args.in[14];
    F.w_ff1 = (const float*)args.in[15]; F.w_ff2 = (const float*)args.in[16]; F.g_post_ffn = (const float*)args.in[17];
    F.out = args.out; F.repA = args.rep[0]; F.repB = args.rep[1]; F.repC = args.rep[2]; F.repD = args.rep[3]; F.repE = args.rep[4]; F.repF = args.rep[5]; F.repG = args.rep[6]; F.repH = args.rep[7];
    F.MOD = (float*)(ws + WS_MOD); F.COS = (float*)(ws + WS_COS); F.SIN = (float*)(ws + WS_SIN); F.PART = (float*)(ws + WS_PART); F.WI = (float*)(ws + WS_WI);
    F.WM = (bf16*)(ws + WS_WM); F.WIN = (bf16*)(ws + WS_WIN); F.WOUT = (bf16*)(ws + WS_WOUT); F.W1 = (bf16*)(ws + WS_W1); F.W2 = (bf16*)(ws + WS_W2);
    F.H = (bf16*)(ws + WS_H); F.ZU = (bf16*)(ws + WS_ZU); F.ZV = (bf16*)(ws + WS_ZV); F.Q = (bf16*)(ws + WS_Q); F.K = (bf16*)(ws + WS_K); F.VT = (bf16*)(ws + WS_VT);
    F.QI = (bf16*)(ws + WS_QI); F.KI = (bf16*)(ws + WS_KI); F.MERGED = (bf16*)(ws + WS_MERGED); F.O = (bf16*)(ws + WS_O); F.HB = (bf16*)(ws + WS_HB); F.FB = (bf16*)(ws + WS_F);
    F.scr = ws + WS_SCR + (size_t)blockIdx.x * SCR_PER_WG;
    for (int u = TID(F); u < (LDS_BYTES - LDSCTL_OFF) / 4; u += NWAVES * 64) ((LAS unsigned*)(F.lds + LDSCTL_OFF))[u] = 0u;
    __syncthreads();
    const int lo = args.ph_lo, hi = args.ph_hi;
    const bool fusedrun = (hi - lo) > 1;
    XcdBarrier bar; bar.wave = F.wave; bar.bar = (unsigned*)(F.ctl + CW_BAR); bar.x = 0; bar.st = nullptr;
    if (fusedrun) bar = xcd_barrier_post((unsigned*)(F.ctl + CW_BAR), F.MISC + 8, F.wave);
#define IN(k) (lo <= (k) && (k) < hi)
#ifdef PROBE_DUP
#define NREP(k) (((k) == PROBE_DUP) ? 2 : 1)
#else
#define NREP(k) 1
#endif
#ifdef ONLY_PHASE
#define PHASE_ON(k) ((k) == ONLY_PHASE)
#else
#define PHASE_ON(k) true
#endif
#define SEAM(k) do { if (IN(k) && IN((k) + 1)) xcd_barrier(bar); } while (0)

    if (PHASE_ON(0) && IN(0)) { p0_prologue(F); SEAM(0); }
    if (PHASE_ON(1) && IN(1)) { p1_hprep(F); SEAM(1); }
    if (PHASE_ON(2) && IN(2)) {
        pg8::Gemm g{F.H, F.WIN, M, DINP, D}; pg8::StaticOrder S; S.init(M, DINP, F.G, (int)blockIdx.x);
        pg8::EpiProj E{F.ZU, F.ZV, F.Q, F.K, F.VT, F.QI, F.KI, F.WI, F.COS, F.SIN, (unsigned*)(F.ctl + CW_KN)};
        pg8::gemm_phase<pg8::EpiProj, pg8::StaticOrder, PG8_ALIGN, PG8_SP2>(F.lds + RING_OFF, g, S, E, F.wave);
        SEAM(2);
    }
    if (PHASE_ON(3) && IN(3)) {
        for (int u = F.vcu; u < BATCH * 16; u += F.G) sgu_unit(F, u >> 4, u & 15);
    }
    if (PHASE_ON(4) && IN(4)) {
        for (int u = F.vcu; u < BATCH * 8; u += F.G) { const int b = u >> 3, p = u & 7;
#pragma unroll 1
            for (int k = 0; k < 2; ++k) dsa_unit(F, b, k ? p : 15 - p); }
        SEAM(4);
    }
    if (PHASE_ON(5) && IN(5)) {
        pg8::Gemm g{F.MERGED, F.WOUT, M, D, D}; pg8::StaticOrder S; S.init(M, D, F.G, (int)blockIdx.x);
        pg8::EpiNormPart E{F.O, D, F.PART};
        pg8::gemm_phase<pg8::EpiNormPart, pg8::StaticOrder, PG8_ALIGN, PG8_SP2>(F.lds + RING_OFF, g, S, E, F.wave);
        SEAM(5);
    }
    if (PHASE_ON(6) && IN(6)) { p5_postmix(F); SEAM(6); }
    if (PHASE_ON(7) && IN(7)) {
        pg8::Gemm g{F.H, F.W1, M, FF, D}; pg8::StaticOrder S; S.init(M, FF, F.G, (int)blockIdx.x);
        pg8::EpiRelu2 E{F.HB, FF};
        pg8::gemm_phase<pg8::EpiRelu2, pg8::StaticOrder, PG8_ALIGN, PG8_SP2>(F.lds + RING_OFF, g, S, E, F.wave);
        SEAM(7);
    }
    if (PHASE_ON(8) && IN(8)) {
        pg8::Gemm g{F.HB, F.W2, M, D, FF}; pg8::StaticOrder S; S.init(M, D, F.G, (int)blockIdx.x);
        pg8::EpiNormPart E{F.FB, D, F.PART};
        pg8::gemm_phase<pg8::EpiNormPart, pg8::StaticOrder, PG8_ALIGN, PG8_SP2>(F.lds + RING_OFF, g, S, E, F.wave);
        SEAM(8);
    }
    if (PHASE_ON(9) && IN(9)) { p8_final(F);
#ifdef DIAG
        {
            asm volatile("s_waitcnt vmcnt(0)" ::: "memory"); __syncthreads();
            float code = 0.f;
#pragma unroll
            for (int k = 0; k < 4; ++k) { const float e = __builtin_bit_cast(float, __hip_atomic_load(F.ctl + 8192 + DIAG_SET * 4 + k, __ATOMIC_RELAXED, __HIP_MEMORY_SCOPE_AGENT)); if (e > DIAG_TOL) code += 0.25f * (float)(1 << k); }
            const int gw = F.vcu * NWAVES + F.wave, NGW = F.G * NWAVES;
            for (int chunk = gw; chunk < M / 32; chunk += NGW) for (int r = 0; r < 32; ++r) { GAS f32x4* outr = (GAS f32x4*)(F.out + ((size_t)chunk * 32 + r) * D) + LANE();
#pragma unroll
                for (int j = 0; j < 4; ++j) outr[64 * j] = outr[64 * j] * (1.0f + code); }
        }
#endif
    }
#undef IN
#undef SEAM
}


#ifdef DIAG
constexpr int CW_DIAG = 8192;
__device__ __forceinline__ void diag_max(gu32* ctl, int k, float err) { if (!(err == err)) err = 1e30f; atomicMax((unsigned*)(ctl + CW_DIAG + k), __builtin_bit_cast(unsigned, err)); }
__device__ __forceinline__ float relerr(float got, float want, float floor_) { return __builtin_fabsf(got - want) / (__builtin_fabsf(want) + floor_); }
__device__ __forceinline__ float bf2f(bf16 v) { return __builtin_bit_cast(float, (unsigned)v << 16); }
__device__ __forceinline__ float h2f(unsigned short v) { return (float)__builtin_bit_cast(_Float16, v); }
__device__ __forceinline__ float wave_max(float v) {
#pragma unroll
    for (int o = 1; o < 64; o <<= 1) v = fmaxf(v, __shfl_xor(v, o));
    return v;
}
__device__ __forceinline__ float gelu_ref(float p) { return p / (1.0f + __expf(-1.5957691216057308f * (p + 0.044715f * p * p * p))); }
__global__ void __launch_bounds__(512) diag_kernel(Args args) {
    __shared__ float pr[8][2400];
    unsigned char* ws = args.ws; gu32* ctl = (gu32*)(ws + WS_CTL);
    const float* x = (const float*)args.in[0]; const float* cc_ = (const float*)args.in[1]; const float* w_ada = (const float*)args.in[3]; const float* b_ada = (const float*)args.in[4];
    const float* g_pre_mix = (const float*)args.in[5]; const float* g_sgu_v = (const float*)args.in[7]; const float* b_spatial = (const float*)args.in[9]; const float* g_out_sgu = (const float*)args.in[10];
    const float* MOD = (const float*)(ws + WS_MOD); const float* COS = (const float*)(ws + WS_COS); const float* SIN = (const float*)(ws + WS_SIN); const float* WI = (const float*)(ws + WS_WI);
    const bf16 *WM = (const bf16*)(ws + WS_WM), *WIN = (const bf16*)(ws + WS_WIN), *H = (const bf16*)(ws + WS_H), *ZU = (const bf16*)(ws + WS_ZU), *ZV = (const bf16*)(ws + WS_ZV), *Q = (const bf16*)(ws + WS_Q), *K = (const bf16*)(ws + WS_K),
               *VT = (const bf16*)(ws + WS_VT), *QI = (const bf16*)(ws + WS_QI), *KI = (const bf16*)(ws + WS_KI), *MERGED = (const bf16*)(ws + WS_MERGED);
    const int tid = threadIdx.x, lane = tid & 63, w = tid >> 6, G = gridDim.x; const int bx = blockIdx.x, vcu = (G % 8 == 0) ? (bx % 8) * (G / 8) + bx / 8 : bx; const int gw = vcu * 8 + w;
    {
        const size_t m = ((size_t)gw * 97 + 13) % M; const size_t b = m >> 11, s = m & 2047;
#pragma unroll 1
        for (int i = 0; i < 38; ++i) { const int col = lane + 64 * i; float acc = 0.f;
            if (col < DIN) {
#pragma unroll 4
                for (int k = 0; k < D; ++k) acc += bf2f(H[m * D + k]) * bf2f(WIN[(size_t)col * D + k]);
                pr[w][col] = acc; } }
        __syncthreads();
#pragma unroll 1
        for (int i = 0; i < 38; ++i) { const int col = lane + 64 * i; if (col >= DIN) break;
            const float p = pr[w][col];
            if (col < 1024) { const float got = bf2f(col < 512 ? ZU[m * 512 + col] : ZV[m * 512 + col - 512]); diag_max(ctl, 4, relerr(got, gelu_ref(p), 0.05f)); }
            else if (col < 1664) { const bool isq = col < 1536; const int cc = isq ? col - 1024 : col - 1536; const int d = cc & 63; float v = p;
                if (d < 8) v = p * COS[m * 8 + d] - pr[w][col + 8] * SIN[m * 8 + d]; else if (d < 16) v = p * COS[m * 8 + d - 8] + pr[w][col - 8] * SIN[m * 8 + d - 8];
                if (isq) v *= 0.18033688011112042f;
                const float got = bf2f(isq ? Q[m * 512 + cc] : K[m * 128 + cc]); diag_max(ctl, 5, relerr(got, v, 0.05f)); }
            else if (col < 1792) { const int cc = col - 1664, kvh = cc >> 6, d = cc & 63; const float got = bf2f(VT[((b * 2 + kvh) * 64 + d) * 2048 + s]); diag_max(ctl, 6, relerr(got, p, 0.05f)); }
            else if (col < 2368) { const bool isq = col < 2304; const int cc = isq ? col - 1792 : col - 2304; const int d = cc & 63; float v = p;
                if (d < 8) v = p * COS[m * 8 + d] - pr[w][col + 8] * SIN[m * 8 + d]; else if (d < 16) v = p * COS[m * 8 + d - 8] + pr[w][col - 8] * SIN[m * 8 + d - 8];
                if (isq) v *= 0.125f;
                const float got = bf2f(isq ? QI[m * 512 + cc] : KI[m * 64 + cc]); diag_max(ctl, 5, relerr(got, v, 0.05f)); }
            else { const float got = WI[m * 8 + col - 2368]; diag_max(ctl, 6, relerr(got, p * 0.3535533905932738f, 0.05f)); } }
        { const int bb = gw & 31, e = (gw * 131 + 7) % 6144; float acc = 0.f;
          for (int k = lane; k < D; k += 64) { const float cv = cc_[bb * D + k]; acc += cv / (1.0f + __expf(-cv)) * w_ada[(size_t)k * 6144 + e]; }
          acc = wave_sum(acc) + b_ada[e]; diag_max(ctl, 7, relerr(MOD[bb * 6144 + e], acc, 0.02f)); }
        { float ss = 0.f; for (int k = lane; k < D; k += 64) { const float xv = x[m * D + k]; ss += xv * xv; }
          const float rstd = rsqrtf(wave_sum(ss) / D + EPS); const int k = (lane * 17 + 3) & 1023; const float* mod = MOD + b * 6144;
          const float want = x[m * D + k] * rstd * g_pre_mix[k] * (1.f + mod[1024 + k]) + mod[k]; diag_max(ctl, 7, relerr(bf2f(H[m * D + k]), want, 0.02f)); }
    }
    {
        const size_t m = ((size_t)gw * 61 + 29) % M; const size_t R0 = m & ~(size_t)127; const int tc = (int)(m & 127);
        float ssq = 0.f;
#pragma unroll 1
        for (int pass = 0; pass < 2; ++pass) { const float rs = rsqrtf(wave_sum(ssq) * (1.f / 512.f) + EPS);
#pragma unroll 1
            for (int e = 0; e < 8; ++e) { const int c = 8 * lane + e, g = c >> 7; float mix = 0.f;
#pragma unroll 1
                for (int s2 = 0; s2 <= tc; ++s2) {
                    float gs = 0.f; for (int k = 0; k < 128; ++k) { const float zv = bf2f(ZV[(R0 + s2) * 512 + g * 128 + k]); gs += zv * zv; }
                    const float vnv = bf2f((bf16)f2bf(bf2f(ZV[(R0 + s2) * 512 + c]) * rsqrtf(gs * (1.f / 128.f) + EPS) * g_sgu_v[c]));
                    mix += bf2f(WM[(g * 128 + tc) * 128 + s2]) * vnv; }
                const float yv = (mix + b_spatial[g * 128 + tc]) * bf2f(ZU[(R0 + tc) * 512 + c]);
                if (pass == 0) ssq += yv * yv; else diag_max(ctl, 3, relerr(bf2f(MERGED[(R0 + tc) * D + c]), yv * rs * g_out_sgu[c], 0.05f)); } }
    }
    if (vcu < 256) {
        const int b = vcu >> 3, qb = vcu & 7;
        const unsigned char* scr = ws + WS_SCR + (size_t)blockIdx.x * SCR_PER_WG;
        const unsigned short* SC = (const unsigned short*)(scr + SCR_SC); const unsigned* MK = (const unsigned*)(scr + SCR_MK); const bf16* YB = (const bf16*)(scr + SCR_YB);
#pragma unroll 1
        for (int i = 0; i < 16; ++i) { const int ql = 16 * w + i, t = 128 * qb + ql; int pc = __builtin_popcount(MK[ql * 64 + lane]);
#pragma unroll
            for (int o = 1; o < 64; o <<= 1) pc += __shfl_xor(pc, o);
            const int want = (t + 1 < 256) ? t + 1 : 256; if (pc < want || pc > want + 16) diag_max(ctl, 0, 1.0f + (float)(pc > want ? pc - want : want - pc)); }
        if (qb >= 2) { const int ql = 16 * w + 5, t = 128 * qb + ql; const size_t row = (size_t)b * SEQ + t; const int s2 = (lane * 37 + w * 11) % (t + 1); const size_t krow = (size_t)b * SEQ + s2;
            float sc2 = 0.f;
#pragma unroll 1
            for (int hd = 0; hd < 8; ++hd) { float d = 0.f; for (int dd = 0; dd < 64; ++dd) d += bf2f(QI[row * 512 + hd * 64 + dd]) * bf2f(KI[krow * 64 + dd]); sc2 += WI[row * 8 + hd] * fmaxf(d, 0.f); }
            diag_max(ctl, 1, relerr(h2f(SC[(size_t)ql * 2048 + s2]), sc2, 0.05f));
            float mins = INFINITY, maxu = -INFINITY;
#pragma unroll 1
            for (int s3 = lane; s3 <= t; s3 += 64) { const float v = h2f(SC[(size_t)ql * 2048 + s3]); if ((MK[ql * 64 + (s3 >> 5)] >> (s3 & 31)) & 1u) mins = fminf(mins, v); else maxu = fmaxf(maxu, v); }
            mins = -wave_max(-mins); maxu = wave_max(maxu); if (maxu > mins) diag_max(ctl, 0, 100.0f); }
        { const int ql = 16 * w + 9, t = 128 * qb + ql, hd = w, kvh = hd >> 2; const size_t row = (size_t)b * SEQ + t;
          const float qd = bf2f(Q[row * 512 + hd * 64 + lane]); float mrun = -1e30f, lrun = 0.f, o = 0.f;
#pragma unroll 1
          for (int s2 = 0; s2 <= t; ++s2) { if (!((MK[ql * 64 + (s2 >> 5)] >> (s2 & 31)) & 1u)) continue;
              const float lg = wave_sum(qd * bf2f(K[((size_t)b * SEQ + s2) * 128 + kvh * 64 + lane]));
              const float mn = fmaxf(mrun, lg), al = __builtin_amdgcn_exp2f(mrun - mn), p = __builtin_amdgcn_exp2f(lg - mn);
              lrun = lrun * al + p; o = o * al + p * bf2f(VT[((size_t)(b * 2 + kvh) * 64 + lane) * 2048 + s2]); mrun = mn; }
          diag_max(ctl, 2, relerr(bf2f(YB[(size_t)ql * 512 + hd * 64 + lane]), o / lrun, 0.02f)); }
    }
}
#endif

extern "C" void kernel_launch(void* const* d_in, const int* in_sizes, int n_in, void* d_out, int out_size, void* d_ws, size_t ws_size, hipStream_t stream) {
    static int grid = 0;
    if (grid == 0) {
        if (n_in != 18 || in_sizes[0] != M * D || out_size != M * D || ws_size < WS_END) { fprintf(stderr, "kernel_launch: unexpected problem shape or workspace (n_in %d, ws %zu < %zu)\n", n_in, ws_size, (size_t)WS_END); grid = -1; return; }
        int dev = 0, cus = 0, per_cu = 0;
        if (hipGetDevice(&dev) != hipSuccess || hipDeviceGetAttribute(&cus, hipDeviceAttributeMultiprocessorCount, dev) != hipSuccess) { grid = -1; return; }
        if (hipFuncSetAttribute((const void*)fwd_kernel, hipFuncAttributeMaxDynamicSharedMemorySize, LDS_BYTES) != hipSuccess) { grid = -1; return; }
        if (hipOccupancyMaxActiveBlocksPerMultiprocessor(&per_cu, (const void*)fwd_kernel, NWAVES * 64, LDS_BYTES) != hipSuccess || per_cu < 1) { fprintf(stderr, "kernel_launch: occupancy query reports %d workgroups per CU\n", per_cu); }
        (void)hipGetLastError();
        grid = cus;
    }
    if (grid < 0) return;
    if (hipMemsetAsync((char*)d_ws + WS_CTL, 0, CTL_ZERO_BYTES, stream) != hipSuccess) return;
    Args a{};
    a.rep[0] = 1; a.rep[1] = 1; a.rep[2] = 1; a.rep[3] = 0; a.rep[4] = 1; a.rep[5] = 1; a.rep[6] = 1; a.rep[7] = 1;
#ifdef PROBE_REP
    a.rep[PROBE_REP] += 1;
#endif
    for (int i = 0; i < 18; ++i) a.in[i] = d_in[i];
    a.out = (float*)d_out; a.ws = (unsigned char*)d_ws;
#if defined(PROBE_SPLIT)
    a.ph_lo = 0; a.ph_hi = PROBE_SPLIT + 1; hipLaunchKernelGGL(fwd_kernel, dim3(grid), dim3(NWAVES * 64), LDS_BYTES, stream, a);
    (void)hipMemsetAsync((char*)d_ws + WS_CTL, 0, CTL_ZERO_BYTES, stream);
    a.ph_lo = PROBE_SPLIT; a.ph_hi = N_PHASES; hipLaunchKernelGGL(fwd_kernel, dim3(grid), dim3(NWAVES * 64), LDS_BYTES, stream, a);
#elif MK_N_LAUNCHES == 1
    a.ph_lo = 0; a.ph_hi = N_PHASES;
    hipLaunchKernelGGL(fwd_kernel, dim3(grid), dim3(NWAVES * 64), LDS_BYTES, stream, a);
#else
    for (int li = 0; li < N_PHASES; ++li) { a.ph_lo = li; a.ph_hi = li + 1; hipLaunchKernelGGL(fwd_kernel, dim3(grid), dim3(NWAVES * 64), LDS_BYTES, stream, a);
#ifdef DIAG
        if (li == 4) hipLaunchKernelGGL(diag_kernel, dim3(grid), dim3(512), 0, stream, a);
#endif
    }
#endif
}
```

```cpp
#include <hip/hip_runtime.h>
#include <cstdio>
#include <cstdint>
#define MK_N_LAUNCHES 1
namespace pg8 {
#define PG8_LAS __attribute__((address_space(3)))
typedef unsigned short bf16_t;
typedef short bf16x8 __attribute__((ext_vector_type(8)));
typedef float f32x4 __attribute__((ext_vector_type(4)));
typedef unsigned u32x4 __attribute__((ext_vector_type(4)));
constexpr int BM = 256, BK = 64, HALF = 128, HTB = HALF * BK * 2  , STAGE_BYTES = 8 * HTB, NXCD = 8, WGM = 8;

__host__ __device__ __forceinline__ int lds_byte(int r, int c) { const int st = (r >> 4) * 2 + (c >> 5), rr = r & 15, cc = c & 31, ob = rr * 64 + cc * 2; return st * 1024 + (ob ^ (((ob >> 9) & 1) << 5)); }
__host__ __device__ __forceinline__ void stage_rc(int b, int& R, int& C) { const int st = b / 1024, sb = b % 1024, swz = sb ^ (((sb >> 9) & 1) << 5); R = (st >> 1) * 16 + swz / 64; C = (st & 1) * 32 + (swz % 64) / 2; }
__host__ __device__ __forceinline__ int perm32(int rho) { const int n = rho >> 4, i = rho & 15; return 8 * (i >> 2) + 4 * n + (i & 3); }

struct Unit { int pm, pn; };
struct Gemm { const bf16_t* A; const bf16_t* Bt; int M, N, K; };

struct StaticOrder {
    int nM, nN, nwg, G, c;
    __host__ __device__ void init(int M, int N, int G_, int c_) { nM = M / BM; nN = N / BM; nwg = nM * nN; G = G_; c = c_; }
    __host__ __device__ bool next(int i, Unit& u) const {
        const long L = (long)i * G + c; if (L >= nwg) return false;
        int wgid = (int)L; { const int q = nwg / NXCD, r = nwg % NXCD, xcd = wgid % NXCD, off = wgid / NXCD; wgid = (xcd < r ? xcd * (q + 1) : r * (q + 1) + (xcd - r) * q) + off; }
        const int nig = WGM * nN, gid = wgid / nig, fm = gid * WGM, gsz = (nM - fm) < WGM ? (nM - fm) : WGM;
        u.pm = fm + ((wgid % nig) % gsz); u.pn = (wgid % nig) / gsz; return true;
    }
    __device__ __forceinline__ void a_ready(const Unit&) const {}
    __device__ __forceinline__ void done(const Unit&) const {}
};
__device__ __forceinline__ unsigned cvt_pk_bf16(float lo, float hi) { unsigned r; asm volatile("v_cvt_pk_bf16_f32 %0, %1, %2" : "=v"(r) : "v"(lo), "v"(hi)); return r; }
typedef unsigned u32x2 __attribute__((ext_vector_type(2)));
__device__ __forceinline__ float gelu_tanh(float x) {
    const float u = x * (1.0f + 0.044715f * x * x);
    const float e = __builtin_amdgcn_exp2f(-2.302208198f * u);
    return x * __builtin_amdgcn_rcpf(1.0f + e);
}
__device__ __forceinline__ void store8(bf16_t* p, const f32x4& v0, const f32x4& v1) {
    u32x4 w; w.x = cvt_pk_bf16(v0[0], v0[1]); w.y = cvt_pk_bf16(v0[2], v0[3]); w.z = cvt_pk_bf16(v1[0], v1[1]); w.w = cvt_pk_bf16(v1[2], v1[3]);
    *(u32x4*)p = w;
}
__device__ __forceinline__ void rope8(f32x4& v0, f32x4& v1, const f32x4& c0, const f32x4& c1, const f32x4& s0, const f32x4& s1, int fq) {
    f32x4 p0, p1;
#pragma unroll
    for (int i = 0; i < 4; ++i) { p0[i] = __shfl_xor(v0[i], 16); p1[i] = __shfl_xor(v1[i], 16); }
    const float sg = (fq == 0) ? -1.f : 1.f;
    if (fq < 2) { v0 = v0 * c0 + sg * (p0 * s0); v1 = v1 * c1 + sg * (p1 * s1); }
}
constexpr float QSCALE = 0.18033688011112042f;
constexpr float QISCALE = 0.125f;
constexpr float WISCALE = 0.3535533905932738f;
struct EpiProj {
    static constexpr bool PERM = true, AFTER_DRAIN = false; static constexpr int RELAX = 0;
    bf16_t *ZU, *ZV, *Q, *K, *VT, *QI, *KI; float* WI; const float* cs; const float* sn; unsigned* KN;
    __device__ __forceinline__ void operator()(const f32x4 (&acc)[2][2][4][2], const Unit& u, int wr, int wc, int fr, int fq) const {
        const int pn = u.pn; const int row0 = u.pm * BM + wr * 64 + fr; const int cw = wc * 32 + 8 * fq;
        if (pn < 4) {
            bf16_t* base = (pn < 2) ? ZU : ZV; const int colt = (pn & 1) * 256;
#pragma unroll
            for (int ai = 0; ai < 2; ++ai)
#pragma unroll
                for (int m = 0; m < 4; ++m) { const size_t row = (size_t)(row0 + ai * HALF + m * 16);
#pragma unroll
                    for (int bj = 0; bj < 2; ++bj) { f32x4 v0 = acc[ai][bj][m][0], v1 = acc[ai][bj][m][1];
#pragma unroll
                        for (int i = 0; i < 4; ++i) { v0[i] = gelu_tanh(v0[i]); v1[i] = gelu_tanh(v1[i]); }
                        store8(base + row * 512 + colt + bj * HALF + cw, v0, v1); } }
        } else if (pn == 4 || pn == 5 || pn == 7 || pn == 8) {
            const bool isq = pn < 6; bf16_t* base = isq ? Q : QI; const int colt = (isq ? pn - 4 : pn - 7) * 256; const float sc = isq ? QSCALE : QISCALE;
            const bool rope = (wc & 1) == 0;
#pragma unroll
            for (int ai = 0; ai < 2; ++ai)
#pragma unroll
                for (int m = 0; m < 4; ++m) { const size_t row = (size_t)(row0 + ai * HALF + m * 16);
                    f32x4 c0 = {1.f, 1.f, 1.f, 1.f}, c1 = c0, s0 = {0.f, 0.f, 0.f, 0.f}, s1 = s0;
                    if (rope) { c0 = *(const f32x4*)(cs + row * 8); c1 = *(const f32x4*)(cs + row * 8 + 4); s0 = *(const f32x4*)(sn + row * 8); s1 = *(const f32x4*)(sn + row * 8 + 4); }
#pragma unroll
                    for (int bj = 0; bj < 2; ++bj) { f32x4 v0 = acc[ai][bj][m][0], v1 = acc[ai][bj][m][1];
                        if (rope) rope8(v0, v1, c0, c1, s0, s1, fq);
                        v0 = v0 * sc; v1 = v1 * sc;
                        store8(base + row * 512 + colt + bj * HALF + cw, v0, v1); } }
        } else if (pn == 6) {
            const bool rope = (wc & 1) == 0; float kn = 0.f;
#pragma unroll
            for (int ai = 0; ai < 2; ++ai)
#pragma unroll
                for (int m = 0; m < 4; ++m) { const size_t row = (size_t)(row0 + ai * HALF + m * 16);
                    { f32x4 v0 = acc[ai][0][m][0], v1 = acc[ai][0][m][1];
                      if (rope) { const f32x4 c0 = *(const f32x4*)(cs + row * 8), c1 = *(const f32x4*)(cs + row * 8 + 4), s0 = *(const f32x4*)(sn + row * 8), s1 = *(const f32x4*)(sn + row * 8 + 4);
                                  rope8(v0, v1, c0, c1, s0, s1, fq); }
                      store8(K + row * 128 + cw, v0, v1);
                      float rs = (v0[0] * v0[0] + v0[1] * v0[1]) + (v0[2] * v0[2] + v0[3] * v0[3]) + (v1[0] * v1[0] + v1[1] * v1[1]) + (v1[2] * v1[2] + v1[3] * v1[3]);
                      rs += __shfl_xor(rs, 16); rs += __shfl_xor(rs, 32); kn = fmaxf(kn, rs); }
                    { const f32x4 v0 = acc[ai][1][m][0], v1 = acc[ai][1][m][1];
                      const size_t b = row >> 11, s = row & 2047; const int kvh = cw >> 6, d0 = cw & 63;
                      bf16_t* vp = VT + ((b * 2 + kvh) * 64 + d0) * 2048 + s;
                      const unsigned w0 = cvt_pk_bf16(v0[0], v0[1]), w1 = cvt_pk_bf16(v0[2], v0[3]), w2 = cvt_pk_bf16(v1[0], v1[1]), w3 = cvt_pk_bf16(v1[2], v1[3]);
                      vp[0 * 2048] = (bf16_t)(w0 & 0xffffu); vp[1 * 2048] = (bf16_t)(w0 >> 16); vp[2 * 2048] = (bf16_t)(w1 & 0xffffu); vp[3 * 2048] = (bf16_t)(w1 >> 16);
                      vp[4 * 2048] = (bf16_t)(w2 & 0xffffu); vp[5 * 2048] = (bf16_t)(w2 >> 16); vp[6 * 2048] = (bf16_t)(w3 & 0xffffu); vp[7 * 2048] = (bf16_t)(w3 >> 16); } }
            kn = fmaxf(kn, __shfl_xor(kn, 1)); kn = fmaxf(kn, __shfl_xor(kn, 2)); kn = fmaxf(kn, __shfl_xor(kn, 4)); kn = fmaxf(kn, __shfl_xor(kn, 8));
            if (fr == 0 && fq == 0) atomicMax(KN + ((u.pm >> 3) * 2 + (wc >> 1)) * 2 + (wc & 1), __float_as_uint(kn));
        } else {
            if (wc < 2) {
                const bool rope = wc == 0;
#pragma unroll
                for (int ai = 0; ai < 2; ++ai)
#pragma unroll
                    for (int m = 0; m < 4; ++m) { const size_t row = (size_t)(row0 + ai * HALF + m * 16);
                        f32x4 v0 = acc[ai][0][m][0], v1 = acc[ai][0][m][1];
                        if (rope) { const f32x4 c0 = *(const f32x4*)(cs + row * 8), c1 = *(const f32x4*)(cs + row * 8 + 4), s0 = *(const f32x4*)(sn + row * 8), s1 = *(const f32x4*)(sn + row * 8 + 4);
                                    rope8(v0, v1, c0, c1, s0, s1, fq); }
                        store8(KI + row * 64 + cw, v0, v1); }
            } else if (wc == 2 && fq == 0) {
#pragma unroll
                for (int ai = 0; ai < 2; ++ai)
#pragma unroll
                    for (int m = 0; m < 4; ++m) { const size_t row = (size_t)(row0 + ai * HALF + m * 16);
                        *(f32x4*)(WI + row * 8) = acc[ai][0][m][0] * WISCALE; *(f32x4*)(WI + row * 8 + 4) = acc[ai][0][m][1] * WISCALE; }
            }
        }
    }
};
struct EpiRelu2 {
    static constexpr bool PERM = true, AFTER_DRAIN = false; static constexpr int RELAX = 16;
    bf16_t* O; int ldc;
    __device__ __forceinline__ void operator()(const f32x4 (&acc)[2][2][4][2], const Unit& u, int wr, int wc, int fr, int fq) const {
        const int row0 = u.pm * BM + wr * 64 + fr; const int col0 = u.pn * BM + wc * 32 + 8 * fq;
#pragma unroll
        for (int ai = 0; ai < 2; ++ai)
#pragma unroll
            for (int m = 0; m < 4; ++m) { bf16_t* rowp = O + (size_t)(row0 + ai * HALF + m * 16) * ldc + col0;
#pragma unroll
                for (int bj = 0; bj < 2; ++bj) { f32x4 v0 = acc[ai][bj][m][0], v1 = acc[ai][bj][m][1];
#pragma unroll
                    for (int i = 0; i < 4; ++i) { const float a = fmaxf(v0[i], 0.f), b = fmaxf(v1[i], 0.f); v0[i] = a * a; v1[i] = b * b; }
                    store8(rowp + bj * HALF, v0, v1);
#ifdef PROBE_EPI2
                    asm volatile("" ::: "memory"); store8(rowp + bj * HALF, v0, v1);
#endif
                    } }
    }
};
struct EpiNormPart {
    static constexpr bool PERM = true, AFTER_DRAIN = false; static constexpr int RELAX = 24;
    bf16_t* O; int ldc; float* part;
    __device__ __forceinline__ void operator()(const f32x4 (&acc)[2][2][4][2], const Unit& u, int wr, int wc, int fr, int fq) const {
        const int row0 = u.pm * BM + wr * 64 + fr; const int col0 = u.pn * BM + wc * 32 + 8 * fq;
#pragma unroll
        for (int ai = 0; ai < 2; ++ai)
#pragma unroll
            for (int m = 0; m < 4; ++m) { const size_t row = (size_t)(row0 + ai * HALF + m * 16); bf16_t* rowp = O + row * ldc + col0; float s = 0.f;
#pragma unroll
                for (int bj = 0; bj < 2; ++bj) { const f32x4 v0 = acc[ai][bj][m][0], v1 = acc[ai][bj][m][1];
                    s += (v0[0] * v0[0] + v0[1] * v0[1]) + (v0[2] * v0[2] + v0[3] * v0[3]) + (v1[0] * v1[0] + v1[1] * v1[1]) + (v1[2] * v1[2] + v1[3] * v1[3]);
                    store8(rowp + bj * HALF, v0, v1); }
                s += __shfl_xor(s, 16); s += __shfl_xor(s, 32);
                if (fq == 0) part[row * 16 + u.pn * 4 + wc] = s; }
    }
};
template <class Epi, class Sched, bool ALIGN_EPI = false, bool SP2 = false>
__device__ __forceinline__ void gemm_phase(PG8_LAS unsigned char* lds, const Gemm g, const Sched& S, const Epi& E, const int wave_in) {
    const int lane = (int)__builtin_amdgcn_mbcnt_hi(~0u, __builtin_amdgcn_mbcnt_lo(~0u, 0u)), wid = wave_in, tid = wid * 64 + lane, wr = wid >> 2, wc = wid & 3, fr = lane & 15, fq = lane >> 4;
    const int K = g.K, nt = K / BK;
    unsigned voffA[2], voffB[2];
#pragma unroll
    for (int i = 0; i < 2; ++i) { int R, C; stage_rc(tid * 16 + i * 8192, R, C); const int Rb = Epi::PERM ? ((R & ~31) + perm32(R & 31)) : R;
        voffA[i] = (unsigned)(R * K + C) * 2u; voffB[i] = (unsigned)(Rb * K + C) * 2u; }
    const size_t kstep = (size_t)(BK * 2);
    const size_t hstep = (size_t)HALF * K * 2;
    const size_t tstep = 2 * hstep;
    const unsigned ldsw = (unsigned)wid * 1024u;
    const int aoff = lds_byte(wr * 64 + fr, fq * 8), boff = lds_byte(wc * 32 + fr, fq * 8);
#define PG8_SA(b, h) (((b) * 2 + (h)) * HTB)
#define PG8_SB(b, h) ((4 + (b) * 2 + (h)) * HTB)
#define PG8_STAGE(bufoff, gbase, voff) do { _Pragma("unroll") for (int _i = 0; _i < 2; ++_i) \
        __builtin_amdgcn_global_load_lds((const unsigned*)((const char*)(gbase) + (voff)[_i]), (PG8_LAS unsigned*)(lds + (bufoff) + ldsw + _i * 8192), 16, 0, 0); } while (0)
#define PG8_LDA(dst, b, h) do { _Pragma("unroll") for (int m = 0; m < 4; ++m) _Pragma("unroll") for (int k = 0; k < 2; ++k) dst[m][k] = *(const PG8_LAS bf16x8*)(lds + PG8_SA(b, h) + aoff + m * 2048 + k * 1024); } while (0)
#define PG8_LDB(dst, b, h) do { _Pragma("unroll") for (int n = 0; n < 2; ++n) _Pragma("unroll") for (int k = 0; k < 2; ++k) dst[n][k] = *(const PG8_LAS bf16x8*)(lds + PG8_SB(b, h) + boff + n * 2048 + k * 1024); } while (0)
#define PG8_MMA(ai, bj, At, Bt) do { __builtin_amdgcn_s_setprio(1); _Pragma("unroll") for (int m = 0; m < 4; ++m) _Pragma("unroll") for (int n = 0; n < 2; ++n) _Pragma("unroll") for (int k = 0; k < 2; ++k) \
        acc[ai][bj][m][n] = __builtin_amdgcn_mfma_f32_16x16x32_bf16(Bt[n][k], At[m][k], acc[ai][bj][m][n], 0, 0, 0); __builtin_amdgcn_s_setprio(0); } while (0)
#define PG8_WAIT_V(n) asm volatile("s_waitcnt vmcnt(" #n ")" ::: "memory")
#define PG8_WAIT_L(n) asm volatile("s_waitcnt lgkmcnt(" #n ")" ::: "memory")
#define PG8_BAR __builtin_amdgcn_s_barrier()
#define PG8_SCHED __builtin_amdgcn_sched_barrier(0)
    Unit cur, nxt; int ui = 0;
    if (!S.next(0, cur)) return;
    f32x4 acc[2][2][4][2];
#pragma unroll
    for (int a = 0; a < 2; ++a)
#pragma unroll
        for (int b = 0; b < 2; ++b)
#pragma unroll
            for (int m = 0; m < 4; ++m)
#pragma unroll
                for (int n = 0; n < 2; ++n) acc[a][b][m][n] = (f32x4){0.f, 0.f, 0.f, 0.f};
    bf16x8 At[4][2], B0[2][2], B1[2][2];
    const char* cA = (const char*)g.A + (size_t)cur.pm * tstep; const char* cB = (const char*)g.Bt + (size_t)cur.pn * tstep;
    S.a_ready(cur);
    if constexpr (SP2) {
        PG8_STAGE(PG8_SB(0, 0), cB, voffB); PG8_STAGE(PG8_SB(0, 1), cB + hstep, voffB); PG8_STAGE(PG8_SA(0, 0), cA, voffA); PG8_STAGE(PG8_SA(0, 1), cA + hstep, voffA);
        if (wr == 1) PG8_BAR;
        PG8_WAIT_V(2); PG8_BAR;
        PG8_STAGE(PG8_SB(1, 0), cB + kstep, voffB); PG8_STAGE(PG8_SA(1, 0), cA + kstep, voffA); PG8_STAGE(PG8_SB(1, 1), cB + hstep + kstep, voffB);
        PG8_WAIT_V(6); PG8_BAR;
    } else {
        PG8_STAGE(PG8_SB(0, 0), cB, voffB); PG8_STAGE(PG8_SA(0, 0), cA, voffA); PG8_STAGE(PG8_SB(0, 1), cB + hstep, voffB); PG8_STAGE(PG8_SA(0, 1), cA + hstep, voffA);
        if (wr == 1) PG8_BAR;
        PG8_WAIT_V(4); PG8_BAR;
        PG8_STAGE(PG8_SB(1, 0), cB + kstep, voffB); PG8_STAGE(PG8_SA(1, 0), cA + kstep, voffA); PG8_STAGE(PG8_SB(1, 1), cB + hstep + kstep, voffB);
        PG8_WAIT_V(6); PG8_BAR;
    }
    for (;;) {
        const bool has_next = S.next(ui + 1, nxt);
        const char* nA = has_next ? (const char*)g.A + (size_t)nxt.pm * tstep : cA; const char* nB = has_next ? (const char*)g.Bt + (size_t)nxt.pn * tstep : cB;
        for (int t = 0; t < nt; t += 2) {
            const bool last = (t == nt - 2);
            const char* a1 = cA + (size_t)(t + 1) * kstep;
            const char* a2 = last ? nA : cA + (size_t)(t + 2) * kstep; const char* b2 = last ? nB : cB + (size_t)(t + 2) * kstep;
            const char* a3 = a2 + kstep; const char* b3 = b2 + kstep;
            if (last && has_next) S.a_ready(nxt);
            if constexpr (SP2) {
            PG8_LDB(B0, 0, 0); PG8_LDB(B1, 0, 1); PG8_SCHED; PG8_LDA(At, 0, 0); PG8_STAGE(PG8_SA(1, 1), a1 + hstep, voffA);
            PG8_WAIT_V(8); PG8_WAIT_L(0); PG8_BAR; PG8_MMA(0, 0, At, B0); PG8_MMA(0, 1, At, B1); PG8_BAR; PG8_SCHED;
            PG8_LDA(At, 0, 1); PG8_STAGE(PG8_SB(0, 0), b2, voffB); PG8_STAGE(PG8_SB(0, 1), b2 + hstep, voffB); PG8_STAGE(PG8_SA(0, 0), a2, voffA);
            PG8_WAIT_V(8); PG8_WAIT_L(0); PG8_BAR; PG8_MMA(1, 0, At, B0); PG8_MMA(1, 1, At, B1); PG8_BAR; PG8_SCHED;
            PG8_LDB(B0, 1, 0); PG8_LDB(B1, 1, 1); PG8_SCHED; PG8_LDA(At, 1, 0); PG8_STAGE(PG8_SA(0, 1), a2 + hstep, voffA);
            PG8_WAIT_V(8); PG8_WAIT_L(0); PG8_BAR; PG8_MMA(0, 0, At, B0); PG8_MMA(0, 1, At, B1); PG8_BAR; PG8_SCHED;
            PG8_LDA(At, 1, 1); PG8_STAGE(PG8_SB(1, 0), b3, voffB); PG8_STAGE(PG8_SB(1, 1), b3 + hstep, voffB); PG8_STAGE(PG8_SA(1, 0), a3, voffA);
            PG8_WAIT_V(8); PG8_WAIT_L(0); PG8_BAR; PG8_MMA(1, 0, At, B0); PG8_MMA(1, 1, At, B1); PG8_BAR; PG8_SCHED;
            } else {
            PG8_LDB(B0, 0, 0); PG8_SCHED; PG8_LDA(At, 0, 0); PG8_STAGE(PG8_SA(1, 1), a1 + hstep, voffA);
            PG8_WAIT_L(8); PG8_BAR; PG8_WAIT_L(0); PG8_MMA(0, 0, At, B0); PG8_BAR; PG8_SCHED;
            PG8_LDB(B1, 0, 1); PG8_STAGE(PG8_SB(0, 0), b2, voffB);
            PG8_BAR; PG8_WAIT_L(0); PG8_MMA(0, 1, At, B1); PG8_BAR;
            PG8_LDA(At, 0, 1); PG8_STAGE(PG8_SA(0, 0), a2, voffA);
            PG8_BAR; PG8_WAIT_L(0); PG8_MMA(1, 0, At, B0); PG8_BAR; PG8_SCHED;
            PG8_STAGE(PG8_SB(0, 1), b2 + hstep, voffB);
            PG8_WAIT_V(6); PG8_BAR; PG8_MMA(1, 1, At, B1); PG8_BAR;
            PG8_LDB(B0, 1, 0); PG8_SCHED; PG8_LDA(At, 1, 0); PG8_STAGE(PG8_SA(0, 1), a2 + hstep, voffA);
            PG8_WAIT_L(8); PG8_BAR; PG8_WAIT_L(0); PG8_MMA(0, 0, At, B0); PG8_BAR; PG8_SCHED;
            PG8_LDB(B1, 1, 1); PG8_STAGE(PG8_SB(1, 0), b3, voffB);
            PG8_BAR; PG8_WAIT_L(0); PG8_MMA(0, 1, At, B1); PG8_BAR;
            PG8_LDA(At, 1, 1); PG8_STAGE(PG8_SA(1, 0), a3, voffA);
            PG8_BAR; PG8_WAIT_L(0); PG8_MMA(1, 0, At, B0); PG8_BAR; PG8_SCHED;
            PG8_STAGE(PG8_SB(1, 1), b3 + hstep, voffB);
            PG8_WAIT_V(6); PG8_BAR; PG8_MMA(1, 1, At, B1); PG8_BAR;
            }
        }
        if constexpr (ALIGN_EPI) { if (wr == 0) PG8_BAR; }
        if constexpr (!Epi::AFTER_DRAIN) { E(acc, cur, wr, wc, fr, fq); S.done(cur); }
        if (!has_next) break;
#pragma unroll
        for (int a = 0; a < 2; ++a)
#pragma unroll
            for (int b = 0; b < 2; ++b)
#pragma unroll
                for (int m = 0; m < 4; ++m)
#pragma unroll
                    for (int n = 0; n < 2; ++n) acc[a][b][m][n] = (f32x4){0.f, 0.f, 0.f, 0.f};
        cur = nxt; cA = nA; cB = nB; ++ui;
        if constexpr (ALIGN_EPI) { if (wr == 1) PG8_BAR; }
    }
    PG8_WAIT_V(0);
    if constexpr (!ALIGN_EPI) { if (wr == 0) PG8_BAR; }
    PG8_BAR;
    if constexpr (Epi::AFTER_DRAIN) { E.fused(acc, cur, wr, wc, fr, fq, lds, wid, lane); S.done(cur); }
#undef PG8_SA
#undef PG8_SB
#undef PG8_STAGE
#undef PG8_LDA
#undef PG8_LDB
#undef PG8_MMA
#undef PG8_WAIT_V
#undef PG8_WAIT_L
#undef PG8_BAR
#undef PG8_SCHED
}
}
#define PG8_SP2 true
#define PG8_ALIGN true
#define GAS __attribute__((address_space(1)))
#define LAS __attribute__((address_space(3)))
typedef unsigned short bf16;
typedef unsigned v4u __attribute__((ext_vector_type(4)));
typedef float f32x4 __attribute__((ext_vector_type(4)));
typedef short bf16x8 __attribute__((ext_vector_type(8)));
typedef GAS unsigned gu32;
typedef GAS unsigned long long gu64;
#define RLX_AGENT __ATOMIC_RELAXED, __HIP_MEMORY_SCOPE_AGENT
#define LDS_WAIT() asm volatile("s_waitcnt lgkmcnt(0)" ::: "memory")
#define VM_WAIT() asm volatile("s_waitcnt vmcnt(0)" ::: "memory")
__device__ __forceinline__ unsigned long long rt() { return __builtin_amdgcn_s_memrealtime(); }
__device__ __forceinline__ unsigned f2bf(float f) { unsigned u = __builtin_bit_cast(unsigned, f); return (u + 0x7fffu + ((u >> 16) & 1u)) >> 16; }
__device__ __forceinline__ unsigned pk2(float lo, float hi) { return f2bf(lo) | (f2bf(hi) << 16); }

#define XB_LANE() ((int)__builtin_amdgcn_mbcnt_hi(~0u, __builtin_amdgcn_mbcnt_lo(~0u, 0u)))
#define XB_TMO      128
#define XB_XCNT(j)  (256  + 64 * (j))
#define XB_XSUB(j)  (1280 + 64 * (j))
#define XB_XGEN(j)  (2304 + 64 * (j))
#define XB_TOP      3328
#define XB_TOPGEN   3392
#define XCD_BAR_WORDS 3456
#define XB_SPIN_CAP (1u << 18)

__device__ __forceinline__ unsigned xb_ld(unsigned* p)              { return __hip_atomic_load(p, __ATOMIC_RELAXED, __HIP_MEMORY_SCOPE_AGENT); }
__device__ __forceinline__ unsigned xb_add(unsigned* p, unsigned v) { return __hip_atomic_fetch_add(p, v, __ATOMIC_RELAXED, __HIP_MEMORY_SCOPE_AGENT); }
__device__ __forceinline__ unsigned xb_xcc_id() { return (unsigned)__builtin_amdgcn_s_getreg((3 << 11) | 20) & 0xFu; }
#define XB_SPIN(cond, bar) do { unsigned _sp = 0; while (cond) { __builtin_amdgcn_s_sleep(1); \
    if ((++_sp & 255u) == 0u) { if (xb_ld(&(bar)[XB_TMO])) break; if (_sp > XB_SPIN_CAP) { atomicAdd(&(bar)[XB_TMO], 1u); break; } } } } while (0)

struct XcdBarrier {
    int wave;
    unsigned* bar; unsigned x;
    volatile LAS unsigned* st;
};

__device__ __forceinline__ XcdBarrier xcd_barrier_post(unsigned* bar, volatile LAS unsigned* st, int wave_in) {
    XcdBarrier b; b.wave = wave_in; b.bar = bar; b.x = xb_xcc_id(); b.st = st;
    if (b.wave == 0 && XB_LANE() == 0) (void)xb_add(&bar[XB_XCNT(b.x)], 1u);
    return b;
}
__device__ __forceinline__ void xcd_barrier_complete(unsigned* bar, unsigned x, unsigned& nloc, unsigned& nx) {
    const unsigned G = gridDim.x * gridDim.y * gridDim.z;
    unsigned sum, cnt, mine, sp = 0u;
    for (;;) {
        sum = 0u; cnt = 0u; mine = 0u;
#pragma unroll
        for (unsigned j = 0; j < 16; ++j) { const unsigned c = xb_ld(&bar[XB_XCNT(j)]); sum += c; cnt += (c > 0u) ? 1u : 0u; mine = (j == x) ? c : mine; }
        if (sum == G) break;
        __builtin_amdgcn_s_sleep(1);
        if ((++sp & 255u) == 0u) { if (xb_ld(&bar[XB_TMO])) break; if (sp > XB_SPIN_CAP) { atomicAdd(&bar[XB_TMO], 1u); break; } }
    }
    nloc = mine > 0u ? mine : 1u; nx = cnt > 0u ? cnt : 1u;
}

__device__ __forceinline__ void xcd_barrier(const XcdBarrier& b) {
    asm volatile("s_waitcnt vmcnt(0)" ::: "memory");
    __syncthreads();
    if (b.wave == 0 && XB_LANE() == 0) {
        unsigned* bar = b.bar;
        __builtin_amdgcn_s_waitcnt(0);
        unsigned nloc = b.st[0], nx = b.st[1];
        if (nloc == 0u) { xcd_barrier_complete(bar, b.x, nloc, nx); b.st[0] = nloc; b.st[1] = nx; }
        const unsigned old = xb_add(&bar[XB_XSUB(b.x)], 1u);
        const unsigned gen = old / nloc;
        if (old + 1u == (gen + 1u) * nloc) {
            __builtin_amdgcn_fence(__ATOMIC_RELEASE, "agent");
            asm volatile("s_waitcnt vmcnt(0)" ::: "memory");
            const unsigned og = xb_add(&bar[XB_TOP], 1u);
            const unsigned tg = og / nx;
            if (og + 1u == (tg + 1u) * nx) xb_add(&bar[XB_TOPGEN], 1u);
            else XB_SPIN(xb_ld(&bar[XB_TOPGEN]) == tg, bar);
            __builtin_amdgcn_fence(__ATOMIC_ACQUIRE, "agent");
            xb_add(&bar[XB_XGEN(b.x)], 1u);
            asm volatile("s_waitcnt vmcnt(0)" ::: "memory");
        } else {
            XB_SPIN(xb_ld(&bar[XB_XGEN(b.x)]) == gen, bar);
            __builtin_amdgcn_fence(__ATOMIC_ACQUIRE, "agent");
            asm volatile("s_waitcnt vmcnt(0)" ::: "memory");
        }
    }
    __syncthreads();
}
#ifndef STAGGER_STEPS
#define STAGGER_STEPS 55
#endif
#ifndef MK_N_LAUNCHES
#define MK_N_LAUNCHES 1
#endif
constexpr int NWAVES = 8;
constexpr int N_PHASES = 10;
constexpr int BATCH = 32, SEQ = 2048, D = 1024, M = BATCH * SEQ, DIN = 2376, DINP = 2560, FF = 4096, DSGU = 512;
constexpr float EPS = 1e-6f;
constexpr size_t MiB = 1u << 20;
constexpr size_t WS_CTL = 0, CTL_ZERO_BYTES = 1 * MiB;
constexpr size_t WS_MOD = 1 * MiB;
constexpr size_t WS_COS = 2 * MiB, WS_SIN = 4 * MiB;
constexpr size_t WS_WM = 6 * MiB;
constexpr size_t WS_PART = 7 * MiB;
constexpr size_t WS_WIN = 12 * MiB, WS_WOUT = 17 * MiB, WS_W1 = 19 * MiB, WS_W2 = 27 * MiB;
constexpr size_t WS_WI = 36 * MiB;
constexpr size_t WS_H = 40 * MiB;
constexpr size_t WS_BIG = 168 * MiB;
constexpr size_t WS_ZU = WS_BIG, WS_ZV = WS_BIG + 64 * MiB, WS_Q = WS_BIG + 128 * MiB, WS_K = WS_BIG + 192 * MiB, WS_VT = WS_BIG + 208 * MiB,
                 WS_QI = WS_BIG + 224 * MiB, WS_KI = WS_BIG + 288 * MiB, WS_MERGED = WS_BIG + 296 * MiB;
constexpr size_t WS_O = WS_BIG;
constexpr size_t WS_HB = WS_BIG;
constexpr size_t WS_SCR = WS_BIG + 512 * MiB;
constexpr size_t WS_F = WS_SCR;
constexpr size_t WS_END = WS_SCR + 256 * MiB;
constexpr size_t SCR_PER_WG = 1 * MiB, SCR_SC = 0, SCR_MK = 512 * 1024, SCR_YB = 768 * 1024;
constexpr int CW_BAR = 4096;
constexpr int CW_KN = 12288;
constexpr int RING_OFF = 0, RING_BYTES = 131072;
constexpr int LDSCTL_OFF = 159744, MISC_OFF = LDSCTL_OFF + 320, AUX_OFF = LDSCTL_OFF + 1024;
constexpr int LDS_BYTES = 163840;

typedef float f32x16 __attribute__((ext_vector_type(16)));
typedef float f32x2 __attribute__((ext_vector_type(2)));
typedef unsigned u32x2 __attribute__((ext_vector_type(2)));
#define MFMA32(a, b, c) __builtin_amdgcn_mfma_f32_32x32x16_bf16((a), (b), (c), 0, 0, 0)
#define LANE() ((int)__builtin_amdgcn_mbcnt_hi(~0u, __builtin_amdgcn_mbcnt_lo(~0u, 0u)))
#define TID(F) ((F).wave * 64 + LANE())

struct Frame {
    LAS unsigned char* lds;
    volatile LAS unsigned* MISC;
    gu32* ctl;
    int wave, vcu, G; int repA, repB, repC, repD, repE, repF, repG, repH;
    const float *x, *c; const int* pos; const float *w_ada, *b_ada, *g_pre_mix, *w_in, *g_sgu_v, *w_spatial, *b_spatial, *g_out_sgu, *g_out_attn, *w_out, *g_post_mix, *g_pre_ffn, *w_ff1, *w_ff2, *g_post_ffn;
    float* out;
    float *MOD, *COS, *SIN, *PART, *WI;
    bf16 *WM, *WIN, *WOUT, *W1, *W2, *H, *ZU, *ZV, *Q, *K, *VT, *QI, *KI, *MERGED, *O, *HB, *FB;
    unsigned char* scr;
};
__device__ __forceinline__ float bflo(unsigned u) { return __builtin_bit_cast(float, u << 16); }
__device__ __forceinline__ float bfhi(unsigned u) { return __builtin_bit_cast(float, u & 0xffff0000u); }
__device__ __forceinline__ unsigned pkbf(float lo, float hi) { return pg8::cvt_pk_bf16(lo, hi); }
__device__ __forceinline__ float wave_sum(float v) {
#pragma unroll
    for (int o = 1; o < 64; o <<= 1) v += __shfl_xor(v, o);
    return v;
}
__device__ __forceinline__ void block_sync_mem(bool wave0) {
    asm volatile("s_waitcnt vmcnt(0)" ::: "memory");
    __syncthreads();
    if (wave0 && LANE() == 0) { __builtin_amdgcn_fence(__ATOMIC_ACQUIRE, "agent"); asm volatile("s_waitcnt vmcnt(0)" ::: "memory"); }
    __syncthreads();
}

__device__ __forceinline__ void block_sync_nofence() { asm volatile("s_waitcnt vmcnt(0)" ::: "memory"); __syncthreads(); }
__device__ __forceinline__ void p0_transpose_item(const float* W, int K, int N, int Npad, bf16* WT, LAS float* scr, int item, int lane) {
    const int nblk = Npad / 32, kb = item / nblk, nb = item % nblk, k0 = 64 * kb, n0 = 32 * nb;
    const int nn = n0 + (lane & 31);
#pragma unroll 8
    for (int i = 0; i < 32; ++i) { const int kk = 2 * i + (lane >> 5); scr[kk * 33 + (lane & 31)] = (nn < N) ? W[(size_t)(k0 + kk) * N + nn] : 0.f; }
    LDS_WAIT(); asm volatile("" ::: "memory");
    const int c = lane & 7;
#pragma unroll
    for (int j = 0; j < 4; ++j) { const int n = (lane >> 3) + 8 * j; const LAS float* s = scr + (8 * c) * 33 + n;
        v4u o; o.x = pk2(s[0 * 33], s[1 * 33]); o.y = pk2(s[2 * 33], s[3 * 33]); o.z = pk2(s[4 * 33], s[5 * 33]); o.w = pk2(s[6 * 33], s[7 * 33]);
        *(GAS v4u*)(WT + (size_t)(n0 + n) * K + k0 + 8 * c) = o; }
    LDS_WAIT(); asm volatile("" ::: "memory");
}
__device__ __forceinline__ void p0_mod_unit(Frame& F, int u) {
    const int lane = LANE(), w = F.wave, tid = TID(F);
    LAS float* csl = (LAS float*)F.lds + w * 4096;
#pragma unroll 4
    for (int i = 0; i < 64; ++i) { const int idx = i * 64 + lane, b = idx >> 7, d = idx & 127; const float cv = F.c[b * D + 128 * w + d];
        csl[d * 32 + b] = cv / (1.0f + __expf(-cv)); }
    LDS_WAIT(); asm volatile("" ::: "memory");
    float acc[32];
#pragma unroll
    for (int b = 0; b < 32; ++b) acc[b] = 0.f;
    const float* wp = F.w_ada + (size_t)(128 * w) * 6144 + 64 * u + lane;
#pragma unroll 2
    for (int d = 0; d < 128; ++d) { const float wv = wp[(size_t)d * 6144];
#pragma unroll
        for (int b4 = 0; b4 < 8; ++b4) { const f32x4 cc = *(const LAS f32x4*)(csl + d * 32 + 4 * b4);
            acc[4 * b4 + 0] += cc[0] * wv; acc[4 * b4 + 1] += cc[1] * wv; acc[4 * b4 + 2] += cc[2] * wv; acc[4 * b4 + 3] += cc[3] * wv; } }
    __syncthreads();
    LAS float* red = (LAS float*)F.lds;
#pragma unroll
    for (int b = 0; b < 32; ++b) red[(w * 32 + b) * 64 + lane] = acc[b];
    __syncthreads();
#pragma unroll
    for (int k = 0; k < 4; ++k) { const int o = tid + 512 * k, b = o >> 6, col = o & 63; float s = 0.f;
#pragma unroll
        for (int ww = 0; ww < 8; ++ww) s += red[(ww * 32 + b) * 64 + col];
        F.MOD[b * 6144 + 64 * u + col] = s + F.b_ada[64 * u + col]; }
    __syncthreads();
}
__device__ __forceinline__ void p0_prologue(Frame& F) {
    for (int u = F.vcu; u < 96; u += F.G) p0_mod_unit(F, u);
    LAS float* scr = (LAS float*)(F.lds + RING_OFF + F.wave * 16384);
    const int gw = F.vcu * NWAVES + F.wave, NGW = F.G * NWAVES;
    constexpr int I_IN = (D / 64) * (DINP / 32), I_OUT = (D / 64) * (D / 32), I_1 = (D / 64) * (FF / 32), I_2 = (FF / 64) * (D / 32);
    constexpr int NITEMS = I_IN + I_OUT + I_1 + I_2;
    for (int it = gw; it < NITEMS; it += NGW) {
        int r = it;
        if (r < I_IN) { p0_transpose_item(F.w_in, D, DIN, DINP, F.WIN, scr, r, LANE()); continue; } r -= I_IN;
        if (r < I_OUT) { p0_transpose_item(F.w_out, D, D, D, F.WOUT, scr, r, LANE()); continue; } r -= I_OUT;
        if (r < I_1) { p0_transpose_item(F.w_ff1, D, FF, FF, F.W1, scr, r, LANE()); continue; } r -= I_1;
        p0_transpose_item(F.w_ff2, FF, D, D, F.W2, scr, r, LANE());
    }
    const int gt = F.vcu * NWAVES * 64 + TID(F), NT = F.G * NWAVES * 64;
    for (int i = gt; i < 4 * 128 * 128; i += NT) { const int t = (i >> 7) & 127, s = i & 127; F.WM[i] = (bf16)f2bf(s <= t ? F.w_spatial[i] : 0.f); }
    for (int i = gt; i < M * 8; i += NT) { const int m = i >> 3, j = i & 7;
        const double rpp = (j == 0) ? 0.15915494309189535 : (j == 1) ? 0.03086376340470123 : (j == 2) ? 0.005985185712713705 : (j == 3) ? 0.001160663641240061 :
                           (j == 4) ? 0.00022507907903927653 : (j == 5) ? 4.364795279280289e-05 : (j == 6) ? 8.464330808241401e-06 : 1.6414262627950345e-06;
        const double rev = (double)F.pos[m] * rpp; const float fr = (float)(rev - __builtin_floor(rev));
        F.COS[i] = __builtin_amdgcn_cosf(fr); F.SIN[i] = __builtin_amdgcn_sinf(fr); }
}
__device__ __forceinline__ void p1_hprep(Frame& F) {
    const int gw = F.vcu * NWAVES + F.wave, NGW = F.G * NWAVES, lane = LANE();
    for (int chunk = gw; chunk < M / 32; chunk += NGW) {
        const int b = (chunk * 32) / SEQ; const float* mod = F.MOD + b * 6144;
        f32x4 ga[4], sh[4];
#pragma unroll
        for (int j = 0; j < 4; ++j) { const int c = 4 * lane + 256 * j; const f32x4 g = *(const f32x4*)(F.g_pre_mix + c), sc = *(const f32x4*)(mod + 1024 + c); ga[j] = g * (sc + 1.0f); sh[j] = *(const f32x4*)(mod + c); }
        const GAS f32x4* xr0 = (const GAS f32x4*)(F.x + (size_t)chunk * 32 * D) + lane;
        f32x4 nx[4];
#pragma unroll
        for (int j = 0; j < 4; ++j) nx[j] = xr0[64 * j];
#pragma unroll 1
        for (int r = 0; r < 32; ++r) { const size_t m = (size_t)chunk * 32 + r;
            f32x4 v[4]; float s = 0.f;
#pragma unroll
            for (int j = 0; j < 4; ++j) { v[j] = nx[j]; s += (v[j].x * v[j].x + v[j].y * v[j].y) + (v[j].z * v[j].z + v[j].w * v[j].w); }
            if (r + 1 < 32) { const GAS f32x4* xn = xr0 + (size_t)(r + 1) * (D / 4);
#pragma unroll
                for (int j = 0; j < 4; ++j) nx[j] = xn[64 * j]; }
            const float rstd = rsqrtf(wave_sum(s) * (1.f / D) + EPS);
            GAS u32x2* o8 = (GAS u32x2*)(F.H + m * D) + lane;
#pragma unroll
            for (int j = 0; j < 4; ++j) { const f32x4 o = v[j] * rstd * ga[j] + sh[j]; u32x2 w; w.x = pkbf(o.x, o.y); w.y = pkbf(o.z, o.w); o8[64 * j] = w; } }
    }
}
__device__ __forceinline__ void p5_postmix(Frame& F) {
    const int gw = F.vcu * NWAVES + F.wave, NGW = F.G * NWAVES, lane = LANE();
    for (int chunk = gw; chunk < M / 32; chunk += NGW) {
        const int b = (chunk * 32) / SEQ; const float* mod = F.MOD + b * 6144;
        f32x4 g1[4], ga[4], sh[4];
#pragma unroll
        for (int j = 0; j < 4; ++j) { const int c = 4 * lane + 256 * j;
            g1[j] = *(const f32x4*)(mod + 2048 + c) * *(const f32x4*)(F.g_post_mix + c);
            ga[j] = *(const f32x4*)(F.g_pre_ffn + c) * (*(const f32x4*)(mod + 4096 + c) + 1.0f); sh[j] = *(const f32x4*)(mod + 3072 + c); }
        const GAS f32x4* xr0 = (const GAS f32x4*)(F.x + (size_t)chunk * 32 * D) + lane; const GAS u32x2* or0 = (const GAS u32x2*)(F.O + (size_t)chunk * 32 * D) + lane;
        f32x4 nx[4]; u32x2 no[4]; float nps = F.PART[(size_t)chunk * 32 * 16 + (lane & 15)];
#pragma unroll
        for (int j = 0; j < 4; ++j) { nx[j] = xr0[64 * j]; no[j] = or0[64 * j]; }
#pragma unroll 1
        for (int r = 0; r < 32; ++r) { const size_t m = (size_t)chunk * 32 + r;
            float ps = nps; f32x4 xv[4]; u32x2 ow[4];
#pragma unroll
            for (int j = 0; j < 4; ++j) { xv[j] = nx[j]; ow[j] = no[j]; }
            if (r + 1 < 32) { const GAS f32x4* xn = xr0 + (size_t)(r + 1) * (D / 4); const GAS u32x2* on = or0 + (size_t)(r + 1) * (D / 4); nps = F.PART[(m + 1) * 16 + (lane & 15)];
#pragma unroll
                for (int j = 0; j < 4; ++j) { nx[j] = xn[64 * j]; no[j] = on[64 * j]; } }
            ps += __shfl_xor(ps, 1); ps += __shfl_xor(ps, 2); ps += __shfl_xor(ps, 4); ps += __shfl_xor(ps, 8);
            const float rstd_o = rsqrtf(ps * (1.f / D) + EPS);
            GAS f32x4* outr = (GAS f32x4*)(F.out + m * D) + lane;
            f32x4 v[4]; float s = 0.f;
#pragma unroll
            for (int j = 0; j < 4; ++j) { const f32x4 ov = {bflo(ow[j].x), bfhi(ow[j].x), bflo(ow[j].y), bfhi(ow[j].y)};
                v[j] = xv[j] + g1[j] * (ov * rstd_o); outr[64 * j] = v[j];
                s += (v[j].x * v[j].x + v[j].y * v[j].y) + (v[j].z * v[j].z + v[j].w * v[j].w); }
            const float rstd = rsqrtf(wave_sum(s) * (1.f / D) + EPS);
            GAS u32x2* o8 = (GAS u32x2*)(F.H + m * D) + lane;
#pragma unroll
            for (int j = 0; j < 4; ++j) { const f32x4 o = v[j] * rstd * ga[j] + sh[j]; u32x2 w; w.x = pkbf(o.x, o.y); w.y = pkbf(o.z, o.w); o8[64 * j] = w; } }
    }
}
__device__ __forceinline__ void p8_final(Frame& F) {
    const int gw = F.vcu * NWAVES + F.wave, NGW = F.G * NWAVES, lane = LANE();
    for (int chunk = gw; chunk < M / 32; chunk += NGW) {
        const int b = (chunk * 32) / SEQ; const float* mod = F.MOD + b * 6144;
        f32x4 g2[4];
#pragma unroll
        for (int j = 0; j < 4; ++j) { const int c = 4 * lane + 256 * j; g2[j] = *(const f32x4*)(mod + 5120 + c) * *(const f32x4*)(F.g_post_ffn + c); }
        const GAS u32x2* fr0 = (const GAS u32x2*)(F.FB + (size_t)chunk * 32 * D) + lane; GAS f32x4* out0 = (GAS f32x4*)(F.out + (size_t)chunk * 32 * D) + lane;
        f32x4 nx[4]; u32x2 nf[4]; float nps = F.PART[(size_t)chunk * 32 * 16 + (lane & 15)];
#pragma unroll
        for (int j = 0; j < 4; ++j) { nx[j] = out0[64 * j]; nf[j] = fr0[64 * j]; }
#pragma unroll 1
        for (int r = 0; r < 32; ++r) { const size_t m = (size_t)chunk * 32 + r;
            float ps = nps; f32x4 xv[4]; u32x2 fw[4];
#pragma unroll
            for (int j = 0; j < 4; ++j) { xv[j] = nx[j]; fw[j] = nf[j]; }
            if (r + 1 < 32) { const GAS f32x4* xn = out0 + (size_t)(r + 1) * (D / 4); const GAS u32x2* fn = fr0 + (size_t)(r + 1) * (D / 4); nps = F.PART[(m + 1) * 16 + (lane & 15)];
#pragma unroll
                for (int j = 0; j < 4; ++j) { nx[j] = xn[64 * j]; nf[j] = fn[64 * j]; } }
            ps += __shfl_xor(ps, 1); ps += __shfl_xor(ps, 2); ps += __shfl_xor(ps, 4); ps += __shfl_xor(ps, 8);
            const float rstd_f = rsqrtf(ps * (1.f / D) + EPS);
            GAS f32x4* outr = out0 + (size_t)r * (D / 4);
#pragma unroll
            for (int j = 0; j < 4; ++j) { const f32x4 fv = {bflo(fw[j].x), bfhi(fw[j].x), bflo(fw[j].y), bfhi(fw[j].y)};
                outr[64 * j] = xv[j] + g2[j] * (fv * rstd_f); } }
    }
}
constexpr int SGU_PITCH = 544;
typedef short v4i16_t __attribute__((ext_vector_type(4)));
__device__ __forceinline__ void sgu_unit(Frame& F, int b, int n) {
    int lane = LANE(); asm volatile("" : "+v"(lane));
    const int w = F.wave;
    const size_t R0 = (size_t)b * SEQ + (size_t)n * 128;
    LAS bf16* vn = (LAS bf16*)F.lds;
    LAS float* rpart = (LAS float*)(F.lds + AUX_OFF);
    {
        f32x4 gv0 = *(const f32x4*)(F.g_sgu_v + 8 * lane), gv1 = *(const f32x4*)(F.g_sgu_v + 8 * lane + 4);
#pragma unroll 4
        for (int i = 0; i < 16; ++i) { const int s = 16 * w + i;
            const v4u raw = *(const GAS v4u*)(F.ZV + (R0 + s) * DSGU + 8 * lane);
            f32x4 a = {bflo(raw.x), bfhi(raw.x), bflo(raw.y), bfhi(raw.y)}, c = {bflo(raw.z), bfhi(raw.z), bflo(raw.w), bfhi(raw.w)};
            float ss = (a.x * a.x + a.y * a.y) + (a.z * a.z + a.w * a.w) + (c.x * c.x + c.y * c.y) + (c.z * c.z + c.w * c.w);
            ss += __shfl_xor(ss, 1); ss += __shfl_xor(ss, 2); ss += __shfl_xor(ss, 4); ss += __shfl_xor(ss, 8);
            const float rstd = rsqrtf(ss * (1.f / 128.f) + EPS);
            a = a * rstd * gv0; c = c * rstd * gv1;
            v4u o; o.x = pkbf(a.x, a.y); o.y = pkbf(a.z, a.w); o.z = pkbf(c.x, c.y); o.w = pkbf(c.z, c.w);
            *(LAS v4u*)(vn + s * SGU_PITCH + 8 * lane) = o; }
    }
    __syncthreads();
    const int tt = w & 3, ch = w >> 2, tl = lane & 31, h = lane >> 5;
    const int t = tt * 32 + tl;
    f32x16 acc[8];
#pragma unroll
    for (int i = 0; i < 8; ++i)
#pragma unroll
        for (int r = 0; r < 16; ++r) acc[i][r] = 0.f;
    const int kmax = 2 * (tt + 1);
    const LAS bf16* trb = vn + (8 * h + ((lane & 15) >> 2)) * SGU_PITCH + 16 * ((lane >> 4) & 1) + 4 * (lane & 3);
#pragma unroll
    for (int gi = 0; gi < 2; ++gi) { const int g = 2 * ch + gi;
        const bf16* bp = F.WM + ((size_t)(g * 128 + t)) * 128 + 8 * h;
        bf16x8 Bf[8];
#pragma unroll
        for (int kk = 0; kk < 8; ++kk) if (kk < kmax) Bf[kk] = *(const GAS bf16x8*)(bp + kk * 16);
#pragma unroll
        for (int ct = 0; ct < 4; ++ct) { const LAS bf16* cp = trb + g * 128 + ct * 32;
            f32x16 a = acc[gi * 4 + ct];
#pragma unroll
            for (int kk = 0; kk < 8; ++kk) if (kk < kmax) {
                const v4i16_t lo = __builtin_amdgcn_ds_read_tr16_b64_v4i16((LAS v4i16_t*)(cp + kk * 16 * SGU_PITCH)), hi = __builtin_amdgcn_ds_read_tr16_b64_v4i16((LAS v4i16_t*)(cp + (kk * 16 + 4) * SGU_PITCH));
                const bf16x8 Af = {lo[0], lo[1], lo[2], lo[3], hi[0], hi[1], hi[2], hi[3]};
                a = MFMA32(Af, Bf[kk], a); }
            acc[gi * 4 + ct] = a; }
    }
    float ssq = 0.f;
#pragma unroll
    for (int gi = 0; gi < 2; ++gi) { const int g = 2 * ch + gi; const float bias = F.b_spatial[g * 128 + t];
#pragma unroll
        for (int ct = 0; ct < 4; ++ct)
#pragma unroll
            for (int qd = 0; qd < 4; ++qd) { const int c0 = g * 128 + ct * 32 + 8 * qd + 4 * h;
                const u32x2 zu = *(const GAS u32x2*)(F.ZU + (R0 + t) * DSGU + c0);
                const float u0 = bflo(zu.x), u1 = bfhi(zu.x), u2 = bflo(zu.y), u3 = bfhi(zu.y);
                float v0 = (acc[gi * 4 + ct][4 * qd + 0] + bias) * u0, v1 = (acc[gi * 4 + ct][4 * qd + 1] + bias) * u1, v2 = (acc[gi * 4 + ct][4 * qd + 2] + bias) * u2, v3 = (acc[gi * 4 + ct][4 * qd + 3] + bias) * u3;
                acc[gi * 4 + ct][4 * qd + 0] = v0; acc[gi * 4 + ct][4 * qd + 1] = v1; acc[gi * 4 + ct][4 * qd + 2] = v2; acc[gi * 4 + ct][4 * qd + 3] = v3;
                ssq += (v0 * v0 + v1 * v1) + (v2 * v2 + v3 * v3); } }
    ssq += __shfl_xor(ssq, 32);
    if (h == 0) rpart[ch * 128 + t] = ssq;
    __syncthreads();
    const float rstd = rsqrtf((rpart[t] + rpart[128 + t]) * (1.f / 512.f) + EPS);
#pragma unroll
    for (int gi = 0; gi < 2; ++gi) { const int g = 2 * ch + gi;
#pragma unroll
        for (int ct = 0; ct < 4; ++ct)
#pragma unroll
            for (int qd = 0; qd < 4; ++qd) { const int c0 = g * 128 + ct * 32 + 8 * qd + 4 * h;
                const f32x4 go = *(const f32x4*)(F.g_out_sgu + c0);
                u32x2 o; o.x = pkbf(acc[gi * 4 + ct][4 * qd + 0] * rstd * go.x, acc[gi * 4 + ct][4 * qd + 1] * rstd * go.y);
                o.y = pkbf(acc[gi * 4 + ct][4 * qd + 2] * rstd * go.z, acc[gi * 4 + ct][4 * qd + 3] * rstd * go.w);
                *(GAS u32x2*)(F.MERGED + (R0 + t) * D + c0) = o; } }
    __syncthreads();
}
__device__ __forceinline__ unsigned okey(unsigned x) { return (x & 0x8000u) ? (x ^ 0xffffu) : (x | 0x8000u); }
__device__ __forceinline__ unsigned wave_incl_scan(unsigned v) {
    v += (unsigned)__builtin_amdgcn_update_dpp(0, (int)v, 0x111, 0xf, 0xf, false);
    v += (unsigned)__builtin_amdgcn_update_dpp(0, (int)v, 0x112, 0xf, 0xf, false);
    v += (unsigned)__builtin_amdgcn_update_dpp(0, (int)v, 0x114, 0xf, 0xf, false);
    v += (unsigned)__builtin_amdgcn_update_dpp(0, (int)v, 0x118, 0xf, 0xf, false);
    v += (unsigned)__builtin_amdgcn_update_dpp(0, (int)v, 0x142, 0xa, 0xf, false);
    v += (unsigned)__builtin_amdgcn_update_dpp(0, (int)v, 0x143, 0xc, 0xf, false);
    return v;
}
__device__ __forceinline__ void radix_scan(const v4u c, unsigned kk, int lane, unsigned& bin_out, unsigned& rem_out) {
    const unsigned T = c.x + c.y + c.z + c.w; const unsigned S = wave_incl_scan(T);
    const unsigned above = S - T; const bool found = (S >= kk) && (above < kk);
    unsigned bin, rem, cum = above;
    if (cum + c.x >= kk) { bin = 0; rem = kk - cum; } else { cum += c.x;
        if (cum + c.y >= kk) { bin = 1; rem = kk - cum; } else { cum += c.y;
            if (cum + c.z >= kk) { bin = 2; rem = kk - cum; } else { cum += c.z; bin = 3; rem = kk - cum; } } }
    bin += 4 * lane;
    const unsigned long long bm = __ballot(found); const int src = bm ? (__ffsll((long long)bm) - 1) : 0;
    bin_out = (unsigned)__builtin_amdgcn_readlane((int)bin, src); rem_out = (unsigned)__builtin_amdgcn_readlane((int)rem, src);
}
constexpr int LDS_SCSTG = 131072;
constexpr int LDS_MASK = 32768, LDS_KVR = 65536, KV_NS = 5, KV_PD = 3;
#define DMA16(gsrc, ldst) __builtin_amdgcn_global_load_lds((const unsigned*)(gsrc), (LAS unsigned*)(ldst), 16, 0, 0)
#define WAIT_VM(n) asm volatile("s_waitcnt vmcnt(" #n ")" ::: "memory")
#define WG_BAR() do { __builtin_amdgcn_s_barrier(); asm volatile("" ::: "memory"); } while (0)
__device__ __forceinline__ void dsa_unit(Frame& F, int b, int qb, int second) {
    const int w = F.wave;
    bf16* SC = (bf16*)(F.scr + (second ? 512 * 1024 : 0)); bf16* YB = (bf16*)(F.scr + (second ? 896 * 1024 : 768 * 1024)); const int SP = second ? 1024 : 2048;
    const int g = w & 3, kh = w >> 2;
    const int t0 = 128 * qb + 32 * g;
    const int ntile = 4 * qb + g + 1;
    LAS unsigned* maskl = (LAS unsigned*)(F.lds + LDS_MASK);
#define LANE_HERE() int lane = LANE(); asm volatile("" : "+v"(lane)); const int q = lane & 31, h = lane >> 5; const size_t rowq = (size_t)b * SEQ + t0 + q; (void)h; (void)rowq
#ifndef NO_PASSA
    for (int rp = 0; rp < F.repA; ++rp)
    if (qb >= 2) { LANE_HERE();
        for (int rq = 0; rq < F.repE; ++rq)
#pragma unroll 4
        for (int i = 0; i < 16; ++i) { const int idx = i * 512 + 64 * w + lane, row = idx >> 6, c = idx & 63;
            const v4u v = *(const GAS v4u*)(F.QI + ((size_t)b * SEQ + 128 * qb + row) * 512 + c * 8);
            *(LAS v4u*)(F.lds + row * 1024 + ((c ^ (row & 15)) << 4)) = v; }
        const int qrow = 32 * g + q; const int lx = h ^ (qrow & 15);
        unsigned offs[8];
#pragma unroll
        for (int c8 = 0; c8 < 8; ++c8) offs[c8] = (unsigned)(qrow * 1024 + (((2 * c8) ^ lx) << 4));
        const f32x4 w0 = *(const f32x4*)(F.WI + rowq * 8), w1 = *(const f32x4*)(F.WI + rowq * 8 + 4);
        const float wv[8] = {w0.x, w0.y, w0.z, w0.w, w1.x, w1.y, w1.z, w1.w};
        const bf16* kbase = F.KI + ((size_t)b * SEQ + q) * 64 + 8 * h;
        asm volatile("s_waitcnt vmcnt(0) lgkmcnt(0)" ::: "memory"); __syncthreads();
        bf16x8 kf[4], kf1[4];
#pragma unroll
        for (int kk = 0; kk < 4; ++kk) kf[kk] = *(const GAS bf16x8*)(kbase + (size_t)(32 * kh) * 64 + kk * 16);
#pragma unroll 1
        for (int j = kh; j < ntile; j += 2) {
            asm volatile("" ::: "memory");
            {
#pragma unroll
                for (int kk = 0; kk < 4; ++kk) kf1[kk] = *(const GAS bf16x8*)(kbase + (size_t)(32 * (j + 2)) * 64 + kk * 16);
                f32x16 sc, dp, dc;
#pragma unroll
                for (int r = 0; r < 16; ++r) { sc[r] = 0.f; dp[r] = 0.f; }
                bf16x8 qc_[4], qn_[4];
#pragma unroll
                for (int kk = 0; kk < 4; ++kk) qc_[kk] = *(const LAS bf16x8*)(F.lds + offs[kk]);
#pragma unroll
                for (int hd = 0; hd < 8; ++hd) {
                    if (hd < 7) {
#pragma unroll
                        for (int kk = 0; kk < 4; ++kk) qn_[kk] = *(const LAS bf16x8*)(F.lds + offs[((hd + 1) & 1) * 4 + kk] + 256 * ((hd + 1) >> 1)); }
#pragma unroll
                    for (int r = 0; r < 16; ++r) dc[r] = 0.f;
#pragma unroll
                    for (int kk = 0; kk < 4; ++kk) dc = MFMA32(kf[kk], qc_[kk], dc);
                    if (hd > 0) {
#pragma unroll
                        for (int r = 0; r < 16; ++r) { const float dv = dp[r]; const int di = __float_as_int(dv); const float rl = __int_as_float(di & ~(di >> 31)); sc[r] = __builtin_fmaf(wv[hd - 1], rl, sc[r]); } }
                    dp = dc;
#pragma unroll
                    for (int kk = 0; kk < 4; ++kk) qc_[kk] = qn_[kk];
                }
#pragma unroll
                for (int r = 0; r < 16; ++r) { const float dv = dp[r]; const int di = __float_as_int(dv); const float rl = __int_as_float(di & ~(di >> 31)); sc[r] = __builtin_fmaf(wv[7], rl, sc[r]); }
#pragma unroll
                for (int it = 0; it < 32; ++it) { __builtin_amdgcn_sched_group_barrier(0x008, 1, 0); __builtin_amdgcn_sched_group_barrier(0x100, 1, 0); __builtin_amdgcn_sched_group_barrier(0x002, 8, 0); }
                if (j >= 4 * qb) {
                    const int dl = t0 + q - 32 * j - 4 * h;
#pragma unroll
                    for (int r = 0; r < 16; ++r) sc[r] = ((r & 3) + 8 * (r >> 2) <= dl) ? sc[r] : -INFINITY;
                }
                {   LAS unsigned char* stg = F.lds + LDS_SCSTG + w * 2560;
#pragma unroll
                    for (int qd = 0; qd < 4; ++qd) { u32x2 o;
                        o.x = __builtin_bit_cast(unsigned, __builtin_amdgcn_cvt_pkrtz(sc[4 * qd + 0], sc[4 * qd + 1]));
                        o.y = __builtin_bit_cast(unsigned, __builtin_amdgcn_cvt_pkrtz(sc[4 * qd + 2], sc[4 * qd + 3]));
                        *(LAS u32x2*)(stg + q * 80 + 16 * qd + 8 * h) = o; }
                    asm volatile("s_waitcnt lgkmcnt(0)" ::: "memory");
                    const int rr = lane >> 2, cc = lane & 3;
                    const v4u v0 = *(const LAS v4u*)(stg + rr * 80 + 16 * cc), v1 = *(const LAS v4u*)(stg + (rr + 16) * 80 + 16 * cc);
                    *(GAS v4u*)(SC + (size_t)(32 * g + rr) * SP + 32 * j + 8 * cc) = v0;
                    *(GAS v4u*)(SC + (size_t)(32 * g + rr + 16) * SP + 32 * j + 8 * cc) = v1;
                    asm volatile("s_waitcnt lgkmcnt(0)" ::: "memory");
                }
#pragma unroll
                for (int kk = 0; kk < 4; ++kk) kf[kk] = kf1[kk];
            }
        }
    }
#endif
    block_sync_nofence();
#ifndef NO_PASSB
    for (int rp = 0; rp < F.repB; ++rp)
    { LANE_HERE();
        v4u nxt[4];
        if (qb >= 2) { const GAS v4u* rp_ = (const GAS v4u*)(SC + (size_t)(16 * w) * SP + 32 * lane);
#pragma unroll
            for (int k = 0; k < 4; ++k) nxt[k] = rp_[k]; }
#pragma unroll 1
        for (int i = 0; i < 16; ++i) { const int ql = 16 * w + i; const int t = 128 * qb + ql;
            const int lo = 32 * lane;
            const unsigned causal = (t >= lo + 31) ? 0xffffffffu : (t < lo ? 0u : ((2u << (t - lo)) - 1u));
            unsigned word = causal;
            if (qb >= 2) {
                v4u cur[4];
#pragma unroll
                for (int k = 0; k < 4; ++k) cur[k] = nxt[k];
                if (i + 1 < 16) { const GAS v4u* rp_ = (const GAS v4u*)(SC + (size_t)(ql + 1) * SP + 32 * lane);
#pragma unroll
                    for (int k = 0; k < 4; ++k) nxt[k] = rp_[k]; }
                const unsigned vmask = (lane <= 4 * qb + (ql >> 5)) ? 0xffffffffu : 0u;
                unsigned W[16];
#pragma unroll
                for (int k = 0; k < 4; ++k)
#pragma unroll
                    for (int c = 0; c < 4; ++c) { const unsigned x = cur[k][c]; const unsigned sgn = (x >> 15) & 0x00010001u; W[4 * k + c] = ~(x ^ ((sgn * 0x7fffu) | 0x80008000u)); }
#define BT_STAGE(J, M) _Pragma("unroll") for (int k = 0; k < 16; ++k) if (!(k & (J))) { const unsigned A = W[k], Bv = W[k + (J)]; \
                    W[k] = ((Bv << (J)) & ((M) << (J))) | (A & ~((M) << (J))); W[k + (J)] = ((A >> (J)) & (M)) | (Bv & ~(M)); }
                BT_STAGE(8, 0x00ff00ffu) BT_STAGE(4, 0x0f0f0f0fu) BT_STAGE(2, 0x33333333u) BT_STAGE(1, 0x55555555u)
#undef BT_STAGE
                unsigned C = vmask, S = 0u, csel = 0u;
#pragma unroll
                for (int bit = 15; bit >= 0; --bit) { const unsigned zeros = C & ~W[bit];
                    const unsigned z = (unsigned)__builtin_amdgcn_readlane((int)wave_incl_scan((unsigned)__builtin_popcount(zeros)), 63);
                    const bool take0 = (csel + z >= 256u);
                    csel = take0 ? csel : csel + z;
                    S = take0 ? S : (S | zeros);
                    C = take0 ? zeros : (C & W[bit]); }
                S |= C;
                unsigned e = S & 0xffffu, o = S >> 16;
                e = (e | (e << 8)) & 0x00ff00ffu; e = (e | (e << 4)) & 0x0f0f0f0fu; e = (e | (e << 2)) & 0x33333333u; e = (e | (e << 1)) & 0x55555555u;
                o = (o | (o << 8)) & 0x00ff00ffu; o = (o | (o << 4)) & 0x0f0f0f0fu; o = (o | (o << 2)) & 0x33333333u; o = (o | (o << 1)) & 0x55555555u;
                word = (e | (o << 1)) & causal;
            }
            maskl[ql * 64 + lane] = word;
#ifdef DIAG
            if (!second) ((unsigned*)(F.scr + 512 * 1024))[ql * 64 + lane] = word;
#endif
        }
    }
    for (int rp = 0; rp < F.repD; ++rp) if (qb >= 2) { LANE_HERE(); unsigned acc = 0u;
#pragma unroll 1
        for (int i = 0; i < 16; ++i) { const GAS v4u* rp_ = (const GAS v4u*)(SC + (size_t)(16 * w + i) * SP + 32 * lane);
#pragma unroll
            for (int k = 0; k < 4; ++k) { const v4u v = rp_[k]; acc ^= v.x ^ v.y ^ v.z ^ v.w; } asm volatile("s_waitcnt vmcnt(0)" ::: "memory"); }
        if (acc == 0x12345678u) ((unsigned*)(F.scr + SCR_MK))[lane] = acc; }
#endif
#ifndef NO_PASSC
    for (int rp = 0; rp < F.repC; ++rp)
    { LANE_HERE();
        const int kr_ = 8 * g + (lane >> 3), kc_ = (lane & 7) ^ ((kr_ >> 1) & 7);
        const bf16* ksrc = F.K + ((size_t)b * SEQ + kr_) * 128 + kh * 64 + kc_ * 8;
        const int vd_ = 16 * g + (lane >> 2), vu_ = (lane & 3) ^ ((vd_ >> 2) & 3);
        const bf16* vsrc = F.VT + ((size_t)(b * 2 + kh) * 64 + vd_) * 2048 + vu_ * 8;
        const int kdst = LDS_KVR + kh * 4096 + g * 1024, vdst = LDS_KVR + 8192 + kh * 4096 + g * 1024;
        unsigned koff[4], voff[4];
#pragma unroll
        for (int kk = 0; kk < 4; ++kk) koff[kk] = (unsigned)(LDS_KVR + kh * 4096 + q * 128 + (((2 * kk + h) ^ ((q >> 1) & 7)) << 4));
#pragma unroll
        for (int u = 0; u < 4; ++u) voff[u] = (unsigned)(LDS_KVR + 8192 + kh * 4096 + q * 64 + ((u ^ ((q >> 2) & 3)) << 4) + 8 * h);
        const float kn2 = __builtin_bit_cast(float, __hip_atomic_load(F.ctl + CW_KN + (b * 2 + kh) * 2, __ATOMIC_RELAXED, __HIP_MEMORY_SCOPE_AGENT)) + __builtin_bit_cast(float, __hip_atomic_load(F.ctl + CW_KN + (b * 2 + kh) * 2 + 1, __ATOMIC_RELAXED, __HIP_MEMORY_SCOPE_AGENT));
        const float kmax = __builtin_sqrtf(kn2) * 1.01f;
        const int NT = 4 * (qb + 1);
#pragma unroll 1
        for (int hp = 0; hp < 2; ++hp) {
            const int hA = 4 * kh + 2 * hp;
            bf16x8 qa[4], qc[4]; float qn0 = 0.f, qn1 = 0.f;
#pragma unroll
            for (int kk = 0; kk < 4; ++kk) { qa[kk] = *(const GAS bf16x8*)(F.Q + rowq * 512 + hA * 64 + kk * 16 + 8 * h); qc[kk] = *(const GAS bf16x8*)(F.Q + rowq * 512 + (hA + 1) * 64 + kk * 16 + 8 * h);
#pragma unroll
                for (int e = 0; e < 8; ++e) { const float a = __builtin_bit_cast(float, (unsigned)(unsigned short)qa[kk][e] << 16), c = __builtin_bit_cast(float, (unsigned)(unsigned short)qc[kk][e] << 16); qn0 += a * a; qn1 += c * c; } }
            qn0 += __shfl_xor(qn0, 32); qn1 += __shfl_xor(qn1, 32);
            const float mb = fminf(__builtin_sqrtf(fmaxf(qn0, qn1)) * kmax, 64.0f);
            const unsigned negmb = __float_as_uint(-mb);
            f32x16 oA0, oA1, oB0, oB1;
#pragma unroll
            for (int r = 0; r < 16; ++r) { oA0[r] = 0.f; oA1[r] = 0.f; oB0[r] = 0.f; oB1[r] = 0.f; }
            float lA = 0.f, lB = 0.f;
            asm volatile("s_waitcnt vmcnt(0) lgkmcnt(0)" ::: "memory"); __syncthreads();
            f32x16 sA, sB;
#define PHASE_A(J, SLOT) do { \
                const int mwh = (int)(maskl[(32 * g + q) * 64 + (J)] >> (4 * h)); f32x16 ci; \
                _Pragma("unroll") for (int r = 0; r < 16; ++r) { const int mr = __builtin_amdgcn_sbfe(mwh, (r & 3) + 8 * (r >> 2), 1); ci[r] = __uint_as_float(((unsigned)mr & negmb) | (~(unsigned)mr & 0xff800000u)); } \
                bf16x8 kf[4]; \
                _Pragma("unroll") for (int kk = 0; kk < 4; ++kk) kf[kk] = *(const LAS bf16x8*)(F.lds + koff[kk] + (SLOT)); \
                sA = MFMA32(kf[0], qa[0], ci); sB = MFMA32(kf[0], qc[0], ci); \
                _Pragma("unroll") for (int kk = 1; kk < 4; ++kk) { sA = MFMA32(kf[kk], qa[kk], sA); sB = MFMA32(kf[kk], qc[kk], sB); } } while (0)
#define PHASE_B(SLOT) do { \
                bf16x8 vt[2][2]; \
                _Pragma("unroll") for (int dt = 0; dt < 2; ++dt) _Pragma("unroll") for (int sp = 0; sp < 2; ++sp) { \
                    const u32x2 lo = *(const LAS u32x2*)(F.lds + voff[2 * sp] + dt * 2048 + (SLOT)), hi = *(const LAS u32x2*)(F.lds + voff[2 * sp + 1] + dt * 2048 + (SLOT)); \
                    vt[dt][sp] = __builtin_bit_cast(bf16x8, ((v4u){lo.x, lo.y, hi.x, hi.y})); } \
                float l0 = 0.f, l1 = 0.f; \
                _Pragma("unroll") for (int r = 0; r < 16; r += 2) { sA[r] = __builtin_amdgcn_exp2f(sA[r]); sA[r + 1] = __builtin_amdgcn_exp2f(sA[r + 1]); l0 += sA[r]; l1 += sA[r + 1]; } \
                lA += l0 + l1; l0 = 0.f; l1 = 0.f; \
                _Pragma("unroll") for (int r = 0; r < 16; r += 2) { sB[r] = __builtin_amdgcn_exp2f(sB[r]); sB[r + 1] = __builtin_amdgcn_exp2f(sB[r + 1]); l0 += sB[r]; l1 += sB[r + 1]; } \
                lB += l0 + l1; \
                v4u pk; pk.x = pkbf(sA[0], sA[1]); pk.y = pkbf(sA[2], sA[3]); pk.z = pkbf(sA[4], sA[5]); pk.w = pkbf(sA[6], sA[7]); const bf16x8 pA0 = __builtin_bit_cast(bf16x8, pk); \
                pk.x = pkbf(sA[8], sA[9]); pk.y = pkbf(sA[10], sA[11]); pk.z = pkbf(sA[12], sA[13]); pk.w = pkbf(sA[14], sA[15]); const bf16x8 pA1 = __builtin_bit_cast(bf16x8, pk); \
                pk.x = pkbf(sB[0], sB[1]); pk.y = pkbf(sB[2], sB[3]); pk.z = pkbf(sB[4], sB[5]); pk.w = pkbf(sB[6], sB[7]); const bf16x8 pB0 = __builtin_bit_cast(bf16x8, pk); \
                pk.x = pkbf(sB[8], sB[9]); pk.y = pkbf(sB[10], sB[11]); pk.z = pkbf(sB[12], sB[13]); pk.w = pkbf(sB[14], sB[15]); const bf16x8 pB1 = __builtin_bit_cast(bf16x8, pk); \
                oA0 = MFMA32(vt[0][0], pA0, oA0); oA0 = MFMA32(vt[0][1], pA1, oA0); oA1 = MFMA32(vt[1][0], pA0, oA1); oA1 = MFMA32(vt[1][1], pA1, oA1); \
                oB0 = MFMA32(vt[0][0], pB0, oB0); oB0 = MFMA32(vt[0][1], pB1, oB0); oB1 = MFMA32(vt[1][0], pB0, oB1); oB1 = MFMA32(vt[1][1], pB1, oB1); } while (0)
#pragma unroll
            for (int p = 0; p < KV_PD; ++p) { DMA16(ksrc + (size_t)p * 32 * 128, F.lds + kdst + p * 16384); DMA16(vsrc + p * 32, F.lds + vdst + p * 16384); }
            if (kh == 1) WG_BAR();
            int slot = -16384, ns = (KV_PD - 1) * 16384;
#pragma unroll 1
            for (int j = 0; j < NT; ++j) {
                slot = (slot == (KV_NS - 1) * 16384) ? 0 : slot + 16384; ns = (ns == (KV_NS - 1) * 16384) ? 0 : ns + 16384;
                if (j + KV_PD < NT) { DMA16(ksrc + (size_t)(j + KV_PD) * 32 * 128, F.lds + kdst + ns); DMA16(vsrc + (j + KV_PD) * 32, F.lds + vdst + ns); WAIT_VM(4); }
                else { const int rem = NT - 1 - j; if (rem >= 2) { WAIT_VM(2); } else { WAIT_VM(0); } }
                WG_BAR();
                if (j < ntile) PHASE_A(j, slot);
                WG_BAR();
                if (j < ntile) PHASE_B(slot);
            }
            if (kh == 0) WG_BAR();
#undef PHASE_A
#undef PHASE_B
            lA += __shfl_xor(lA, 32); lB += __shfl_xor(lB, 32);
            const float iA = 1.0f / lA, iB = 1.0f / lB;
            bf16* yrow = YB + (size_t)(32 * g + q) * 512 + hA * 64 + 4 * h;
#pragma unroll
            for (int qd = 0; qd < 4; ++qd) { u32x2 o;
                o.x = pkbf(oA0[4 * qd] * iA, oA0[4 * qd + 1] * iA); o.y = pkbf(oA0[4 * qd + 2] * iA, oA0[4 * qd + 3] * iA); *(GAS u32x2*)(yrow + 8 * qd) = o;
                o.x = pkbf(oA1[4 * qd] * iA, oA1[4 * qd + 1] * iA); o.y = pkbf(oA1[4 * qd + 2] * iA, oA1[4 * qd + 3] * iA); *(GAS u32x2*)(yrow + 32 + 8 * qd) = o;
                o.x = pkbf(oB0[4 * qd] * iB, oB0[4 * qd + 1] * iB); o.y = pkbf(oB0[4 * qd + 2] * iB, oB0[4 * qd + 3] * iB); *(GAS u32x2*)(yrow + 64 + 8 * qd) = o;
                o.x = pkbf(oB1[4 * qd] * iB, oB1[4 * qd + 1] * iB); o.y = pkbf(oB1[4 * qd + 2] * iB, oB1[4 * qd + 3] * iB); *(GAS u32x2*)(yrow + 96 + 8 * qd) = o; }
        }
    }
#endif
    block_sync_nofence();
    { LANE_HERE();
        const f32x4 go0 = *(const f32x4*)(F.g_out_attn + 8 * lane), go1 = *(const f32x4*)(F.g_out_attn + 8 * lane + 4);
#pragma unroll 2
        for (int i = 0; i < 16; ++i) { const int ql = 16 * w + i; const size_t row = (size_t)b * SEQ + 128 * qb + ql;
            const v4u raw = *(const GAS v4u*)(YB + (size_t)ql * 512 + 8 * lane);
            f32x4 a = {bflo(raw.x), bfhi(raw.x), bflo(raw.y), bfhi(raw.y)}, c = {bflo(raw.z), bfhi(raw.z), bflo(raw.w), bfhi(raw.w)};
            const float ss = wave_sum((a.x * a.x + a.y * a.y) + (a.z * a.z + a.w * a.w) + (c.x * c.x + c.y * c.y) + (c.z * c.z + c.w * c.w));
            const float rstd = rsqrtf(ss * (1.f / 512.f) + EPS);
            a = a * rstd * go0; c = c * rstd * go1;
            v4u o; o.x = pkbf(a.x, a.y); o.y = pkbf(a.z, a.w); o.z = pkbf(c.x, c.y); o.w = pkbf(c.z, c.w);
            *(GAS v4u*)(F.MERGED + row * D + 512 + 8 * lane) = o; }
    }
    block_sync_nofence();
}
#undef DMA16
#undef WAIT_VM
#undef WG_BAR
#undef LANE_HERE

__device__ __forceinline__ void stagger_start(int gidx, int steps) { for (int i = 0; i < gidx; ++i) __builtin_amdgcn_s_sleep(0); for (int i = 0; i < gidx * steps; ++i) __builtin_amdgcn_s_sleep(1); }
struct Args { const void* in[18]; float* out; unsigned char* ws; int ph_lo, ph_hi; int rep[8]; };
__global__ void __launch_bounds__(NWAVES * 64, 2) fwd_kernel(Args args) {
    extern __shared__ __attribute__((aligned(16))) unsigned char lds[];
    Frame F;
    F.lds = (LAS unsigned char*)lds;
    F.MISC = (volatile LAS unsigned*)(F.lds + MISC_OFF);
    F.wave = __builtin_amdgcn_readfirstlane((int)threadIdx.x >> 6);
    F.G = gridDim.x; { const int bx = blockIdx.x; F.vcu = (F.G % 8 == 0) ? (bx % 8) * (F.G / 8) + bx / 8 : bx; }
    unsigned char* ws = args.ws;
    F.ctl = (gu32*)(ws + WS_CTL);
    F.x = (const float*)args.in[0]; F.c = (const float*)args.in[1]; F.pos = (const int*)args.in[2]; F.w_ada = (const float*)args.in[3]; F.b_ada = (const float*)args.in[4];
    F.g_pre_mix = (const float*)args.in[5]; F.w_in = (const float*)args.in[6]; F.g_sgu_v = (const float*)args.in[7]; F.w_spatial = (const float*)args.in[8]; F.b_spatial = (const float*)args.in[9];
    F.g_out_sgu = (const float*)args.in[10]; F.g_out_attn = (const float*)args.in[11]; F.w_out = (const float*)args.in[12]; F.g_post_mix = (const float*)args.in[13]; F.g_pre_ffn = (const float*)args.in[14];
    F.w_ff1 = (const float*)args.in[15]; F.w_ff2 = (const float*)args.in[16]; F.g_post_ffn = (const float*)args.in[17];
    F.out = args.out; F.repA = args.rep[0]; F.repB = args.rep[1]; F.repC = args.rep[2]; F.repD = args.rep[3]; F.repE = args.rep[4]; F.repF = args.rep[5]; F.repG = args.rep[6]; F.repH = args.rep[7];
    F.MOD = (float*)(ws + WS_MOD); F.COS = (float*)(ws + WS_COS); F.SIN = (float*)(ws + WS_SIN); F.PART = (float*)(ws + WS_PART); F.WI = (float*)(ws + WS_WI);
    F.WM = (bf16*)(ws + WS_WM); F.WIN = (bf16*)(ws + WS_WIN); F.WOUT = (bf16*)(ws + WS_WOUT); F.W1 = (bf16*)(ws + WS_W1); F.W2 = (bf16*)(ws + WS_W2);
    F.H = (bf16*)(ws + WS_H); F.ZU = (bf16*)(ws + WS_ZU); F.ZV = (bf16*)(ws + WS_ZV); F.Q = (bf16*)(ws + WS_Q); F.K = (bf16*)(ws + WS_K); F.VT = (bf16*)(ws + WS_VT);
    F.QI = (bf16*)(ws + WS_QI); F.KI = (bf16*)(ws + WS_KI); F.MERGED = (bf16*)(ws + WS_MERGED); F.O = (bf16*)(ws + WS_O); F.HB = (bf16*)(ws + WS_HB); F.FB = (bf16*)(ws + WS_F);
    F.scr = ws + WS_SCR + (size_t)blockIdx.x * SCR_PER_WG;
    for (int u = TID(F); u < (LDS_BYTES - LDSCTL_OFF) / 4; u += NWAVES * 64) ((LAS unsigned*)(F.lds + LDSCTL_OFF))[u] = 0u;
    __syncthreads();
    const int lo = args.ph_lo, hi = args.ph_hi;
    const bool fusedrun = (hi - lo) > 1;
    XcdBarrier bar; bar.wave = F.wave; bar.bar = (unsigned*)(F.ctl + CW_BAR); bar.x = 0; bar.st = nullptr;
    if (fusedrun) bar = xcd_barrier_post((unsigned*)(F.ctl + CW_BAR), F.MISC + 8, F.wave);
#define IN(k) (lo <= (k) && (k) < hi)
#ifdef PROBE_DUP
#define NREP(k) (((k) == PROBE_DUP) ? 2 : 1)
#else
#define NREP(k) 1
#endif
#ifdef ONLY_PHASE
#define PHASE_ON(k) ((k) == ONLY_PHASE)
#else
#define PHASE_ON(k) true
#endif
#define SEAM(k) do { if (IN(k) && IN((k) + 1)) xcd_barrier(bar); } while (0)

    if (PHASE_ON(0) && IN(0)) { p0_prologue(F); SEAM(0); }
    if (PHASE_ON(1) && IN(1)) { p1_hprep(F); SEAM(1); }
    if (PHASE_ON(2) && IN(2)) {
        pg8::Gemm g{F.H, F.WIN, M, DINP, D}; pg8::StaticOrder S; S.init(M, DINP, F.G, (int)blockIdx.x);
        pg8::EpiProj E{F.ZU, F.ZV, F.Q, F.K, F.VT, F.QI, F.KI, F.WI, F.COS, F.SIN, (unsigned*)(F.ctl + CW_KN)};
        pg8::gemm_phase<pg8::EpiProj, pg8::StaticOrder, PG8_ALIGN, PG8_SP2>(F.lds + RING_OFF, g, S, E, F.wave);
        SEAM(2);
    }
    if (PHASE_ON(3) && IN(3)) {
        for (int u = F.vcu; u < BATCH * 16; u += F.G) sgu_unit(F, u >> 4, u & 15);
    }
    if (PHASE_ON(4) && IN(4)) {
        for (int u = F.vcu; u < BATCH * 8; u += F.G) { const int b = u >> 3, p = u & 7;
#pragma unroll 1
            for (int k = 0; k < 2; ++k) dsa_unit(F, b, k ? p : 15 - p, k); }
        SEAM(4);
    }
    if (PHASE_ON(5) && IN(5)) {
        pg8::Gemm g{F.MERGED, F.WOUT, M, D, D}; pg8::StaticOrder S; S.init(M, D, F.G, (int)blockIdx.x);
        pg8::EpiNormPart E{F.O, D, F.PART};
        pg8::gemm_phase<pg8::EpiNormPart, pg8::StaticOrder, PG8_ALIGN, PG8_SP2>(F.lds + RING_OFF, g, S, E, F.wave);
        SEAM(5);
    }
    if (PHASE_ON(6) && IN(6)) { p5_postmix(F); SEAM(6); }
    if (PHASE_ON(7) && IN(7)) {
        pg8::Gemm g{F.H, F.W1, M, FF, D}; pg8::StaticOrder S; S.init(M, FF, F.G, (int)blockIdx.x);
        pg8::EpiRelu2 E{F.HB, FF};
        stagger_start((int)(blockIdx.x >> 3) & 3, STAGGER_STEPS);
        pg8::gemm_phase<pg8::EpiRelu2, pg8::StaticOrder, PG8_ALIGN, PG8_SP2>(F.lds + RING_OFF, g, S, E, F.wave);
        SEAM(7);
    }
    if (PHASE_ON(8) && IN(8)) {
        pg8::Gemm g{F.HB, F.W2, M, D, FF}; pg8::StaticOrder S; S.init(M, D, F.G, (int)blockIdx.x);
        pg8::EpiNormPart E{F.FB, D, F.PART};
        pg8::gemm_phase<pg8::EpiNormPart, pg8::StaticOrder, PG8_ALIGN, PG8_SP2>(F.lds + RING_OFF, g, S, E, F.wave);
        SEAM(8);
    }
    if (PHASE_ON(9) && IN(9)) { p8_final(F);
#ifdef DIAG
        {
            asm volatile("s_waitcnt vmcnt(0)" ::: "memory"); __syncthreads();
            float code = 0.f;
#pragma unroll
            for (int k = 0; k < 4; ++k) { const float e = __builtin_bit_cast(float, __hip_atomic_load(F.ctl + 8192 + DIAG_SET * 4 + k, __ATOMIC_RELAXED, __HIP_MEMORY_SCOPE_AGENT)); if (e > DIAG_TOL) code += 0.25f * (float)(1 << k); }
            const int gw = F.vcu * NWAVES + F.wave, NGW = F.G * NWAVES;
            for (int chunk = gw; chunk < M / 32; chunk += NGW) for (int r = 0; r < 32; ++r) { GAS f32x4* outr = (GAS f32x4*)(F.out + ((size_t)chunk * 32 + r) * D) + LANE();
#pragma unroll
                for (int j = 0; j < 4; ++j) outr[64 * j] = outr[64 * j] * (1.0f + code); }
        }
#endif
    }
#undef IN
#undef SEAM
}


#ifdef DIAG
constexpr int CW_DIAG = 8192;
__device__ __forceinline__ void diag_max(gu32* ctl, int k, float err) { if (!(err == err)) err = 1e30f; atomicMax((unsigned*)(ctl + CW_DIAG + k), __builtin_bit_cast(unsigned, err)); }
__device__ __forceinline__ float relerr(float got, float want, float floor_) { return __builtin_fabsf(got - want) / (__builtin_fabsf(want) + floor_); }
__device__ __forceinline__ float bf2f(bf16 v) { return __builtin_bit_cast(float, (unsigned)v << 16); }
__device__ __forceinline__ float h2f(unsigned short v) { return (float)__builtin_bit_cast(_Float16, v); }
__device__ __forceinline__ float wave_max(float v) {
#pragma unroll
    for (int o = 1; o < 64; o <<= 1) v = fmaxf(v, __shfl_xor(v, o));
    return v;
}
__device__ __forceinline__ float gelu_ref(float p) { return p / (1.0f + __expf(-1.5957691216057308f * (p + 0.044715f * p * p * p))); }
__global__ void __launch_bounds__(512) diag_kernel(Args args) {
    __shared__ float pr[8][2400];
    unsigned char* ws = args.ws; gu32* ctl = (gu32*)(ws + WS_CTL);
    const float* x = (const float*)args.in[0]; const float* cc_ = (const float*)args.in[1]; const float* w_ada = (const float*)args.in[3]; const float* b_ada = (const float*)args.in[4];
    const float* g_pre_mix = (const float*)args.in[5]; const float* g_sgu_v = (const float*)args.in[7]; const float* b_spatial = (const float*)args.in[9]; const float* g_out_sgu = (const float*)args.in[10];
    const float* MOD = (const float*)(ws + WS_MOD); const float* COS = (const float*)(ws + WS_COS); const float* SIN = (const float*)(ws + WS_SIN); const float* WI = (const float*)(ws + WS_WI);
    const bf16 *WM = (const bf16*)(ws + WS_WM), *WIN = (const bf16*)(ws + WS_WIN), *H = (const bf16*)(ws + WS_H), *ZU = (const bf16*)(ws + WS_ZU), *ZV = (const bf16*)(ws + WS_ZV), *Q = (const bf16*)(ws + WS_Q), *K = (const bf16*)(ws + WS_K),
               *VT = (const bf16*)(ws + WS_VT), *QI = (const bf16*)(ws + WS_QI), *KI = (const bf16*)(ws + WS_KI), *MERGED = (const bf16*)(ws + WS_MERGED);
    const int tid = threadIdx.x, lane = tid & 63, w = tid >> 6, G = gridDim.x; const int bx = blockIdx.x, vcu = (G % 8 == 0) ? (bx % 8) * (G / 8) + bx / 8 : bx; const int gw = vcu * 8 + w;
    {
        const size_t m = ((size_t)gw * 97 + 13) % M; const size_t b = m >> 11, s = m & 2047;
#pragma unroll 1
        for (int i = 0; i < 38; ++i) { const int col = lane + 64 * i; float acc = 0.f;
            if (col < DIN) {
#pragma unroll 4
                for (int k = 0; k < D; ++k) acc += bf2f(H[m * D + k]) * bf2f(WIN[(size_t)col * D + k]);
                pr[w][col] = acc; } }
        __syncthreads();
#pragma unroll 1
        for (int i = 0; i < 38; ++i) { const int col = lane + 64 * i; if (col >= DIN) break;
            const float p = pr[w][col];
            if (col < 1024) { const float got = bf2f(col < 512 ? ZU[m * 512 + col] : ZV[m * 512 + col - 512]); diag_max(ctl, 4, relerr(got, gelu_ref(p), 0.05f)); }
            else if (col < 1664) { const bool isq = col < 1536; const int cc = isq ? col - 1024 : col - 1536; const int d = cc & 63; float v = p;
                if (d < 8) v = p * COS[m * 8 + d] - pr[w][col + 8] * SIN[m * 8 + d]; else if (d < 16) v = p * COS[m * 8 + d - 8] + pr[w][col - 8] * SIN[m * 8 + d - 8];
                if (isq) v *= 0.18033688011112042f;
                const float got = bf2f(isq ? Q[m * 512 + cc] : K[m * 128 + cc]); diag_max(ctl, 5, relerr(got, v, 0.05f)); }
            else if (col < 1792) { const int cc = col - 1664, kvh = cc >> 6, d = cc & 63; const float got = bf2f(VT[((b * 2 + kvh) * 64 + d) * 2048 + s]); diag_max(ctl, 6, relerr(got, p, 0.05f)); }
            else if (col < 2368) { const bool isq = col < 2304; const int cc = isq ? col - 1792 : col - 2304; const int d = cc & 63; float v = p;
                if (d < 8) v = p * COS[m * 8 + d] - pr[w][col + 8] * SIN[m * 8 + d]; else if (d < 16) v = p * COS[m * 8 + d - 8] + pr[w][col - 8] * SIN[m * 8 + d - 8];
                if (isq) v *= 0.125f;
                const float got = bf2f(isq ? QI[m * 512 + cc] : KI[m * 64 + cc]); diag_max(ctl, 5, relerr(got, v, 0.05f)); }
            else { const float got = WI[m * 8 + col - 2368]; diag_max(ctl, 6, relerr(got, p * 0.3535533905932738f, 0.05f)); } }
        { const int bb = gw & 31, e = (gw * 131 + 7) % 6144; float acc = 0.f;
          for (int k = lane; k < D; k += 64) { const float cv = cc_[bb * D + k]; acc += cv / (1.0f + __expf(-cv)) * w_ada[(size_t)k * 6144 + e]; }
          acc = wave_sum(acc) + b_ada[e]; diag_max(ctl, 7, relerr(MOD[bb * 6144 + e], acc, 0.02f)); }
        { float ss = 0.f; for (int k = lane; k < D; k += 64) { const float xv = x[m * D + k]; ss += xv * xv; }
          const float rstd = rsqrtf(wave_sum(ss) / D + EPS); const int k = (lane * 17 + 3) & 1023; const float* mod = MOD + b * 6144;
          const float want = x[m * D + k] * rstd * g_pre_mix[k] * (1.f + mod[1024 + k]) + mod[k]; diag_max(ctl, 7, relerr(bf2f(H[m * D + k]), want, 0.02f)); }
    }
    {
        const size_t m = ((size_t)gw * 61 + 29) % M; const size_t R0 = m & ~(size_t)127; const int tc = (int)(m & 127);
        float ssq = 0.f;
#pragma unroll 1
        for (int pass = 0; pass < 2; ++pass) { const float rs = rsqrtf(wave_sum(ssq) * (1.f / 512.f) + EPS);
#pragma unroll 1
            for (int e = 0; e < 8; ++e) { const int c = 8 * lane + e, g = c >> 7; float mix = 0.f;
#pragma unroll 1
                for (int s2 = 0; s2 <= tc; ++s2) {
                    float gs = 0.f; for (int k = 0; k < 128; ++k) { const float zv = bf2f(ZV[(R0 + s2) * 512 + g * 128 + k]); gs += zv * zv; }
                    const float vnv = bf2f((bf16)f2bf(bf2f(ZV[(R0 + s2) * 512 + c]) * rsqrtf(gs * (1.f / 128.f) + EPS) * g_sgu_v[c]));
                    mix += bf2f(WM[(g * 128 + tc) * 128 + s2]) * vnv; }
                const float yv = (mix + b_spatial[g * 128 + tc]) * bf2f(ZU[(R0 + tc) * 512 + c]);
                if (pass == 0) ssq += yv * yv; else diag_max(ctl, 3, relerr(bf2f(MERGED[(R0 + tc) * D + c]), yv * rs * g_out_sgu[c], 0.05f)); } }
    }
    if (vcu < 256) {
        const int b = vcu >> 3, qb = vcu & 7;
        const unsigned char* scr = ws + WS_SCR + (size_t)blockIdx.x * SCR_PER_WG;
        const unsigned short* SC = (const unsigned short*)(scr + SCR_SC); const unsigned* MK = (const unsigned*)(scr + SCR_MK); const bf16* YB = (const bf16*)(scr + SCR_YB);
#pragma unroll 1
        for (int i = 0; i < 16; ++i) { const int ql = 16 * w + i, t = 128 * qb + ql; int pc = __builtin_popcount(MK[ql * 64 + lane]);
#pragma unroll
            for (int o = 1; o < 64; o <<= 1) pc += __shfl_xor(pc, o);
            const int want = (t + 1 < 256) ? t + 1 : 256; if (pc < want || pc > want + 16) diag_max(ctl, 0, 1.0f + (float)(pc > want ? pc - want : want - pc)); }
        if (qb >= 2) { const int ql = 16 * w + 5, t = 128 * qb + ql; const size_t row = (size_t)b * SEQ + t; const int s2 = (lane * 37 + w * 11) % (t + 1); const size_t krow = (size_t)b * SEQ + s2;
            float sc2 = 0.f;
#pragma unroll 1
            for (int hd = 0; hd < 8; ++hd) { float d = 0.f; for (int dd = 0; dd < 64; ++dd) d += bf2f(QI[row * 512 + hd * 64 + dd]) * bf2f(KI[krow * 64 + dd]); sc2 += WI[row * 8 + hd] * fmaxf(d, 0.f); }
            diag_max(ctl, 1, relerr(h2f(SC[(size_t)ql * 2048 + s2]), sc2, 0.05f));
            float mins = INFINITY, maxu = -INFINITY;
#pragma unroll 1
            for (int s3 = lane; s3 <= t; s3 += 64) { const float v = h2f(SC[(size_t)ql * 2048 + s3]); if ((MK[ql * 64 + (s3 >> 5)] >> (s3 & 31)) & 1u) mins = fminf(mins, v); else maxu = fmaxf(maxu, v); }
            mins = -wave_max(-mins); maxu = wave_max(maxu); if (maxu > mins) diag_max(ctl, 0, 100.0f); }
        { const int ql = 16 * w + 9, t = 128 * qb + ql, hd = w, kvh = hd >> 2; const size_t row = (size_t)b * SEQ + t;
          const float qd = bf2f(Q[row * 512 + hd * 64 + lane]); float mrun = -1e30f, lrun = 0.f, o = 0.f;
#pragma unroll 1
          for (int s2 = 0; s2 <= t; ++s2) { if (!((MK[ql * 64 + (s2 >> 5)] >> (s2 & 31)) & 1u)) continue;
              const float lg = wave_sum(qd * bf2f(K[((size_t)b * SEQ + s2) * 128 + kvh * 64 + lane]));
              const float mn = fmaxf(mrun, lg), al = __builtin_amdgcn_exp2f(mrun - mn), p = __builtin_amdgcn_exp2f(lg - mn);
              lrun = lrun * al + p; o = o * al + p * bf2f(VT[((size_t)(b * 2 + kvh) * 64 + lane) * 2048 + s2]); mrun = mn; }
          diag_max(ctl, 2, relerr(bf2f(YB[(size_t)ql * 512 + hd * 64 + lane]), o / lrun, 0.02f)); }
    }
}
#endif

extern "C" void kernel_launch(void* const* d_in, const int* in_sizes, int n_in, void* d_out, int out_size, void* d_ws, size_t ws_size, hipStream_t stream) {
    static int grid = 0;
    if (grid == 0) {
        if (n_in != 18 || in_sizes[0] != M * D || out_size != M * D || ws_size < WS_END) { fprintf(stderr, "kernel_launch: unexpected problem shape or workspace (n_in %d, ws %zu < %zu)\n", n_in, ws_size, (size_t)WS_END); grid = -1; return; }
        int dev = 0, cus = 0, per_cu = 0;
        if (hipGetDevice(&dev) != hipSuccess || hipDeviceGetAttribute(&cus, hipDeviceAttributeMultiprocessorCount, dev) != hipSuccess) { grid = -1; return; }
        if (hipFuncSetAttribute((const void*)fwd_kernel, hipFuncAttributeMaxDynamicSharedMemorySize, LDS_BYTES) != hipSuccess) { grid = -1; return; }
        if (hipOccupancyMaxActiveBlocksPerMultiprocessor(&per_cu, (const void*)fwd_kernel, NWAVES * 64, LDS_BYTES) != hipSuccess || per_cu < 1) { fprintf(stderr, "kernel_launch: occupancy query reports %d workgroups per CU\n", per_cu); }
        (void)hipGetLastError();
        grid = cus;
    }
    if (grid < 0) return;
    if (hipMemsetAsync((char*)d_ws + WS_CTL, 0, CTL_ZERO_BYTES, stream) != hipSuccess) return;
    Args a{};
    a.rep[0] = 1; a.rep[1] = 1; a.rep[2] = 1; a.rep[3] = 0; a.rep[4] = 1; a.rep[5] = 1; a.rep[6] = 1; a.rep[7] = 1;
#ifdef PROBE_REP
    a.rep[PROBE_REP] += 1;
#endif
    for (int i = 0; i < 18; ++i) a.in[i] = d_in[i];
    a.out = (float*)d_out; a.ws = (unsigned char*)d_ws;
#if defined(PROBE_SPLIT)
    a.ph_lo = 0; a.ph_hi = PROBE_SPLIT + 1; hipLaunchKernelGGL(fwd_kernel, dim3(grid), dim3(NWAVES * 64), LDS_BYTES, stream, a);
    (void)hipMemsetAsync((char*)d_ws + WS_CTL, 0, CTL_ZERO_BYTES, stream);
    a.ph_lo = PROBE_SPLIT; a.ph_hi = N_PHASES; hipLaunchKernelGGL(fwd_kernel, dim3(grid), dim3(NWAVES * 64), LDS_BYTES, stream, a);
#elif MK_N_LAUNCHES == 1
    a.ph_lo = 0; a.ph_hi = N_PHASES;
    hipLaunchKernelGGL(fwd_kernel, dim3(grid), dim3(NWAVES * 64), LDS_BYTES, stream, a);
#else
    for (int li = 0; li < N_PHASES; ++li) { a.ph_lo = li; a.ph_hi = li + 1; hipLaunchKernelGGL(fwd_kernel, dim3(grid), dim3(NWAVES * 64), LDS_BYTES, stream, a);
#ifdef DIAG
        if (li == 4) hipLaunchKernelGGL(diag_kernel, dim3(grid), dim3(512), 0, stream, a);
#endif
    }
#endif
}
```
